# Optimizing an MI355X kernel written in HIP

```python
import jax, jax.numpy as jnp
from jax import lax
import numpy as np

D_MODEL = 2048
BATCH = 2
SEQ = 8192
DEPTH = 4

GRID_W = 64
CTX_LEN = 256
HEAD_DIM = 128
N_HEADS_A = 8
N_KV_A = 2
N_HEADS_B = 8
N_KV_B = 2
WINDOW = 128
Q_BLOCK = 128
ROPE_THETA = 10000.0
MLA_HEADS = 16
MLA_Q_RANK = 512
MLA_KV_RANK = 256
MLA_NOPE = 128
MLA_ROPE = 64
MLA_V = 128
D_FF = 5632
N_MOD = 9
EPS = 1e-6
NEG_INF = -1e30
N_EVEN = (DEPTH + 1) // 2
N_ODD = DEPTH // 2

QA = N_HEADS_A * HEAD_DIM
KA = N_KV_A * HEAD_DIM
QB = N_HEADS_B * HEAD_DIM
KB = N_KV_B * HEAD_DIM
AB_IN = QA + 2 * KA + QB + 2 * KB
AB_SPLITS = [QA, QA + KA, QA + 2 * KA, QA + 2 * KA + QB, QA + 2 * KA + QB + KB]
AB_OUT = (N_HEADS_A + N_HEADS_B) * HEAD_DIM
C_IN = MLA_Q_RANK + MLA_KV_RANK + MLA_ROPE
MLA_Q_OUT = MLA_HEADS * (MLA_NOPE + MLA_ROPE)
MLA_KV_OUT = MLA_HEADS * (MLA_NOPE + MLA_V)
MLA_OUT = MLA_HEADS * MLA_V

kernel_name = "hybrid_flow_backbone_gqa_swa_mla_macaron"


def rmsnorm(x, g):
    xf = x.astype(jnp.float32)
    y = xf * lax.rsqrt(jnp.mean(xf * xf, axis=-1, keepdims=True) + EPS)
    return (y * g.astype(jnp.float32)).astype(x.dtype)


def adaln_in(h, g, mod, j):
    return rmsnorm(h, g) * (1.0 + mod[..., 3 * j + 1, :]) + mod[..., 3 * j, :]


def swiglu(h, w_gu, w_dn):
    g, u = jnp.split(h @ w_gu, 2, axis=-1)
    return (jax.nn.silu(g) * u) @ w_dn


def ffn_sub(h, mod, j, g, w_gu, w_dn):
    return h + 0.5 * mod[..., 3 * j + 2, :] * swiglu(adaln_in(h, g, mod, j), w_gu, w_dn)


def grid_rope_tables(rows, rot_dim):
    r, col = jnp.meshgrid(jnp.arange(rows), jnp.arange(GRID_W), indexing="ij")
    pos = jnp.stack([r.reshape(-1), col.reshape(-1)], axis=-1).astype(jnp.float32)
    nf = rot_dim // 4
    inv = ROPE_THETA ** (-jnp.arange(nf, dtype=jnp.float32) / nf)
    ang = pos[:, :, None] * inv
    return jnp.cos(ang), jnp.sin(ang)


def rope_2d(x, cos, sin):
    b, n, h, d = x.shape
    nf = d // 4
    xr = x.reshape(b, n, h, 2, 2, nf).astype(jnp.float32)
    x1, x2 = xr[..., 0, :], xr[..., 1, :]
    cs, sn = cos[None, :, None], sin[None, :, None]
    out = jnp.stack([x1 * cs - x2 * sn, x2 * cs + x1 * sn], axis=-2)
    return out.reshape(b, n, h, d).astype(x.dtype)


def gqa_small(q, k, v, sink=None):
    b, n, h, d = q.shape
    n_kv = k.shape[2]
    g = h // n_kv
    qg = q.reshape(b, n, n_kv, g, d)
    s = jnp.einsum("bqhgd,bkhd->bhgqk", qg, k).astype(jnp.float32) * (d ** -0.5)
    if sink is not None:
        sk = jnp.broadcast_to(sink.astype(jnp.float32).reshape(n_kv, g)[None, :, :, None, None], s.shape[:-1] + (1,))
        s = jnp.concatenate([s, sk], axis=-1)
    p = jax.nn.softmax(s, axis=-1)
    if sink is not None:
        p = p[..., :-1]
    o = jnp.einsum("bhgqk,bkhd->bqhgd", p.astype(v.dtype), v)
    return o.reshape(b, n, h, d)


def dense_gqa_blocks(q, k, v):
    b, n, h, d = q.shape
    nblk = n // Q_BLOCK
    qb = q.reshape(b, nblk, Q_BLOCK, h, d).swapaxes(0, 1)
    o = lax.map(lambda qblk: gqa_small(qblk, k, v), qb)
    return o.swapaxes(0, 1).reshape(b, n, h, d)


def window_gqa(q, k, v, k_ctx, v_ctx, sink):
    b, n, h, d = q.shape
    n_kv = k.shape[2]
    g = h // n_kv
    nblk = n // Q_BLOCK
    qb = q.reshape(b, nblk, Q_BLOCK, n_kv, g, d)
    pad = ((0, 0), (Q_BLOCK, Q_BLOCK), (0, 0), (0, 0))

    def band(t):
        tp = jnp.pad(t, pad).reshape(b, nblk + 2, Q_BLOCK, n_kv, d)
        return jnp.concatenate([tp[:, :-2], tp[:, 1:-1], tp[:, 2:]], axis=2)

    kb, vb = band(k), band(v)
    qpos = jnp.arange(n).reshape(nblk, Q_BLOCK)
    kpos = jnp.arange(nblk)[:, None] * Q_BLOCK - Q_BLOCK + jnp.arange(3 * Q_BLOCK)[None, :]
    mask = (jnp.abs(qpos[:, :, None] - kpos[:, None, :]) <= WINDOW) & (kpos[:, None, :] >= 0) & (kpos[:, None, :] < n)
    scale = d ** -0.5
    s_loc = jnp.einsum("bnqhgd,bnkhd->bnhgqk", qb, kb).astype(jnp.float32) * scale
    s_loc = jnp.where(mask[None, :, None, None], s_loc, NEG_INF)
    s_ctx = jnp.einsum("bnqhgd,bkhd->bnhgqk", qb, k_ctx).astype(jnp.float32) * scale
    s_sink = jnp.broadcast_to(sink.astype(jnp.float32).reshape(n_kv, g)[None, None, :, :, None, None], s_loc.shape[:-1] + (1,))
    p = jax.nn.softmax(jnp.concatenate([s_loc, s_ctx, s_sink], axis=-1), axis=-1)
    L = 3 * Q_BLOCK
    m = k_ctx.shape[1]
    o = (jnp.einsum("bnhgqk,bnkhd->bnqhgd", p[..., :L].astype(v.dtype), vb)
         + jnp.einsum("bnhgqk,bkhd->bnqhgd", p[..., L:L + m].astype(v.dtype), v_ctx))
    return o.reshape(b, n, h, d)


def ab_heads(hs, w_in, g_q, g_k):
    b, n, _ = hs.shape
    qa, ka, va, qb, kb, vb = jnp.split(hs @ w_in, AB_SPLITS, axis=-1)
    qa = rmsnorm(qa.reshape(b, n, N_HEADS_A, HEAD_DIM), g_q)
    ka = rmsnorm(ka.reshape(b, n, N_KV_A, HEAD_DIM), g_k)
    va = va.reshape(b, n, N_KV_A, HEAD_DIM)
    qb = qb.reshape(b, n, N_HEADS_B, HEAD_DIM)
    kb = kb.reshape(b, n, N_KV_B, HEAD_DIM)
    vb = vb.reshape(b, n, N_KV_B, HEAD_DIM)
    return qa, ka, va, qb, kb, vb


def mixer_ab(hx, hc, w_in, g_q, g_k, sink, w_out, cos, sin, need_ctx):
    qa_c, ka_c, va_c, qb_c, kb_c, vb_c = ab_heads(hc, w_in, g_q, g_k)
    qa, ka, va, qb, kb, vb = ab_heads(hx, w_in, g_q, g_k)
    qa, ka, qb, kb = rope_2d(qa, cos, sin), rope_2d(ka, cos, sin), rope_2d(qb, cos, sin), rope_2d(kb, cos, sin)
    b, n = hx.shape[0], hx.shape[1]
    oa = dense_gqa_blocks(qa, jnp.concatenate([ka_c, ka], axis=1), jnp.concatenate([va_c, va], axis=1))
    ob = window_gqa(qb, kb, vb, kb_c, vb_c, sink)
    out_x = jnp.concatenate([oa.reshape(b, n, QA), ob.reshape(b, n, QB)], axis=-1) @ w_out
    if not need_ctx:
        return out_x, None
    m = hc.shape[1]
    oa_c = gqa_small(qa_c, ka_c, va_c)
    ob_c = gqa_small(qb_c, kb_c, vb_c, sink)
    out_c = jnp.concatenate([oa_c.reshape(b, m, QA), ob_c.reshape(b, m, QB)], axis=-1) @ w_out
    return out_x, out_c


def mla_heads(hs, w_in, g_cq, g_ckv, w_uq, w_ukv):
    b, n, _ = hs.shape
    cq, ckv, k_rope = jnp.split(hs @ w_in, [MLA_Q_RANK, MLA_Q_RANK + MLA_KV_RANK], axis=-1)
    q = (rmsnorm(cq, g_cq) @ w_uq).reshape(b, n, MLA_HEADS, MLA_NOPE + MLA_ROPE)
    kv = (rmsnorm(ckv, g_ckv) @ w_ukv).reshape(b, n, MLA_HEADS, MLA_NOPE + MLA_V)
    q_nope, q_rope = q[..., :MLA_NOPE], q[..., MLA_NOPE:]
    k_nope, v = kv[..., :MLA_NOPE], kv[..., MLA_NOPE:]
    return q_nope, q_rope, k_nope, k_rope, v


def mla_attend(q_nope, q_rope, k_nope, k_rope, v):
    s = (jnp.einsum("bqhd,bkhd->bhqk", q_nope, k_nope)
         + jnp.einsum("bqhd,bkd->bhqk", q_rope, k_rope)).astype(jnp.float32) * ((MLA_NOPE + MLA_ROPE) ** -0.5)
    p = jax.nn.softmax(s, axis=-1)
    return jnp.einsum("bhqk,bkhd->bqhd", p.astype(v.dtype), v)


def mixer_mla(hx, hc, w_in, g_cq, g_ckv, w_uq, w_ukv, w_out, cos, sin, need_ctx):
    qn_c, qr_c, kn_c, kr_c, v_c = mla_heads(hc, w_in, g_cq, g_ckv, w_uq, w_ukv)
    qn, qr, kn, kr, v = mla_heads(hx, w_in, g_cq, g_ckv, w_uq, w_ukv)
    qr = rope_2d(qr, cos, sin)
    kr = rope_2d(kr[:, :, None, :], cos, sin)[:, :, 0, :]
    kn_all = jnp.concatenate([kn_c, kn], axis=1)
    kr_all = jnp.concatenate([kr_c, kr], axis=1)
    v_all = jnp.concatenate([v_c, v], axis=1)
    b, n = hx.shape[0], hx.shape[1]
    nblk = n // Q_BLOCK
    qn_b = qn.reshape(b, nblk, Q_BLOCK, MLA_HEADS, MLA_NOPE).swapaxes(0, 1)
    qr_b = qr.reshape(b, nblk, Q_BLOCK, MLA_HEADS, MLA_ROPE).swapaxes(0, 1)
    o = lax.map(lambda qs: mla_attend(qs[0], qs[1], kn_all, kr_all, v_all), (qn_b, qr_b))
    out_x = o.swapaxes(0, 1).reshape(b, n, MLA_OUT) @ w_out
    if not need_ctx:
        return out_x, None
    o_c = mla_attend(qn_c, qr_c, kn_c, kr_c, v_c)
    out_c = o_c.reshape(b, hc.shape[1], MLA_OUT) @ w_out
    return out_x, out_c


def setup_inputs(seed: int = 0) -> dict:
    key = jax.random.key(seed)
    ks = jax.random.split(key, 24)

    def nrm(k, shape, scale):
        return jax.random.normal(k, shape, jnp.float32) * scale

    return {
        "x": nrm(ks[0], (BATCH, SEQ, D_MODEL), 1.0),
        "c": nrm(ks[1], (BATCH, D_MODEL), 1.0),
        "ctx": nrm(ks[2], (BATCH, CTX_LEN, D_MODEL), 1.0),
        "c_ctx": nrm(ks[3], (D_MODEL,), 1.0),
        "w_mod": nrm(ks[4], (DEPTH, D_MODEL, N_MOD * D_MODEL), D_MODEL ** -0.5),
        "b_mod": nrm(ks[5], (DEPTH, N_MOD * D_MODEL), 0.01),
        "g_norm": 1.0 + nrm(ks[6], (DEPTH, 3, D_MODEL), 0.02),
        "w_gate_up": nrm(ks[7], (DEPTH, 2, D_MODEL, 2 * D_FF), D_MODEL ** -0.5),
        "w_down": nrm(ks[8], (DEPTH, 2, D_FF, D_MODEL), D_FF ** -0.5),
        "w_in_ab": nrm(ks[9], (N_EVEN, D_MODEL, AB_IN), D_MODEL ** -0.5),
        "g_qnorm_a": 1.0 + nrm(ks[10], (N_EVEN, HEAD_DIM), 0.02),
        "g_knorm_a": 1.0 + nrm(ks[11], (N_EVEN, HEAD_DIM), 0.02),
        "sink_b": nrm(ks[12], (N_EVEN, N_HEADS_B), 0.5),
        "w_out_ab": nrm(ks[13], (N_EVEN, AB_OUT, D_MODEL), AB_OUT ** -0.5),
        "w_in_c": nrm(ks[14], (N_ODD, D_MODEL, C_IN), D_MODEL ** -0.5),
        "g_cq": 1.0 + nrm(ks[15], (N_ODD, MLA_Q_RANK), 0.02),
        "g_ckv": 1.0 + nrm(ks[16], (N_ODD, MLA_KV_RANK), 0.02),
        "w_uq": nrm(ks[17], (N_ODD, MLA_Q_RANK, MLA_Q_OUT), MLA_Q_RANK ** -0.5),
        "w_ukv": nrm(ks[18], (N_ODD, MLA_KV_RANK, MLA_KV_OUT), MLA_KV_RANK ** -0.5),
        "w_out_c": nrm(ks[19], (N_ODD, MLA_OUT, D_MODEL), MLA_OUT ** -0.5),
        "g_final": 1.0 + nrm(ks[20], (D_MODEL,), 0.02),
    }


def reference(x, c, ctx, c_ctx, w_mod, b_mod, g_norm, w_gate_up, w_down, w_in_ab, g_qnorm_a, g_knorm_a,
              sink_b, w_out_ab, w_in_c, g_cq, g_ckv, w_uq, w_ukv, w_out_c, g_final):
    n = x.shape[1]
    rows = n // GRID_W
    cos_h, sin_h = grid_rope_tables(rows, HEAD_DIM)
    cos_m, sin_m = grid_rope_tables(rows, MLA_ROPE)
    sc = jax.nn.silu(c)
    scc = jax.nn.silu(c_ctx)
    h = ctx
    for l in range(DEPTH):
        need_ctx = l < DEPTH - 1
        mod_x = (sc @ w_mod[l] + b_mod[l]).reshape(-1, N_MOD, D_MODEL)[:, None]
        mod_c = (scc @ w_mod[l] + b_mod[l]).reshape(N_MOD, D_MODEL)
        x = ffn_sub(x, mod_x, 0, g_norm[l, 0], w_gate_up[l, 0], w_down[l, 0])
        h = ffn_sub(h, mod_c, 0, g_norm[l, 0], w_gate_up[l, 0], w_down[l, 0])
        ax = adaln_in(x, g_norm[l, 1], mod_x, 1)
        ah = adaln_in(h, g_norm[l, 1], mod_c, 1)
        i = l // 2
        if l % 2 == 0:
            ox, oh = mixer_ab(ax, ah, w_in_ab[i], g_qnorm_a[i], g_knorm_a[i], sink_b[i], w_out_ab[i], cos_h, sin_h, need_ctx)
        else:
            ox, oh = mixer_mla(ax, ah, w_in_c[i], g_cq[i], g_ckv[i], w_uq[i], w_ukv[i], w_out_c[i], cos_m, sin_m, need_ctx)
        x = x + mod_x[..., 5, :] * ox
        x = ffn_sub(x, mod_x, 2, g_norm[l, 2], w_gate_up[l, 1], w_down[l, 1])
        if need_ctx:
            h = h + mod_c[..., 5, :] * oh
            h = ffn_sub(h, mod_c, 2, g_norm[l, 2], w_gate_up[l, 1], w_down[l, 1])
    return rmsnorm(x, g_final)
```

```cpp
#include <hip/hip_runtime.h>
#include <cstdio>
#include <cstdint>

constexpr int DM = 2048, NB = 2, SEQ = 8192, CTXL = 256, DEPTH = 4, DFF = 5632, NMOD = 9, GRID_W = 64;
constexpr int RPB = CTXL + SEQ;
constexpr int MROWS = NB * RPB;
constexpr int PPB = RPB / 256;
constexpr int AB_IN = 3072, C_IN = 832, C_IN_PAD = 1024, QRANK = 512, KVRANK = 256, MLA_QOUT = 3072, MLA_KVOUT = 4096;
constexpr float EPS = 1e-6f;

#ifndef DIS_A128
#define DIS_A128 0
#endif
#ifndef DIS_A192
#define DIS_A192 0
#endif
#ifndef DIS_G1
#define DIS_G1 0
#endif
#ifndef DIS_G2
#define DIS_G2 0
#endif
#ifndef DIS_G3
#define DIS_G3 0
#endif
#ifndef DIS_G4
#define DIS_G4 0
#endif
#ifndef DIS_G5
#define DIS_G5 0
#endif
#ifndef DIS_G6
#define DIS_G6 0
#endif
#ifndef ATT_SD128
#define ATT_SD128 1
#endif
#ifndef ATT_SD192
#define ATT_SD192 1
#endif
namespace pg8 {
#define PG8_LAS __attribute__((address_space(3)))
typedef unsigned short bf16_t;
typedef short bf16x8 __attribute__((ext_vector_type(8)));
typedef float f32x4 __attribute__((ext_vector_type(4)));
typedef unsigned u32x4 __attribute__((ext_vector_type(4)));
constexpr int BM = 256, BK = 64, HALF = 128, HTB = HALF * BK * 2  , STAGE_BYTES = 8 * HTB, NXCD = 8, WGM = 8;

__host__ __device__ __forceinline__ int lds_byte(int r, int c) { const int st = (r >> 4) * 2 + (c >> 5), rr = r & 15, cc = c & 31, ob = rr * 64 + cc * 2; return st * 1024 + (ob ^ (((ob >> 9) & 1) << 5)); }
__host__ __device__ __forceinline__ void stage_rc(int b, int& R, int& C) { const int st = b / 1024, sb = b % 1024, swz = sb ^ (((sb >> 9) & 1) << 5); R = (st >> 1) * 16 + swz / 64; C = (st & 1) * 32 + (swz % 64) / 2; }
__host__ __device__ __forceinline__ int perm32(int rho) { const int n = rho >> 4, i = rho & 15; return 8 * (i >> 2) + 4 * n + (i & 3); }

struct Unit { int pm, pn; };
struct Gemm { const bf16_t* A; const bf16_t* Bt; int M, N, K; };

struct StaticOrder {
    int nM, nN, nwg, G, c;
    __host__ __device__ void init(int M, int N, int G_, int c_) { nM = M / BM; nN = N / BM; nwg = nM * nN; G = G_; c = c_; }
    __host__ __device__ bool next(int i, Unit& u) const {
        const long L = (long)i * G + c; if (L >= nwg) return false;
        int wgid = (int)L; { const int q = nwg / NXCD, r = nwg % NXCD, xcd = wgid % NXCD, off = wgid / NXCD; wgid = (xcd < r ? xcd * (q + 1) : r * (q + 1) + (xcd - r) * q) + off; }
        const int nig = WGM * nN, gid = wgid / nig, fm = gid * WGM, gsz = (nM - fm) < WGM ? (nM - fm) : WGM;
        u.pm = fm + ((wgid % nig) % gsz); u.pn = (wgid % nig) / gsz; return true;
    }
    __device__ __forceinline__ void a_ready(const Unit&) const {}
    __device__ __forceinline__ void done(const Unit&) const {}
};

__device__ __forceinline__ unsigned cvt_pk_bf16(float lo, float hi) { unsigned r; asm volatile("v_cvt_pk_bf16_f32 %0, %1, %2" : "=v"(r) : "v"(lo), "v"(hi)); return r; }

struct EpiPlain {
    static constexpr bool PERM = true, AFTER_DRAIN = false;
    bf16_t* O; int ldc;
    __device__ __forceinline__ void operator()(const f32x4 (&acc)[2][2][4][2], const Unit& u, int wr, int wc, int fr, int fq) const {
        const int row0 = u.pm * BM + wr * 64 + fr, col0 = u.pn * BM + wc * 32 + 8 * fq;
#pragma unroll
        for (int ai = 0; ai < 2; ++ai)
#pragma unroll
            for (int m = 0; m < 4; ++m) { bf16_t* rowp = O + (size_t)(row0 + ai * HALF + m * 16) * ldc + col0;
#pragma unroll
                for (int bj = 0; bj < 2; ++bj) { const f32x4 v0 = acc[ai][bj][m][0], v1 = acc[ai][bj][m][1];
                    u32x4 w; w.x = cvt_pk_bf16(v0[0], v0[1]); w.y = cvt_pk_bf16(v0[2], v0[3]); w.z = cvt_pk_bf16(v1[0], v1[1]); w.w = cvt_pk_bf16(v1[2], v1[3]);
                    *(u32x4*)(rowp + bj * HALF) = w; } }
    }
};
__device__ __forceinline__ float silu_mul(float g, float u) { const float e = __builtin_amdgcn_exp2f(g * -1.4426950408889634f); return g * __builtin_amdgcn_rcpf(1.0f + e) * u; }
struct EpiSwiGLU {
    static constexpr bool PERM = true, AFTER_DRAIN = false;
    bf16_t* H; int ldh;
    __device__ __forceinline__ void operator()(const f32x4 (&acc)[2][2][4][2], const Unit& u, int wr, int wc, int fr, int fq) const {
        const int row0 = u.pm * BM + wr * 64 + fr, col0 = u.pn * HALF + wc * 32 + 8 * fq;
#pragma unroll
        for (int ai = 0; ai < 2; ++ai)
#pragma unroll
            for (int m = 0; m < 4; ++m) { bf16_t* rowp = H + (size_t)(row0 + ai * HALF + m * 16) * ldh + col0;
                const f32x4 g0 = acc[ai][0][m][0], g1 = acc[ai][0][m][1], u0 = acc[ai][1][m][0], u1 = acc[ai][1][m][1];
                u32x4 w;
                w.x = cvt_pk_bf16(silu_mul(g0[0], u0[0]), silu_mul(g0[1], u0[1])); w.y = cvt_pk_bf16(silu_mul(g0[2], u0[2]), silu_mul(g0[3], u0[3]));
                w.z = cvt_pk_bf16(silu_mul(g1[0], u1[0]), silu_mul(g1[1], u1[1])); w.w = cvt_pk_bf16(silu_mul(g1[2], u1[2]), silu_mul(g1[3], u1[3]));
                *(u32x4*)rowp = w; }
    }
};
struct EpiResid {
    static constexpr bool PERM = false, AFTER_DRAIN = false;
    float* X; const float* modl; int gidx; float coef;
    __device__ __forceinline__ void operator()(const f32x4 (&acc)[2][2][4][2], const Unit& u, int wr, int wc, int fr, int fq) const {
        const int b = u.pm / 33, v = (u.pm - b * 33 == 0) ? 2 : b;
        const float* gate = modl + (size_t)(v * 9 + gidx) * 2048;
        const int row0 = u.pm * BM + wr * 64 + fr, col0 = u.pn * BM + wc * 32 + 4 * fq;
        f32x4 gv[2][2];
#pragma unroll
        for (int bj = 0; bj < 2; ++bj)
#pragma unroll
            for (int n = 0; n < 2; ++n) gv[bj][n] = *(const f32x4*)(gate + col0 + bj * HALF + n * 16) * coef;
#pragma unroll
        for (int ai = 0; ai < 2; ++ai)
#pragma unroll
            for (int m = 0; m < 4; ++m) { float* rowp = X + (size_t)(row0 + ai * HALF + m * 16) * 2048 + col0;
#pragma unroll
                for (int bj = 0; bj < 2; ++bj)
#pragma unroll
                    for (int n = 0; n < 2; ++n) { float* p = rowp + bj * HALF + n * 16; const f32x4 xo = *(const f32x4*)p; *(f32x4*)p = xo + gv[bj][n] * acc[ai][bj][m][n]; }
                asm volatile("" ::: "memory"); }
    }
};

template <class Epi, class Sched, bool ALIGN_EPI = false, bool SP2 = false>
__device__ __forceinline__ void gemm_phase(PG8_LAS unsigned char* lds, const Gemm g, const Sched& S, const Epi& E) {
    int tid_ = threadIdx.x; asm volatile("" : "+v"(tid_));
    const int tid = tid_, wid = __builtin_amdgcn_readfirstlane(tid >> 6), lane = tid & 63, wr = wid >> 2, wc = wid & 3, fr = lane & 15, fq = lane >> 4;
    const int K = g.K, nt = K / BK;
    unsigned voffA[2], voffB[2];
#pragma unroll
    for (int i = 0; i < 2; ++i) { int R, C; stage_rc(tid * 16 + i * 8192, R, C); const int Rb = Epi::PERM ? ((R & ~31) + perm32(R & 31)) : R;
        voffA[i] = (unsigned)(R * K + C) * 2u; voffB[i] = (unsigned)(Rb * K + C) * 2u; }
    const size_t kstep = (size_t)(BK * 2);
    const size_t hstep = (size_t)HALF * K * 2;
    const size_t tstep = 2 * hstep;
    const unsigned ldsw = (unsigned)wid * 1024u;
    const int aoff = lds_byte(wr * 64 + fr, fq * 8), boff = lds_byte(wc * 32 + fr, fq * 8);
#define PG8_SA(b, h) (((b) * 2 + (h)) * HTB)
#define PG8_SB(b, h) ((4 + (b) * 2 + (h)) * HTB)
#define PG8_STAGE(bufoff, gbase, voff) do { _Pragma("unroll") for (int _i = 0; _i < 2; ++_i) \
        __builtin_amdgcn_global_load_lds((const unsigned*)((const char*)(gbase) + (voff)[_i]), (PG8_LAS unsigned*)(lds + (bufoff) + ldsw + _i * 8192), 16, 0, 0); } while (0)
#define PG8_LDA(dst, b, h) do { _Pragma("unroll") for (int m = 0; m < 4; ++m) _Pragma("unroll") for (int k = 0; k < 2; ++k) dst[m][k] = *(const PG8_LAS bf16x8*)(lds + PG8_SA(b, h) + aoff + m * 2048 + k * 1024); } while (0)
#define PG8_LDB(dst, b, h) do { _Pragma("unroll") for (int n = 0; n < 2; ++n) _Pragma("unroll") for (int k = 0; k < 2; ++k) dst[n][k] = *(const PG8_LAS bf16x8*)(lds + PG8_SB(b, h) + boff + n * 2048 + k * 1024); } while (0)
#define PG8_MMA(ai, bj, At, Bt) do { __builtin_amdgcn_s_setprio(1); _Pragma("unroll") for (int m = 0; m < 4; ++m) _Pragma("unroll") for (int n = 0; n < 2; ++n) _Pragma("unroll") for (int k = 0; k < 2; ++k) \
        acc[ai][bj][m][n] = __builtin_amdgcn_mfma_f32_16x16x32_bf16(Bt[n][k], At[m][k], acc[ai][bj][m][n], 0, 0, 0); __builtin_amdgcn_s_setprio(0); } while (0)
#define PG8_WAIT_V(n) asm volatile("s_waitcnt vmcnt(" #n ")" ::: "memory")
#define PG8_WAIT_L(n) asm volatile("s_waitcnt lgkmcnt(" #n ")" ::: "memory")
#define PG8_BAR __builtin_amdgcn_s_barrier()
#define PG8_SCHED __builtin_amdgcn_sched_barrier(0)
    Unit cur, nxt; int ui = 0;
    if (!S.next(0, cur)) return;
    f32x4 acc[2][2][4][2];
#pragma unroll
    for (int a = 0; a < 2; ++a)
#pragma unroll
        for (int b = 0; b < 2; ++b)
#pragma unroll
            for (int m = 0; m < 4; ++m)
#pragma unroll
                for (int n = 0; n < 2; ++n) acc[a][b][m][n] = (f32x4){0.f, 0.f, 0.f, 0.f};
    bf16x8 At[4][2], B0[2][2], B1[2][2];
    const char* cA = (const char*)g.A + (size_t)cur.pm * tstep; const char* cB = (const char*)g.Bt + (size_t)cur.pn * tstep;
    S.a_ready(cur);
    if constexpr (SP2) {
        PG8_STAGE(PG8_SB(0, 0), cB, voffB); PG8_STAGE(PG8_SB(0, 1), cB + hstep, voffB); PG8_STAGE(PG8_SA(0, 0), cA, voffA); PG8_STAGE(PG8_SA(0, 1), cA + hstep, voffA);
        if (wr == 1) PG8_BAR;
        PG8_WAIT_V(2); PG8_BAR;
        PG8_STAGE(PG8_SB(1, 0), cB + kstep, voffB); PG8_STAGE(PG8_SA(1, 0), cA + kstep, voffA); PG8_STAGE(PG8_SB(1, 1), cB + hstep + kstep, voffB);
        PG8_WAIT_V(6); PG8_BAR;
    } else {
        PG8_STAGE(PG8_SB(0, 0), cB, voffB); PG8_STAGE(PG8_SA(0, 0), cA, voffA); PG8_STAGE(PG8_SB(0, 1), cB + hstep, voffB); PG8_STAGE(PG8_SA(0, 1), cA + hstep, voffA);
        if (wr == 1) PG8_BAR;
        PG8_WAIT_V(4); PG8_BAR;
        PG8_STAGE(PG8_SB(1, 0), cB + kstep, voffB); PG8_STAGE(PG8_SA(1, 0), cA + kstep, voffA); PG8_STAGE(PG8_SB(1, 1), cB + hstep + kstep, voffB);
        PG8_WAIT_V(6); PG8_BAR;
    }
    for (;;) {
        const bool has_next = S.next(ui + 1, nxt);
        const char* nA = has_next ? (const char*)g.A + (size_t)nxt.pm * tstep : cA; const char* nB = has_next ? (const char*)g.Bt + (size_t)nxt.pn * tstep : cB;
        for (int t = 0; t < nt; t += 2) {
            const bool last = (t == nt - 2);
            const char* a1 = cA + (size_t)(t + 1) * kstep;
            const char* a2 = last ? nA : cA + (size_t)(t + 2) * kstep; const char* b2 = last ? nB : cB + (size_t)(t + 2) * kstep;
            const char* a3 = a2 + kstep; const char* b3 = b2 + kstep;
            if (last && has_next) S.a_ready(nxt);
            if constexpr (SP2) {
            PG8_LDB(B0, 0, 0); PG8_LDB(B1, 0, 1); PG8_SCHED; PG8_LDA(At, 0, 0); PG8_STAGE(PG8_SA(1, 1), a1 + hstep, voffA);
            PG8_WAIT_V(8); PG8_WAIT_L(0); PG8_BAR; PG8_MMA(0, 0, At, B0); PG8_MMA(0, 1, At, B1); PG8_BAR; PG8_SCHED;
            PG8_LDA(At, 0, 1); PG8_STAGE(PG8_SB(0, 0), b2, voffB); PG8_STAGE(PG8_SB(0, 1), b2 + hstep, voffB); PG8_STAGE(PG8_SA(0, 0), a2, voffA);
            PG8_WAIT_V(8); PG8_WAIT_L(0); PG8_BAR; PG8_MMA(1, 0, At, B0); PG8_MMA(1, 1, At, B1); PG8_BAR; PG8_SCHED;
            PG8_LDB(B0, 1, 0); PG8_LDB(B1, 1, 1); PG8_SCHED; PG8_LDA(At, 1, 0); PG8_STAGE(PG8_SA(0, 1), a2 + hstep, voffA);
            PG8_WAIT_V(8); PG8_WAIT_L(0); PG8_BAR; PG8_MMA(0, 0, At, B0); PG8_MMA(0, 1, At, B1); PG8_BAR; PG8_SCHED;
            PG8_LDA(At, 1, 1); PG8_STAGE(PG8_SB(1, 0), b3, voffB); PG8_STAGE(PG8_SB(1, 1), b3 + hstep, voffB); PG8_STAGE(PG8_SA(1, 0), a3, voffA);
            PG8_WAIT_V(8); PG8_WAIT_L(0); PG8_BAR; PG8_MMA(1, 0, At, B0); PG8_MMA(1, 1, At, B1); PG8_BAR; PG8_SCHED;
            } else {
            PG8_LDB(B0, 0, 0); PG8_SCHED; PG8_LDA(At, 0, 0); PG8_STAGE(PG8_SA(1, 1), a1 + hstep, voffA);
            PG8_WAIT_L(8); PG8_BAR; PG8_WAIT_L(0); PG8_MMA(0, 0, At, B0); PG8_BAR; PG8_SCHED;
            PG8_LDB(B1, 0, 1); PG8_STAGE(PG8_SB(0, 0), b2, voffB);
            PG8_BAR; PG8_WAIT_L(0); PG8_MMA(0, 1, At, B1); PG8_BAR;
            PG8_LDA(At, 0, 1); PG8_STAGE(PG8_SA(0, 0), a2, voffA);
            PG8_BAR; PG8_WAIT_L(0); PG8_MMA(1, 0, At, B0); PG8_BAR; PG8_SCHED;
            PG8_STAGE(PG8_SB(0, 1), b2 + hstep, voffB);
            PG8_WAIT_V(6); PG8_BAR; PG8_MMA(1, 1, At, B1); PG8_BAR;
            PG8_LDB(B0, 1, 0); PG8_SCHED; PG8_LDA(At, 1, 0); PG8_STAGE(PG8_SA(0, 1), a2 + hstep, voffA);
            PG8_WAIT_L(8); PG8_BAR; PG8_WAIT_L(0); PG8_MMA(0, 0, At, B0); PG8_BAR; PG8_SCHED;
            PG8_LDB(B1, 1, 1); PG8_STAGE(PG8_SB(1, 0), b3, voffB);
            PG8_BAR; PG8_WAIT_L(0); PG8_MMA(0, 1, At, B1); PG8_BAR;
            PG8_LDA(At, 1, 1); PG8_STAGE(PG8_SA(1, 0), a3, voffA);
            PG8_BAR; PG8_WAIT_L(0); PG8_MMA(1, 0, At, B0); PG8_BAR; PG8_SCHED;
            PG8_STAGE(PG8_SB(1, 1), b3 + hstep, voffB);
            PG8_WAIT_V(6); PG8_BAR; PG8_MMA(1, 1, At, B1); PG8_BAR;
            }
        }
        if constexpr (ALIGN_EPI) { if (wr == 0) PG8_BAR; }
        if constexpr (!Epi::AFTER_DRAIN) { E(acc, cur, wr, wc, fr, fq); S.done(cur); }
        if (!has_next) break;
#pragma unroll
        for (int a = 0; a < 2; ++a)
#pragma unroll
            for (int b = 0; b < 2; ++b)
#pragma unroll
                for (int m = 0; m < 4; ++m)
#pragma unroll
                    for (int n = 0; n < 2; ++n) acc[a][b][m][n] = (f32x4){0.f, 0.f, 0.f, 0.f};
        cur = nxt; cA = nA; cB = nB; ++ui;
        if constexpr (ALIGN_EPI) { if (wr == 1) PG8_BAR; }
    }
    PG8_WAIT_V(0);
    if constexpr (!ALIGN_EPI) { if (wr == 0) PG8_BAR; }
    PG8_BAR;
    if constexpr (Epi::AFTER_DRAIN) { E.fused(acc, cur, wr, wc, fr, fq, lds, wid, lane); S.done(cur); }
#undef PG8_SA
#undef PG8_SB
#undef PG8_STAGE
#undef PG8_LDA
#undef PG8_LDB
#undef PG8_MMA
#undef PG8_WAIT_V
#undef PG8_WAIT_L
#undef PG8_BAR
#undef PG8_SCHED
}
}
#ifndef PG8_SP2
#define PG8_SP2 true
#endif
#ifndef PG8_ALIGN
#define PG8_ALIGN true
#endif

namespace att {
typedef unsigned short bf16_t;
using bf16x8 = __attribute__((ext_vector_type(8))) short;
using s16x4  = __attribute__((ext_vector_type(4))) short;
using f32x16 = __attribute__((ext_vector_type(16))) float;
using u32x4  = __attribute__((ext_vector_type(4))) unsigned;
constexpr int NW = 8, QBLK = 32, KVBLK = 64;
constexpr int SHM_V = 16384, SHM_K = 16384, SHM_KR = 8192;
constexpr int OFF_V = 0, OFF_K = 2 * SHM_V, OFF_KR = OFF_K + 2 * SHM_K, OFF_WS = OFF_KR + 2 * SHM_KR, OFF_QR = OFF_WS + NW * 64 * 4, LDS_BYTES = OFF_QR + NW * 4096;
#ifndef ATTN_THR
#define ATTN_THR 8.f
#endif
constexpr float THR = ATTN_THR;
#define KSWZ(row, colB) ((row) * 256 + ((colB) ^ (((row) & 7) << 4)))
#define KRSWZ(row, colB) ((row) * 128 + ((colB) ^ ((((row) >> 1) & 7) << 4)))
#define SBAR() __builtin_amdgcn_sched_barrier(0)
__device__ __forceinline__ int crow(int r, int hi) { return (r & 3) + 8 * (r >> 2) + 4 * hi; }
__device__ __forceinline__ unsigned cvtpk(float lo, float hi) { unsigned r; asm volatile("v_cvt_pk_bf16_f32 %0, %1, %2" : "=v"(r) : "v"(lo), "v"(hi)); return r; }
template <int DQK> struct Cfg { static constexpr float SCALE = (DQK == 128) ? 0.08838834764831845f : 0.07216878364870323f; };

template <int DQK>
__device__ __forceinline__ void partialSM(f32x16& p0, f32x16& p1, float& m_reg, float& mn, float& alpha) {
  constexpr float SCALE = Cfg<DQK>::SCALE, C = SCALE * 1.4426950408889634f;
  float pmax = p0[0];
#pragma unroll
  for (int r = 1; r < 16; ++r) pmax = fmaxf(pmax, p0[r]);
#pragma unroll
  for (int r = 0; r < 16; ++r) pmax = fmaxf(pmax, p1[r]);
  { auto rr = __builtin_amdgcn_permlane32_swap(__float_as_uint(pmax), __float_as_uint(pmax), false, false);
    pmax = fmaxf(__uint_as_float(rr[0]), __uint_as_float(rr[1])); }
  if (__builtin_expect(__all(pmax - m_reg <= THR / SCALE), 1)) { mn = m_reg; alpha = 1.f; }
  else { mn = fmaxf(m_reg, pmax); alpha = __builtin_amdgcn_exp2f((m_reg - mn) * C); m_reg = mn; }
  const float mnC = -mn * C;
#pragma unroll
  for (int r = 0; r < 16; ++r) p0[r] = fmaf(p0[r], C, mnC);
#pragma unroll
  for (int r = 0; r < 16; ++r) p1[r] = fmaf(p1[r], C, mnC);
#pragma unroll
  for (int r = 0; r < 16; ++r) p0[r] = __builtin_amdgcn_exp2f(p0[r]);
}
__device__ __forceinline__ void finishSM(f32x16& p0, f32x16& p1, float alpha, float& l_reg, bf16x8& pa0, bf16x8& pa1, bf16x8& pa2, bf16x8& pa3) {
#pragma unroll
  for (int r = 0; r < 16; ++r) p1[r] = __builtin_amdgcn_exp2f(p1[r]);
  float ps = 0;
#pragma unroll
  for (int r = 0; r < 16; ++r) ps += p0[r];
#pragma unroll
  for (int r = 0; r < 16; ++r) ps += p1[r];
  { auto rr = __builtin_amdgcn_permlane32_swap(__float_as_uint(ps), __float_as_uint(ps), false, false);
    ps = __uint_as_float(rr[0]) + __uint_as_float(rr[1]); }
  l_reg = l_reg * alpha + ps;
#define PK4(P, BASE, OUT) do { unsigned a0 = cvtpk(P[BASE + 0], P[BASE + 1]), a1 = cvtpk(P[BASE + 2], P[BASE + 3]);   \
    unsigned b0 = cvtpk(P[BASE + 4], P[BASE + 5]), b1 = cvtpk(P[BASE + 6], P[BASE + 7]);                              \
    auto r0 = __builtin_amdgcn_permlane32_swap(a0, b0, false, false); auto r1 = __builtin_amdgcn_permlane32_swap(a1, b1, false, false); \
    u32x4 w = {r0[0], r1[0], r0[1], r1[1]}; OUT = *reinterpret_cast<bf16x8*>(&w); } while (0)
  PK4(p0, 0, pa0); PK4(p0, 8, pa1); PK4(p1, 0, pa2); PK4(p1, 8, pa3);
#undef PK4
}
template <int DQK>
__device__ __forceinline__ void qkt(f32x16& p0, f32x16& p1, const char* Ks, const char* Krs, const bf16x8* qr, const char* qrl, int r32, int hi) {
  p0 = f32x16{}; p1 = f32x16{};
#pragma unroll
  for (int d0 = 0; d0 < 8; ++d0) { const int cb = (d0 * 16 + hi * 8) * 2;
    const bf16x8 b0 = *reinterpret_cast<const bf16x8*>(Ks + KSWZ(r32, cb));
    const bf16x8 b1 = *reinterpret_cast<const bf16x8*>(Ks + KSWZ(32 + r32, cb));
    p0 = __builtin_amdgcn_mfma_f32_32x32x16_bf16(b0, qr[d0], p0, 0, 0, 0);
    p1 = __builtin_amdgcn_mfma_f32_32x32x16_bf16(b1, qr[d0], p1, 0, 0, 0); }
  if constexpr (DQK == 192) {
#pragma unroll
    for (int d0 = 0; d0 < 4; ++d0) { const int cb = (d0 * 16 + hi * 8) * 2;
      const bf16x8 b0 = *reinterpret_cast<const bf16x8*>(Krs + KRSWZ(r32, cb));
      const bf16x8 b1 = *reinterpret_cast<const bf16x8*>(Krs + KRSWZ(32 + r32, cb));
      const bf16x8 qv = *reinterpret_cast<const bf16x8*>(qrl + d0 * 1024);
      p0 = __builtin_amdgcn_mfma_f32_32x32x16_bf16(b0, qv, p0, 0, 0, 0);
      p1 = __builtin_amdgcn_mfma_f32_32x32x16_bf16(b1, qv, p1, 0, 0, 0); }
  }
}
__device__ __forceinline__ void wmask(f32x16& p0, f32x16& p1, int dbase, int hi) {
#pragma unroll
  for (int r = 0; r < 16; ++r) { const int d0 = dbase + (r & 3) + 8 * (r >> 2) + 4 * hi, d1 = d0 + 32;
    if (d0 > 128 || d0 < -128) p0[r] = -1e30f;
    if (d1 > 128 || d1 < -128) p1[r] = -1e30f; }
}
__device__ __forceinline__ int v_st(int k, int c) { const int kk = (k & ~0xC) | ((k & 4) << 1) | ((k & 8) >> 1); return ((kk >> 3) * 4 + (c >> 5)) * 512 + ((kk & 7) * 32 + (c & 31)) * 2; }
__device__ __forceinline__ int v_rd_base(int lane) { return ((lane & 3) << 3) | (((lane >> 2) & 3) << 6) | (((lane >> 4) & 1) << 5) | (((lane >> 5) & 1) << 8); }
constexpr int v_rd_off(int d0, int ks, int half) { return d0 * 512 + ks * 4096 + half * 2048; }
template <int OFF> __device__ __forceinline__ s16x4 tr_read(int vb) {
  s16x4 r; asm volatile("ds_read_b64_tr_b16 %0, %1 offset:%2" : "=&v"(r) : "v"(vb), "i"(OFF) : "memory"); return r;
}
template <int D0> __device__ __forceinline__ void pv_one(f32x16& od, int vb, bf16x8 pa0, bf16x8 pa1, bf16x8 pa2, bf16x8 pa3) {
  const s16x4 l0 = tr_read<v_rd_off(D0, 0, 0)>(vb), h0 = tr_read<v_rd_off(D0, 0, 1)>(vb), l1 = tr_read<v_rd_off(D0, 1, 0)>(vb), h1 = tr_read<v_rd_off(D0, 1, 1)>(vb);
  const s16x4 l2 = tr_read<v_rd_off(D0, 2, 0)>(vb), h2 = tr_read<v_rd_off(D0, 2, 1)>(vb), l3 = tr_read<v_rd_off(D0, 3, 0)>(vb), h3 = tr_read<v_rd_off(D0, 3, 1)>(vb);
  asm volatile("s_waitcnt lgkmcnt(0)" ::: "memory"); SBAR();
#define PK(L, H) (bf16x8){L[0], L[1], L[2], L[3], H[0], H[1], H[2], H[3]}
  od = __builtin_amdgcn_mfma_f32_32x32x16_bf16(pa0, PK(l0, h0), od, 0, 0, 0);
  od = __builtin_amdgcn_mfma_f32_32x32x16_bf16(pa1, PK(l1, h1), od, 0, 0, 0);
  od = __builtin_amdgcn_mfma_f32_32x32x16_bf16(pa2, PK(l2, h2), od, 0, 0, 0);
  od = __builtin_amdgcn_mfma_f32_32x32x16_bf16(pa3, PK(l3, h3), od, 0, 0, 0);
#undef PK
}
__device__ __forceinline__ void pv_d0(f32x16* o, int vb, bf16x8 pa0, bf16x8 pa1, bf16x8 pa2, bf16x8 pa3) {
  pv_one<0>(o[0], vb, pa0, pa1, pa2, pa3); pv_one<1>(o[1], vb, pa0, pa1, pa2, pa3); pv_one<2>(o[2], vb, pa0, pa1, pa2, pa3); pv_one<3>(o[3], vb, pa0, pa1, pa2, pa3);
}

template <int DQK, int LDQ, int LDK, int LDV, int LDO, int SDEPTH>
__device__ __forceinline__ void attn_unit(const bf16_t* __restrict__ Qb, const bf16_t* __restrict__ Kh, const bf16_t* __restrict__ Krp, const bf16_t* __restrict__ Vh,
                                          bf16_t* __restrict__ Ob, const int NT, const int base1, const int wmode, const int qpos0, const float m_init, const float l_init, char* lds) {
  constexpr int NQ = 8;
  int tid_ = threadIdx.x; asm volatile("" : "+v"(tid_));
  const int tid = tid_, wid = tid >> 6, lane = tid & 63, r32 = lane & 31, hi = lane >> 5;
  char* V_lds = lds + OFF_V; char* K_lds = lds + OFF_K; char* KR_lds = lds + OFF_KR;
  float* ws = (float*)(lds + OFF_WS) + wid * 64; float* li_l = ws; float* al_l = ws + 32;
  float m_reg = m_init, l_reg = l_init; f32x16 o[4] = {}; bf16x8 qr[NQ];
  const bf16_t* Qw = Qb + (long)(wid * QBLK + r32) * LDQ + hi * 8;
#pragma unroll
  for (int d0 = 0; d0 < NQ; ++d0) qr[d0] = *reinterpret_cast<const bf16x8*>(Qw + d0 * 16);
  char* qrl = lds + OFF_QR + wid * 4096 + lane * 16;
  if constexpr (DQK == 192) {
#pragma unroll
    for (int d0 = 0; d0 < 4; ++d0) *reinterpret_cast<bf16x8*>(qrl + d0 * 1024) = *reinterpret_cast<const bf16x8*>(Qw + 128 + d0 * 16);
  }
  const int sr = tid >> 4, sc = (tid & 15) * 8, vst0 = v_st(sr, sc), vst1 = v_st(32 + sr, sc);
  const int krr = tid >> 3, krc = (tid & 7) * 8;
  const int vb0 = (int)(uintptr_t)V_lds + v_rd_base(lane);
  const int dq = -(qpos0 + wid * QBLK + r32) - 256;
  struct { bf16x8 vs0, vs1, ks0, ks1, kr; } sr_[SDEPTH];
#define KROW(j) ((j) < 4 ? (j) * 64 : base1 + ((j) - 4) * 64)
#define SLOAD(i, k0) do { const int k0_ = (k0); sr_[i].vs0 = *reinterpret_cast<const bf16x8*>(&Vh[(long)(k0_ + sr) * LDV + sc]); sr_[i].vs1 = *reinterpret_cast<const bf16x8*>(&Vh[(long)(k0_ + 32 + sr) * LDV + sc]); \
    sr_[i].ks0 = *reinterpret_cast<const bf16x8*>(&Kh[(long)(k0_ + sr) * LDK + sc]); sr_[i].ks1 = *reinterpret_cast<const bf16x8*>(&Kh[(long)(k0_ + 32 + sr) * LDK + sc]); \
    if constexpr (DQK == 192) sr_[i].kr = *reinterpret_cast<const bf16x8*>(&Krp[(long)(k0_ + krr) * 64 + krc]); } while (0)
#define SWRITE(b, i) do { *(bf16x8*)(V_lds + (b) * SHM_V + vst0) = sr_[i].vs0; *(bf16x8*)(V_lds + (b) * SHM_V + vst1) = sr_[i].vs1; const int kc = sc * 2; \
    *(bf16x8*)(K_lds + (b) * SHM_K + KSWZ(sr, kc)) = sr_[i].ks0; *(bf16x8*)(K_lds + (b) * SHM_K + KSWZ(32 + sr, kc)) = sr_[i].ks1; \
    if constexpr (DQK == 192) *(bf16x8*)(KR_lds + (b) * SHM_KR + KRSWZ(krr, krc * 2)) = sr_[i].kr; } while (0)
#define SWAIT() do { if constexpr (SDEPTH == 1) asm volatile("s_waitcnt vmcnt(0)" ::: "memory"); else if constexpr (DQK == 192) asm volatile("s_waitcnt vmcnt(5)" ::: "memory"); else asm volatile("s_waitcnt vmcnt(4)" ::: "memory"); } while (0)
#define RESC(a) do { if (__any((a) < 1.f)) { if (hi == 0) al_l[r32] = (a); asm volatile("s_waitcnt lgkmcnt(0)" ::: "memory"); \
    _Pragma("unroll") for (int d = 0; d < 4; ++d) _Pragma("unroll") for (int r = 0; r < 16; ++r) o[d][r] *= al_l[crow(r, hi)]; } } while (0)
#define MASK(P0, P1, j) do { if (wmode && (j) >= 4) wmask(P0, P1, KROW(j) + dq, hi); } while (0)
  f32x16 pA0, pA1, pB0, pB1; float mnA, mnB, alA, alB; bf16x8 pa0, pa1, pa2, pa3;
  constexpr int SE = 0, SO = SDEPTH - 1;
  SLOAD(SE, 0); asm volatile("s_waitcnt vmcnt(0)" ::: "memory"); SWRITE(0, SE); __syncthreads();
  qkt<DQK>(pA0, pA1, K_lds, KR_lds, qr, qrl, r32, hi); partialSM<DQK>(pA0, pA1, m_reg, mnA, alA);
  SLOAD(SO, KROW(1)); if constexpr (SDEPTH == 2) { if (2 < NT) SLOAD(SE, KROW(2)); }
  SWAIT(); SWRITE(1, SO); __syncthreads();
  for (int j = 1; j + 1 < NT; j += 2) {
    SBAR(); qkt<DQK>(pB0, pB1, K_lds + SHM_K, KR_lds + SHM_KR, qr, qrl, r32, hi); MASK(pB0, pB1, j);
    finishSM(pA0, pA1, alA, l_reg, pa0, pa1, pa2, pa3); SBAR();
    SLOAD(SO, KROW(j + SDEPTH)); SBAR();
    pv_d0(o, vb0, pa0, pa1, pa2, pa3); partialSM<DQK>(pB0, pB1, m_reg, mnB, alB);
    __syncthreads(); SWAIT(); SWRITE(0, SE);
    RESC(alB); __syncthreads();
    SBAR(); qkt<DQK>(pA0, pA1, K_lds, KR_lds, qr, qrl, r32, hi); MASK(pA0, pA1, j + 1);
    finishSM(pB0, pB1, alB, l_reg, pa0, pa1, pa2, pa3); SBAR();
    if (SDEPTH == 1 || j + 3 < NT) SLOAD(SE, KROW(j + 1 + SDEPTH)); SBAR();
    pv_d0(o, vb0 + SHM_V, pa0, pa1, pa2, pa3); partialSM<DQK>(pA0, pA1, m_reg, mnA, alA);
    __syncthreads(); SWAIT(); SWRITE(1, SO);
    RESC(alA); __syncthreads();
  }
  SBAR(); qkt<DQK>(pB0, pB1, K_lds + SHM_K, KR_lds + SHM_KR, qr, qrl, r32, hi); MASK(pB0, pB1, NT - 1);
  finishSM(pA0, pA1, alA, l_reg, pa0, pa1, pa2, pa3); SBAR();
  pv_d0(o, vb0, pa0, pa1, pa2, pa3); partialSM<DQK>(pB0, pB1, m_reg, mnB, alB);
  __syncthreads(); RESC(alB);
  finishSM(pB0, pB1, alB, l_reg, pa0, pa1, pa2, pa3); SBAR();
  pv_d0(o, vb0 + SHM_V, pa0, pa1, pa2, pa3);
  if (hi == 0) li_l[r32] = l_reg; asm volatile("s_waitcnt lgkmcnt(0)" ::: "memory");
  float rli[16];
#pragma unroll
  for (int r = 0; r < 16; ++r) rli[r] = __builtin_amdgcn_rcpf(li_l[crow(r, hi)]);
  __syncthreads();
  { bf16_t* stg = (bf16_t*)(lds + wid * 8192);
#pragma unroll
    for (int r = 0; r < 16; r += 2) { const int orow = crow(r, hi);
#pragma unroll
      for (int d0 = 0; d0 < 4; ++d0) { const unsigned pk = cvtpk(o[d0][r] * rli[r], o[d0][r + 1] * rli[r + 1]);
        stg[orow * 128 + d0 * 32 + r32] = (bf16_t)(pk & 0xffffu); stg[(orow + 1) * 128 + d0 * 32 + r32] = (bf16_t)(pk >> 16); } }
    asm volatile("s_waitcnt lgkmcnt(0)" ::: "memory");
    bf16_t* Ow = Ob + (long)(wid * QBLK) * LDO;
#pragma unroll
    for (int i = 0; i < 8; ++i) { const int ch = i * 64 + lane, row = ch >> 4, c8 = (ch & 15) * 8;
      const u32x4 v = *(const u32x4*)(stg + row * 128 + c8); *(u32x4*)(Ow + (long)row * LDO + c8) = v; }
  }
  __syncthreads();
#undef KROW
#undef SLOAD
#undef SWRITE
#undef SWAIT
#undef RESC
#undef MASK
}
#undef KSWZ
#undef KRSWZ
#undef SBAR
}

constexpr int NWAVES = 8;
constexpr size_t MiB = 1u << 20;
constexpr size_t WS_CTL = 0, CTL_ZERO_BYTES = 2 * MiB;
constexpr size_t WS_MOD = 1 * MiB;
constexpr size_t WS_TBL = 2 * MiB;
constexpr size_t SZ_WGU = (size_t)2 * DFF * DM * 2, SZ_WDN = (size_t)DM * DFF * 2;
constexpr size_t WS_WGU = 4 * MiB;
constexpr size_t WS_WDN = WS_WGU + 8 * SZ_WGU;
constexpr size_t SZ_WINAB = (size_t)AB_IN * DM * 2, SZ_WSQ = (size_t)DM * DM * 2, SZ_WINC = (size_t)C_IN_PAD * DM * 2, SZ_WUQ = (size_t)MLA_QOUT * QRANK * 2, SZ_WUKV = (size_t)MLA_KVOUT * KVRANK * 2;
constexpr size_t WS_WINAB = WS_WDN + 8 * SZ_WDN;
constexpr size_t WS_WOUTAB = WS_WINAB + 2 * SZ_WINAB;
constexpr size_t WS_WINC = WS_WOUTAB + 2 * SZ_WSQ;
constexpr size_t WS_WUQ = WS_WINC + 2 * SZ_WINC;
constexpr size_t WS_WUKV = WS_WUQ + 2 * SZ_WUQ;
constexpr size_t WS_WOUTC = WS_WUKV + 2 * SZ_WUKV;
constexpr size_t WS_X = WS_WOUTC + 2 * SZ_WSQ;
constexpr size_t WS_XN = WS_X + (size_t)MROWS * DM * 4;
constexpr size_t WS_H = WS_XN + (size_t)MROWS * DM * 2;
constexpr size_t WS_QKV = WS_H + (size_t)MROWS * DFF * 2;
constexpr size_t WS_KV = WS_QKV + (size_t)MROWS * 3072 * 2;
constexpr size_t WS_CQ = WS_KV + (size_t)MROWS * 4096 * 2;
constexpr size_t WS_CQN = WS_CQ + (size_t)MROWS * 1024 * 2;
constexpr size_t WS_CKVN = WS_CQN + (size_t)MROWS * 512 * 2;
constexpr size_t WS_KR = WS_CKVN + (size_t)MROWS * 256 * 2;
constexpr size_t WS_O = WS_KR + (size_t)MROWS * 64 * 2;
constexpr size_t WS_END = WS_O + (size_t)MROWS * DM * 2;
static_assert(WS_WGU % 256 == 0 && WS_X % 256 == 0 && WS_O % 256 == 0, "alignment");
constexpr int T_HRC = 0, T_HRS = 4096, T_HCC = 8192, T_HCS = 10240, T_MRC = 12288, T_MRS = 14336, T_MCC = 16384, T_MCS = 17408, T_END = 18432;
constexpr int CW_BAR = 4096;
constexpr int RING_OFF = 0, RING_BYTES = 131072, LDSCTL_OFF = RING_BYTES, MISC_OFF = LDSCTL_OFF + 320, LDS_BYTES = 147456;

#define GAS __attribute__((address_space(1)))
#define LAS __attribute__((address_space(3)))
typedef unsigned short bf16;
typedef unsigned v4u __attribute__((ext_vector_type(4)));
typedef unsigned v2u __attribute__((ext_vector_type(2)));
typedef float f32x4 __attribute__((ext_vector_type(4)));
typedef GAS unsigned gu32;
#define RLX_AGENT __ATOMIC_RELAXED, __HIP_MEMORY_SCOPE_AGENT
#define LDS_WAIT() asm volatile("s_waitcnt lgkmcnt(0)" ::: "memory")
__device__ __forceinline__ unsigned f2bf(float f) { unsigned u = __builtin_bit_cast(unsigned, f); return (u + 0x7fffu + ((u >> 16) & 1u)) >> 16; }
__device__ __forceinline__ unsigned pk2(float lo, float hi) { return f2bf(lo) | (f2bf(hi) << 16); }
__device__ __forceinline__ float bf2f(unsigned short h) { return __builtin_bit_cast(float, (unsigned)h << 16); }
__device__ __forceinline__ float bflo(unsigned w) { return __builtin_bit_cast(float, w << 16); }
__device__ __forceinline__ float bfhi(unsigned w) { return __builtin_bit_cast(float, w & 0xffff0000u); }
__device__ __forceinline__ float wave_sum(float v) {
#pragma unroll
    for (int o = 1; o < 64; o <<= 1) v += __shfl_xor(v, o);
    return v;
}

#define XB_TMO      128
#define XB_XCNT(j)  (256  + 64 * (j))
#define XB_XSUB(j)  (1280 + 64 * (j))
#define XB_XGEN(j)  (2304 + 64 * (j))
#define XB_TOP      3328
#define XB_TOPGEN   3392
#define XCD_BAR_WORDS 3456
#define XB_SPIN_CAP (1u << 18)

__device__ __forceinline__ unsigned xb_ld(unsigned* p)              { return __hip_atomic_load(p, __ATOMIC_RELAXED, __HIP_MEMORY_SCOPE_AGENT); }
__device__ __forceinline__ unsigned xb_add(unsigned* p, unsigned v) { return __hip_atomic_fetch_add(p, v, __ATOMIC_RELAXED, __HIP_MEMORY_SCOPE_AGENT); }
__device__ __forceinline__ unsigned xb_xcc_id() { return (unsigned)__builtin_amdgcn_s_getreg((3 << 11) | 20) & 0xFu; }
#define XB_SPIN(cond, bar) do { unsigned _sp = 0; while (cond) { __builtin_amdgcn_s_sleep(1); \
    if ((++_sp & 255u) == 0u) { if (xb_ld(&(bar)[XB_TMO])) break; if (_sp > XB_SPIN_CAP) { atomicAdd(&(bar)[XB_TMO], 1u); break; } } } } while (0)

struct XcdBarrier {
    unsigned* bar; unsigned x;
    volatile LAS unsigned* st;
};

__device__ __forceinline__ XcdBarrier xcd_barrier_post(unsigned* bar, volatile LAS unsigned* st) {
    XcdBarrier b; b.bar = bar; b.x = xb_xcc_id(); b.st = st;
    if (threadIdx.x == 0) (void)xb_add(&bar[XB_XCNT(b.x)], 1u);
    return b;
}
__device__ __forceinline__ void xcd_barrier_complete(unsigned* bar, unsigned x, unsigned& nloc, unsigned& nx) {
    const unsigned G = gridDim.x * gridDim.y * gridDim.z;
    unsigned sum, cnt, mine, sp = 0u;
    for (;;) {
        sum = 0u; cnt = 0u; mine = 0u;
#pragma unroll
        for (unsigned j = 0; j < 16; ++j) { const unsigned c = xb_ld(&bar[XB_XCNT(j)]); sum += c; cnt += (c > 0u) ? 1u : 0u; mine = (j == x) ? c : mine; }
        if (sum == G) break;
        __builtin_amdgcn_s_sleep(1);
        if ((++sp & 255u) == 0u) { if (xb_ld(&bar[XB_TMO])) break; if (sp > XB_SPIN_CAP) { atomicAdd(&bar[XB_TMO], 1u); break; } }
    }
    nloc = mine > 0u ? mine : 1u; nx = cnt > 0u ? cnt : 1u;
}

__device__ __forceinline__ void xcd_barrier(const XcdBarrier& b) {
    asm volatile("s_waitcnt vmcnt(0)" ::: "memory");
    __syncthreads();
    if (threadIdx.x == 0) {
        unsigned* bar = b.bar;
        __builtin_amdgcn_s_waitcnt(0);
        unsigned nloc = b.st[0], nx = b.st[1];
        if (nloc == 0u) { xcd_barrier_complete(bar, b.x, nloc, nx); b.st[0] = nloc; b.st[1] = nx; }
        const unsigned old = xb_add(&bar[XB_XSUB(b.x)], 1u);
        const unsigned gen = old / nloc;
        if (old + 1u == (gen + 1u) * nloc) {
            __builtin_amdgcn_fence(__ATOMIC_RELEASE, "agent");
            asm volatile("s_waitcnt vmcnt(0)" ::: "memory");
            const unsigned og = xb_add(&bar[XB_TOP], 1u);
            const unsigned tg = og / nx;
            if (og + 1u == (tg + 1u) * nx) xb_add(&bar[XB_TOPGEN], 1u);
            else XB_SPIN(xb_ld(&bar[XB_TOPGEN]) == tg, bar);
            __builtin_amdgcn_fence(__ATOMIC_ACQUIRE, "agent");
            xb_add(&bar[XB_XGEN(b.x)], 1u);
            asm volatile("s_waitcnt vmcnt(0)" ::: "memory");
        } else {
            XB_SPIN(xb_ld(&bar[XB_XGEN(b.x)]) == gen, bar);
            __builtin_amdgcn_fence(__ATOMIC_ACQUIRE, "agent");
            asm volatile("s_waitcnt vmcnt(0)" ::: "memory");
        }
    }
    __syncthreads();
}
__device__ __forceinline__ void p0_mod(const float* __restrict__ c, const float* __restrict__ cctx, const float* __restrict__ wmod, float* PART,
                                       LAS unsigned char* lds, int tid, int wave, int lane) {
    LAS float* sv = (LAS float*)lds;
    LAS float* red = (LAS float*)(lds + 24576);
    for (int i = tid; i < 3 * 2048; i += 512) { const int v = i >> 11, k = i & 2047; const float x = v < 2 ? c[v * 2048 + k] : cctx[k]; sv[i] = x / (1.0f + expf(-x)); }
    __syncthreads();
    for (int t = blockIdx.x; t < 2304; t += gridDim.x) {
        const int l = t / 576, rem = t - l * 576, nch = rem >> 3, kch = rem & 7;
        const int k0 = kch * 256 + wave * 32;
        const float* W = wmod + ((size_t)l * 2048 + k0) * 18432 + nch * 256 + lane * 4;
        f32x4 a0 = {0.f, 0.f, 0.f, 0.f}, a1 = a0, a2 = a0;
#pragma unroll 8
        for (int kk = 0; kk < 32; ++kk) { const f32x4 w = *(const f32x4*)(W + (size_t)kk * 18432);
            a0 += sv[k0 + kk] * w; a1 += sv[2048 + k0 + kk] * w; a2 += sv[4096 + k0 + kk] * w; }
#pragma unroll
        for (int j = 0; j < 4; ++j) { red[(wave * 12 + j) * 64 + lane] = a0[j]; red[(wave * 12 + 4 + j) * 64 + lane] = a1[j]; red[(wave * 12 + 8 + j) * 64 + lane] = a2[j]; }
        __syncthreads();
        for (int idx = tid; idx < 768; idx += 512) { const int v = idx >> 8, cc = idx & 255, ln = cc >> 2, j = cc & 3; float s = 0.f;
#pragma unroll
            for (int w = 0; w < 8; ++w) s += red[(w * 12 + v * 4 + j) * 64 + ln];
            PART[(size_t)((l * 8 + kch) * 3 + v) * 18432 + nch * 256 + cc] = s; }
        __syncthreads();
    }
}
__device__ __forceinline__ void p0_mod_sum(const float* PART, const float* __restrict__ bmod, float* MOD, int gtid, int NT_) {
    for (int i = gtid; i < DEPTH * 3 * 18432; i += NT_) { const int l = i / (3 * 18432), r = i - l * 3 * 18432, v = r / 18432, n = r - v * 18432;
        float s = bmod[(size_t)l * 18432 + n];
#pragma unroll
        for (int k = 0; k < 8; ++k) s += PART[(size_t)((l * 8 + k) * 3 + v) * 18432 + n];
        MOD[i] = s; }
}
template <int MAP>
__device__ __forceinline__ void p0_transpose_item(const float* __restrict__ W, int K, int N, bf16* WT, LAS float* scr, int item, int lane) {
    const int nblk = N / 32, kb = item / nblk, nb = item - kb * nblk, k0 = 64 * kb, n0 = 32 * nb;
#pragma unroll 8
    for (int i = 0; i < 32; ++i) { const int kk = 2 * i + (lane >> 5); scr[kk * 33 + (lane & 31)] = W[(size_t)(k0 + kk) * N + n0 + (lane & 31)]; }
    LDS_WAIT(); asm volatile("" ::: "memory");
    int r0 = n0;
    if (MAP == 1) { r0 = n0 < DFF ? (n0 / 128) * 256 + (n0 % 128) : ((n0 - DFF) / 128) * 256 + 128 + ((n0 - DFF) % 128); }
    const int c = lane & 7;
#pragma unroll
    for (int j = 0; j < 4; ++j) { const int n = (lane >> 3) + 8 * j; const LAS float* s = scr + (8 * c) * 33 + n;
        v4u o; o.x = pk2(s[0 * 33], s[1 * 33]); o.y = pk2(s[2 * 33], s[3 * 33]); o.z = pk2(s[4 * 33], s[5 * 33]); o.w = pk2(s[6 * 33], s[7 * 33]);
        *(GAS v4u*)(WT + (size_t)(r0 + n) * K + k0 + 8 * c) = o; }
    LDS_WAIT(); asm volatile("" ::: "memory");
}
__device__ __forceinline__ double my_exp(double y) {
    const double t = y * (1.0 / 1024.0); double e = 1.0, term = 1.0;
#pragma unroll
    for (int i = 1; i <= 10; ++i) { term *= t * (1.0 / i); e += term; }
#pragma unroll
    for (int i = 0; i < 10; ++i) e *= e;
    return e;
}
__device__ __forceinline__ void my_sincos(double x, double& s, double& c) {
    const double k = __builtin_rint(x * 0.15915494309189535);
    const double r = (x - k * 6.283185307179586) - k * 2.4492935982947064e-16;
    const double r2 = r * r; double cs = 1.0, sn = r, tc = 1.0, ts = r;
#pragma unroll
    for (int i = 1; i <= 16; ++i) { tc *= -r2 * (1.0 / ((2.0 * i - 1.0) * (2.0 * i))); cs += tc; ts *= -r2 * (1.0 / ((2.0 * i) * (2.0 * i + 1.0))); sn += ts; }
    s = sn; c = cs;
}

__device__ __forceinline__ void norm_phase(const float* __restrict__ xin, const float* __restrict__ cin, float* X, bf16* XN, const float* __restrict__ g, const float* modl, int jmod, bool first,
                                           int gw, int NGW, int lane) {
    asm volatile("" : "+v"(lane));
    for (int row = gw; row < MROWS; row += NGW) {
        const int b = row >= RPB ? 1 : 0, rr = row - b * RPB; const bool isctx = rr < CTXL; const int v = isctx ? 2 : b;
        const float* src = first ? (isctx ? cin + (size_t)(b * CTXL + rr) * DM : xin + (size_t)(b * SEQ + rr - CTXL) * DM) : X + (size_t)row * DM;
        const f32x4* xr = (const f32x4*)src + lane;
        f32x4 x[8]; float ss = 0.f;
#pragma unroll
        for (int i = 0; i < 8; ++i) { x[i] = xr[64 * i]; ss += (x[i].x * x[i].x + x[i].y * x[i].y) + (x[i].z * x[i].z + x[i].w * x[i].w); }
        ss = wave_sum(ss);
        const float r = 1.0f / sqrtf(ss * (1.0f / DM) + EPS);
        const float* sh = modl + (size_t)(v * 9 + 3 * jmod) * DM; const float* sc = sh + DM;
        bf16* orow = XN + (size_t)row * DM;
#pragma unroll
        for (int i = 0; i < 8; ++i) { const int col = 4 * (lane + 64 * i);
            const f32x4 gg = *(const f32x4*)(g + col), s1 = *(const f32x4*)(sc + col), s0 = *(const f32x4*)(sh + col);
            const f32x4 y = x[i] * r * gg * (1.0f + s1) + s0;
            v2u o; o.x = pk2(y.x, y.y); o.y = pk2(y.z, y.w); *(v2u*)(orow + col) = o; }
        if (first) { f32x4* xo = (f32x4*)(X + (size_t)row * DM) + lane;
#pragma unroll
            for (int i = 0; i < 8; ++i) xo[64 * i] = x[i]; }
    }
}
__device__ __forceinline__ void final_phase(const float* X, float* out, const float* __restrict__ g, int gw, int NGW, int lane) {
    asm volatile("" : "+v"(lane));
    for (int r0 = gw; r0 < NB * SEQ; r0 += NGW) {
        const int b = r0 >= SEQ ? 1 : 0, t = r0 - b * SEQ; const size_t row = (size_t)b * RPB + CTXL + t;
        const f32x4* xr = (const f32x4*)(X + row * DM) + lane;
        f32x4 x[8]; float ss = 0.f;
#pragma unroll
        for (int i = 0; i < 8; ++i) { x[i] = xr[64 * i]; ss += (x[i].x * x[i].x + x[i].y * x[i].y) + (x[i].z * x[i].z + x[i].w * x[i].w); }
        ss = wave_sum(ss);
        const float r = 1.0f / sqrtf(ss * (1.0f / DM) + EPS);
        f32x4* o = (f32x4*)(out + (size_t)r0 * DM) + lane;
#pragma unroll
        for (int i = 0; i < 8; ++i) { const f32x4 gg = *(const f32x4*)(g + 4 * (lane + 64 * i)); o[64 * i] = x[i] * r * gg; }
    }
}
__device__ __forceinline__ void pass_ab(bf16* QKV, const float* __restrict__ gq, const float* __restrict__ gk, const float* tbl, int gw, int NGW, int lane) {
    asm volatile("" : "+v"(lane));
    const int a = lane >> 5, f = lane & 31;
    const float gq1 = gq[a * 64 + f], gq2 = gq[a * 64 + 32 + f], gk1 = gk[a * 64 + f], gk2 = gk[a * 64 + 32 + f];
    for (int row = gw; row < MROWS; row += NGW) {
        const int b = row >= RPB ? 1 : 0, rr = row - b * RPB; const bool isctx = rr < CTXL; const int t = rr - CTXL;
        float cs = 1.f, sn = 0.f;
        if (!isctx) { const int pos = a == 0 ? (t >> 6) : (t & 63); cs = tbl[(a == 0 ? T_HRC : T_HCC) + pos * 32 + f]; sn = tbl[(a == 0 ? T_HRS : T_HCS) + pos * 32 + f]; }
        bf16* rowp = QKV + (size_t)row * AB_IN + a * 64 + f;
#pragma unroll
        for (int hd = 0; hd < 22; ++hd) {
            if (hd == 10 || hd == 11) continue;
            float x1 = bf2f(rowp[hd * 128]), x2 = bf2f(rowp[hd * 128 + 32]);
            if (hd < 10) { const float ss = wave_sum(x1 * x1 + x2 * x2); const float r = 1.0f / sqrtf(ss * (1.0f / 128.0f) + EPS);
                x1 *= r * (hd < 8 ? gq1 : gk1); x2 *= r * (hd < 8 ? gq2 : gk2); }
            const float y1 = x1 * cs - x2 * sn, y2 = x2 * cs + x1 * sn;
            rowp[hd * 128] = (bf16)f2bf(y1); rowp[hd * 128 + 32] = (bf16)f2bf(y2);
        }
    }
}
__device__ __forceinline__ void pass_mla1(const bf16* CQ, bf16* CQN, bf16* CKVN, bf16* KR, const float* __restrict__ gcq, const float* __restrict__ gckv, const float* tbl, int gw, int NGW, int lane) {
    asm volatile("" : "+v"(lane));
    for (int row = gw; row < MROWS; row += NGW) {
        const int b = row >= RPB ? 1 : 0, rr = row - b * RPB; const bool isctx = rr < CTXL; const int t = rr - CTXL;
        const bf16* rp = CQ + (size_t)row * C_IN_PAD;
        { const v4u w = *(const v4u*)(rp + lane * 8);
          float x[8] = {bflo(w.x), bfhi(w.x), bflo(w.y), bfhi(w.y), bflo(w.z), bfhi(w.z), bflo(w.w), bfhi(w.w)};
          float ss = 0.f;
#pragma unroll
          for (int i = 0; i < 8; ++i) ss += x[i] * x[i];
          ss = wave_sum(ss); const float r = 1.0f / sqrtf(ss * (1.0f / QRANK) + EPS);
          const f32x4 g0 = *(const f32x4*)(gcq + lane * 8), g1 = *(const f32x4*)(gcq + lane * 8 + 4);
          v4u o; o.x = pk2(x[0] * r * g0.x, x[1] * r * g0.y); o.y = pk2(x[2] * r * g0.z, x[3] * r * g0.w); o.z = pk2(x[4] * r * g1.x, x[5] * r * g1.y); o.w = pk2(x[6] * r * g1.z, x[7] * r * g1.w);
          *(v4u*)(CQN + (size_t)row * QRANK + lane * 8) = o; }
        { const v2u w = *(const v2u*)(rp + 512 + lane * 4);
          float x[4] = {bflo(w.x), bfhi(w.x), bflo(w.y), bfhi(w.y)};
          float ss = (x[0] * x[0] + x[1] * x[1]) + (x[2] * x[2] + x[3] * x[3]);
          ss = wave_sum(ss); const float r = 1.0f / sqrtf(ss * (1.0f / KVRANK) + EPS);
          const f32x4 g0 = *(const f32x4*)(gckv + lane * 4);
          v2u o; o.x = pk2(x[0] * r * g0.x, x[1] * r * g0.y); o.y = pk2(x[2] * r * g0.z, x[3] * r * g0.w);
          *(v2u*)(CKVN + (size_t)row * KVRANK + lane * 4) = o; }
        if (lane < 32) { const int a = lane >> 4, f = lane & 15;
          const float x1 = bf2f(rp[768 + a * 32 + f]), x2 = bf2f(rp[768 + a * 32 + 16 + f]);
          float cs = 1.f, sn = 0.f;
          if (!isctx) { const int pos = a == 0 ? (t >> 6) : (t & 63); cs = tbl[(a == 0 ? T_MRC : T_MCC) + pos * 16 + f]; sn = tbl[(a == 0 ? T_MRS : T_MCS) + pos * 16 + f]; }
          bf16* kr = KR + (size_t)row * 64 + a * 32 + f;
          kr[0] = (bf16)f2bf(x1 * cs - x2 * sn); kr[16] = (bf16)f2bf(x2 * cs + x1 * sn); }
    }
}
__device__ __forceinline__ void pass_mla2(bf16* Q, const float* tbl, int gw, int NGW, int lane) {
    asm volatile("" : "+v"(lane));
    for (int row = gw; row < MROWS; row += NGW) {
        const int b = row >= RPB ? 1 : 0, rr = row - b * RPB; if (rr < CTXL) continue; const int t = rr - CTXL;
        bf16* rp = Q + (size_t)row * MLA_QOUT;
#pragma unroll
        for (int it = 0; it < 8; ++it) { const int P = it * 64 + lane, h = P >> 5, p = P & 31, a = p >> 4, f = p & 15;
            const int pos = a == 0 ? (t >> 6) : (t & 63);
            const float cs = tbl[(a == 0 ? T_MRC : T_MCC) + pos * 16 + f], sn = tbl[(a == 0 ? T_MRS : T_MCS) + pos * 16 + f];
            bf16* q = rp + h * 192 + 128 + a * 32 + f;
            const float x1 = bf2f(q[0]), x2 = bf2f(q[16]);
            q[0] = (bf16)f2bf(x1 * cs - x2 * sn); q[16] = (bf16)f2bf(x2 * cs + x1 * sn); }
    }
}

struct Args { const float* in[21]; float* out; unsigned char* ws; };
#define INP(k) ({ int k_ = (k); asm volatile("" : "+s"(k_)); args.in[k_]; })
#define WSP(T, off) ({ size_t o_ = (off); asm volatile("" : "+s"(o_)); (T*)(args.ws + o_); })
#define MOD WSP(float, WS_MOD)
#define TBL WSP(float, WS_TBL)
#define WGU WSP(bf16, WS_WGU)
#define WDN WSP(bf16, WS_WDN)
#define WINAB WSP(bf16, WS_WINAB)
#define WOUTAB WSP(bf16, WS_WOUTAB)
#define WINC WSP(bf16, WS_WINC)
#define WUQ WSP(bf16, WS_WUQ)
#define WUKV WSP(bf16, WS_WUKV)
#define WOUTC WSP(bf16, WS_WOUTC)
#define X WSP(float, WS_X)
#define XN WSP(bf16, WS_XN)
#define H WSP(bf16, WS_H)
#define QKV WSP(bf16, WS_QKV)
#define KV WSP(bf16, WS_KV)
#define CQ WSP(bf16, WS_CQ)
#define CQN WSP(bf16, WS_CQN)
#define CKVN WSP(bf16, WS_CKVN)
#define KR WSP(bf16, WS_KR)
#define O WSP(bf16, WS_O)
__global__ void __launch_bounds__(NWAVES * 64, 2) fwd(Args args) {
    extern __shared__ __attribute__((aligned(16))) unsigned char lds[];
    LAS unsigned char* L = (LAS unsigned char*)lds;
    volatile LAS unsigned* MISC = (volatile LAS unsigned*)(L + MISC_OFF);
    const int tid = threadIdx.x, lane = tid & 63, wave = __builtin_amdgcn_readfirstlane(tid >> 6);
    const int G = gridDim.x, bx = blockIdx.x, vcu = (G % 8 == 0) ? (bx % 8) * (G / 8) + bx / 8 : bx;
    const int gw = vcu * NWAVES + wave, NGW = G * NWAVES;
    unsigned* ctl = (unsigned*)(args.ws + WS_CTL);
    for (int u = tid; u < (LDS_BYTES - LDSCTL_OFF) / 4; u += NWAVES * 64) ((LAS unsigned*)(L + LDSCTL_OFF))[u] = 0u;
    __syncthreads();
    (void)xcd_barrier_post((unsigned*)(ctl + CW_BAR), MISC + 8);
#define GRID_BAR() do { XcdBarrier bar_; bar_.bar = WSP(unsigned, WS_CTL) + CW_BAR; bar_.x = xb_xcc_id(); bar_.st = (volatile LAS unsigned*)(L + MISC_OFF) + 8; xcd_barrier(bar_); } while (0)

    {
        p0_mod(INP(1), INP(3), INP(4), WSP(float, WS_H), L, tid, wave, lane);
        LAS float* scr = (LAS float*)(L + RING_OFF + wave * 16384);
        constexpr int I_GU = 32 * 352, I_DN = 88 * 64, I_INAB = 32 * 96, I_SQ = 32 * 64, I_INC = 32 * 26, I_UQ = 8 * 96, I_UKV = 4 * 128;
        constexpr int NITEMS = 8 * I_GU + 8 * I_DN + 2 * (I_INAB + I_SQ + I_INC + I_UQ + I_UKV + I_SQ);
        for (int it = gw; it < NITEMS; it += NGW) {
            int r = it;
            if (r < 8 * I_GU) { const int m = r / I_GU; p0_transpose_item<1>(INP(7) + (size_t)m * DM * 2 * DFF, DM, 2 * DFF, WGU + (size_t)m * 2 * DFF * DM, scr, r - m * I_GU, lane); continue; } r -= 8 * I_GU;
            if (r < 8 * I_DN) { const int m = r / I_DN; p0_transpose_item<0>(INP(8) + (size_t)m * DFF * DM, DFF, DM, WDN + (size_t)m * DM * DFF, scr, r - m * I_DN, lane); continue; } r -= 8 * I_DN;
            if (r < 2 * I_INAB) { const int m = r / I_INAB; p0_transpose_item<0>(INP(9) + (size_t)m * DM * AB_IN, DM, AB_IN, WINAB + (size_t)m * AB_IN * DM, scr, r - m * I_INAB, lane); continue; } r -= 2 * I_INAB;
            if (r < 2 * I_SQ) { const int m = r / I_SQ; p0_transpose_item<0>(INP(13) + (size_t)m * DM * DM, DM, DM, WOUTAB + (size_t)m * DM * DM, scr, r - m * I_SQ, lane); continue; } r -= 2 * I_SQ;
            if (r < 2 * I_INC) { const int m = r / I_INC; p0_transpose_item<0>(INP(14) + (size_t)m * DM * C_IN, DM, C_IN, WINC + (size_t)m * C_IN_PAD * DM, scr, r - m * I_INC, lane); continue; } r -= 2 * I_INC;
            if (r < 2 * I_UQ) { const int m = r / I_UQ; p0_transpose_item<0>(INP(17) + (size_t)m * QRANK * MLA_QOUT, QRANK, MLA_QOUT, WUQ + (size_t)m * MLA_QOUT * QRANK, scr, r - m * I_UQ, lane); continue; } r -= 2 * I_UQ;
            if (r < 2 * I_UKV) { const int m = r / I_UKV; p0_transpose_item<0>(INP(18) + (size_t)m * KVRANK * MLA_KVOUT, KVRANK, MLA_KVOUT, WUKV + (size_t)m * MLA_KVOUT * KVRANK, scr, r - m * I_UKV, lane); continue; } r -= 2 * I_UKV;
            { const int m = r / I_SQ; p0_transpose_item<0>(INP(19) + (size_t)m * DM * DM, DM, DM, WOUTC + (size_t)m * DM * DM, scr, r - m * I_SQ, lane); }
        }
        { constexpr int PER = (C_IN_PAD - C_IN) * DM * 2 / 16;
          for (int i = gw * 64 + lane; i < 2 * PER; i += NGW * 64) { const int m = i / PER, j = i - m * PER;
              *(v4u*)((unsigned char*)WINC + (size_t)m * SZ_WINC + (size_t)C_IN * DM * 2 + (size_t)j * 16) = (v4u){0u, 0u, 0u, 0u}; } }
        for (int e = gw * 64 + lane; e < 9216; e += NGW * 64) {
            int p, f, nf, oc, os;
            if (e < 6144) { p = e >> 5; f = e & 31; nf = 32; if (p < 128) { oc = T_HRC + p * 32 + f; os = T_HRS + p * 32 + f; } else { oc = T_HCC + (p - 128) * 32 + f; os = T_HCS + (p - 128) * 32 + f; } }
            else { const int e2 = e - 6144; p = e2 >> 4; f = e2 & 15; nf = 16; if (p < 128) { oc = T_MRC + p * 16 + f; os = T_MRS + p * 16 + f; } else { oc = T_MCC + (p - 128) * 16 + f; os = T_MCS + (p - 128) * 16 + f; } }
            const int pos = p < 128 ? p : p - 128;
            const double inv = my_exp(-((double)f / (double)nf) * 9.210340371976184);
            double s, c; my_sincos((double)pos * inv, s, c);
            TBL[oc] = (float)c; TBL[os] = (float)s;
        }
    }
    GRID_BAR();
    p0_mod_sum(WSP(float, WS_H), INP(5), MOD, gw * 64 + lane, NGW * 64);
    GRID_BAR();

    for (int l = 0; l < DEPTH; ++l) {
        const float* modl = MOD + (size_t)l * 3 * 9 * DM;
        const int li = l >> 1; const bool even = (l & 1) == 0;
        for (int half = 0; half < 2; ++half) {
            if (half == 1) {
                norm_phase(nullptr, nullptr, X, XN, INP(6) + (size_t)(l * 3 + 1) * DM, modl, 1, false, gw, NGW, lane);
                GRID_BAR();
                {
                    const int N = even ? AB_IN : C_IN_PAD;
                    pg8::Gemm g{XN, even ? WINAB + (size_t)li * AB_IN * DM : WINC + (size_t)li * C_IN_PAD * DM, MROWS, N, DM};
                    pg8::StaticOrder S; S.init(MROWS, N, G, bx);
                    pg8::EpiPlain E{even ? QKV : CQ, N};
                    pg8::gemm_phase<pg8::EpiPlain, pg8::StaticOrder, PG8_ALIGN, PG8_SP2>(L + RING_OFF, g, S, E);
                }
                GRID_BAR();
                if (even) {
                    pass_ab(QKV, INP(10) + li * 128, INP(11) + li * 128, TBL, gw, NGW, lane);
                    GRID_BAR();
                    for (int it = 0; it < 5; ++it) {
                        int type, b, h, qb = 0;
                        if (it < 4) { type = it >> 1; b = it & 1; h = vcu >> 5; qb = vcu & 31; }
                        else { if (vcu >= 32) break; type = 2 + ((vcu >> 3) & 1); b = vcu >> 4; h = vcu & 7; }
                        const bool isB = (type & 1) != 0; const int kvh = h >> 2;
                        const int qcol = (isB ? 1536 : 0) + 128 * h, kcol = (isB ? 2560 : 1024) + 128 * kvh, vcol = (isB ? 2816 : 1280) + 128 * kvh, ocol = (isB ? 1024 : 0) + 128 * h;
                        const size_t rowb = (size_t)b * RPB, qrow = rowb + (type < 2 ? CTXL + 256 * qb : 0);
                        int NT = 4, base1 = 256, wmode = 0, qpos0 = 0;
                        if (type == 0) NT = 132;
                        else if (type == 1) { const int bs = (256 * qb - 128) < 0 ? 0 : (256 * qb - 128), be = (256 * qb + 384) > SEQ ? SEQ : (256 * qb + 384); NT = 4 + (be - bs) / 64; base1 = 256 + bs; wmode = 1; qpos0 = 256 * qb; }
                        float m_init = -1e30f, l_init = 0.f;
                        if (isB) { m_init = INP(12)[li * 8 + h] * 11.313708498984761f; l_init = 1.f; }
                        att::attn_unit<128, 3072, 3072, 3072, 2048, ATT_SD128>(QKV + qrow * AB_IN + qcol, QKV + rowb * AB_IN + kcol, nullptr, QKV + rowb * AB_IN + vcol, O + qrow * DM + ocol,
                                                                   NT, base1, wmode, qpos0, m_init, l_init, (char*)lds + RING_OFF);
                    }
                } else {
                    pass_mla1(CQ, CQN, CKVN, KR, INP(15) + li * QRANK, INP(16) + li * KVRANK, TBL, gw, NGW, lane);
                    GRID_BAR();
                    {   pg8::Gemm g{CQN, WUQ + (size_t)li * MLA_QOUT * QRANK, MROWS, MLA_QOUT, QRANK};
                        pg8::StaticOrder S; S.init(MROWS, MLA_QOUT, G, bx);
                        pg8::EpiPlain E{QKV, MLA_QOUT};
                        pg8::gemm_phase<pg8::EpiPlain, pg8::StaticOrder, PG8_ALIGN, PG8_SP2>(L + RING_OFF, g, S, E); }
                    {   pg8::Gemm g{CKVN, WUKV + (size_t)li * MLA_KVOUT * KVRANK, MROWS, MLA_KVOUT, KVRANK};
                        pg8::StaticOrder S; S.init(MROWS, MLA_KVOUT, G, bx);
                        pg8::EpiPlain E{KV, MLA_KVOUT};
                        pg8::gemm_phase<pg8::EpiPlain, pg8::StaticOrder, PG8_ALIGN, PG8_SP2>(L + RING_OFF, g, S, E); }
                    GRID_BAR();
                    pass_mla2(QKV, TBL, gw, NGW, lane);
                    GRID_BAR();
                    const bool need_ctx = l < DEPTH - 1;
                    for (int it = 0; it < 5; ++it) {
                        int b, h, qb = 0; bool cx = false;
                        if (it < 4) { b = it >> 1; h = (it & 1) * 8 + (vcu >> 5); qb = vcu & 31; }
                        else { if (!need_ctx || vcu >= 32) break; b = vcu >> 4; h = vcu & 15; cx = true; }
                        const size_t rowb = (size_t)b * RPB, qrow = rowb + (cx ? 0 : CTXL + 256 * qb);
                        att::attn_unit<192, 3072, 4096, 4096, 2048, ATT_SD192>(QKV + qrow * MLA_QOUT + 192 * h, KV + rowb * MLA_KVOUT + 256 * h, KR + rowb * 64, KV + rowb * MLA_KVOUT + 256 * h + 128, O + qrow * DM + 128 * h,
                                                                   cx ? 4 : 132, 256, 0, 0, -1e30f, 0.f, (char*)lds + RING_OFF);
                    }
                }
                GRID_BAR();
                {
                    pg8::Gemm g{O, even ? WOUTAB + (size_t)li * DM * DM : WOUTC + (size_t)li * DM * DM, MROWS, DM, DM};
                    pg8::StaticOrder S; S.init(MROWS, DM, G, bx);
                    pg8::EpiResid E{X, modl, 5, 1.0f};
                    pg8::gemm_phase<pg8::EpiResid, pg8::StaticOrder, PG8_ALIGN, PG8_SP2>(L + RING_OFF, g, S, E);
                }
                GRID_BAR();
            }
            const int j = 2 * half, wi = l * 2 + half;
            norm_phase(INP(0), INP(2), X, XN, INP(6) + (size_t)(l * 3 + j) * DM, modl, j, l == 0 && half == 0, gw, NGW, lane);
            GRID_BAR();
            {   pg8::Gemm g{XN, WGU + (size_t)wi * 2 * DFF * DM, MROWS, 2 * DFF, DM};
                pg8::StaticOrder S; S.init(MROWS, 2 * DFF, G, bx);
                pg8::EpiSwiGLU E{H, DFF};
                pg8::gemm_phase<pg8::EpiSwiGLU, pg8::StaticOrder, PG8_ALIGN, PG8_SP2>(L + RING_OFF, g, S, E); }
            GRID_BAR();
            {   pg8::Gemm g{H, WDN + (size_t)wi * DM * DFF, MROWS, DM, DFF};
                pg8::StaticOrder S; S.init(MROWS, DM, G, bx);
                pg8::EpiResid E{X, modl, 3 * j + 2, 0.5f};
                pg8::gemm_phase<pg8::EpiResid, pg8::StaticOrder, PG8_ALIGN, PG8_SP2>(L + RING_OFF, g, S, E); }
            GRID_BAR();
        }
    }
    final_phase(X, args.out, INP(20), gw, NGW, lane);
#undef GRID_BAR
}
#undef MOD
#undef TBL
#undef WGU
#undef WDN
#undef WINAB
#undef WOUTAB
#undef WINC
#undef WUQ
#undef WUKV
#undef WOUTC
#undef X
#undef XN
#undef H
#undef QKV
#undef KV
#undef CQ
#undef CQN
#undef CKVN
#undef KR
#undef O

extern "C" void kernel_launch(void* const* d_in, const int* in_sizes, int n_in, void* d_out, int out_size, void* d_ws, size_t ws_size, hipStream_t stream) {
    static int grid = 0;
    if (grid == 0) {
        if (n_in != 21 || in_sizes[0] != NB * SEQ * DM || out_size != NB * SEQ * DM || ws_size < WS_END) {
            fprintf(stderr, "kernel_launch: shape mismatch: n_in %d in0 %d out %d ws %zu (need %zu)\n", n_in, n_in > 0 ? in_sizes[0] : -1, out_size, ws_size, (size_t)WS_END); grid = -1; return; }
        int dev = 0, cus = 0, per_cu = 0;
        if (hipGetDevice(&dev) != hipSuccess || hipDeviceGetAttribute(&cus, hipDeviceAttributeMultiprocessorCount, dev) != hipSuccess) { fprintf(stderr, "kernel_launch: device query failed\n"); grid = -1; return; }
        if (hipFuncSetAttribute((const void*)fwd, hipFuncAttributeMaxDynamicSharedMemorySize, LDS_BYTES) != hipSuccess) { fprintf(stderr, "kernel_launch: hipFuncSetAttribute failed\n"); grid = -1; return; }
        if (hipOccupancyMaxActiveBlocksPerMultiprocessor(&per_cu, (const void*)fwd, NWAVES * 64, LDS_BYTES) != hipSuccess || per_cu < 1)
            fprintf(stderr, "kernel_launch: note: occupancy query reports %d workgroups per CU\n", per_cu);
        (void)hipGetLastError();
        grid = cus;
    }
    if (grid < 0) return;
    if (hipMemsetAsync((char*)d_ws + WS_CTL, 0, CTL_ZERO_BYTES, stream) != hipSuccess) { fprintf(stderr, "kernel_launch: memset failed\n"); return; }
    Args a{};
    for (int i = 0; i < 21; ++i) a.in[i] = (const float*)d_in[i];
    a.out = (float*)d_out; a.ws = (unsigned char*)d_ws;
    hipLaunchKernelGGL(fwd, dim3(grid), dim3(NWAVES * 64), LDS_BYTES, stream, a);
    const hipError_t le = hipPeekAtLastError();
    if (le != hipSuccess) fprintf(stderr, "kernel_launch: launch failed: %s\n", hipGetErrorName(le));
}
```

```cpp
#include <hip/hip_runtime.h>
#include <cstdio>
#include <cstdint>

constexpr int DM = 2048, NB = 2, SEQ = 8192, CTXL = 256, DEPTH = 4, DFF = 5632, NMOD = 9, GRID_W = 64;
constexpr int RPB = CTXL + SEQ;
constexpr int MROWS = NB * RPB;
constexpr int PPB = RPB / 256;
constexpr int AB_IN = 3072, C_IN = 832, C_IN_PAD = 1024, QRANK = 512, KVRANK = 256, MLA_QOUT = 3072, MLA_KVOUT = 4096;
constexpr float EPS = 1e-6f;

__device__ __forceinline__ int lane_id_fresh() { unsigned z = 0u; asm volatile("" : "+v"(z)); return (int)__builtin_amdgcn_mbcnt_hi(~0u, __builtin_amdgcn_mbcnt_lo(~0u, z)); }

#ifndef DIS_A128
#define DIS_A128 0
#endif
#ifndef DIS_A192
#define DIS_A192 0
#endif
#ifndef DIS_G1
#define DIS_G1 0
#endif
#ifndef DIS_G2
#define DIS_G2 0
#endif
#ifndef DIS_G3
#define DIS_G3 0
#endif
#ifndef DIS_G4
#define DIS_G4 0
#endif
#ifndef DIS_G5
#define DIS_G5 0
#endif
#ifndef DIS_G6
#define DIS_G6 0
#endif
#ifndef ATT_SD128
#define ATT_SD128 1
#endif
#ifndef ATT_SD192
#define ATT_SD192 1
#endif
#ifndef PROBE_ATTAB
#define PROBE_ATTAB 0
#endif
#ifndef PROBE_ATTMLA
#define PROBE_ATTMLA 0
#endif
#ifndef PROBE_G1
#define PROBE_G1 0
#endif
#ifndef PROBE_NORM
#define PROBE_NORM 0
#endif
#ifndef PROBE_TR
#define PROBE_TR 0
#endif
#ifndef PROBE_G2
#define PROBE_G2 0
#endif
#ifndef PROBE_PASS
#define PROBE_PASS 0
#endif
#ifndef PROBE_MOD
#define PROBE_MOD 0
#endif
#ifndef PROBE_INPROJ
#define PROBE_INPROJ 0
#endif
#ifndef PROBE_UQKV
#define PROBE_UQKV 0
#endif
#ifndef PROBE_OUTPROJ
#define PROBE_OUTPROJ 0
#endif
#ifndef PROBE_BAR
#define PROBE_BAR 0
#endif
#ifndef PROBE_WAIT_MASK
#define PROBE_WAIT_MASK 0
#endif
#ifndef PROBE_WAIT_Q
#define PROBE_WAIT_Q 200.0f
#endif
#ifndef PROBE_WAIT_OFF
#define PROBE_WAIT_OFF 0.0f
#endif
#ifndef REV_G2
#define REV_G2 true
#endif
#ifndef WGM_G2
#define WGM_G2 4
#endif
#ifndef NT_H
#define NT_H 0
#endif
#ifndef DEFER_CONV
#define DEFER_CONV 0
#endif
#ifndef PROBE_OUTPLAIN
#define PROBE_OUTPLAIN 0
#endif
#ifndef PROBE_G1PLAIN
#define PROBE_G1PLAIN 0
#endif
#ifndef H_TILED
#define H_TILED 1
#endif
#ifndef G1_CUTS
#define G1_CUTS 1
#endif
#ifndef NT_W
#define NT_W 0
#endif
#ifndef WGM_G1
#define WGM_G1 4
#endif
#ifndef CODE_SHIFT
#define CODE_SHIFT 2
#endif
#ifndef ATT_PRIO
#define ATT_PRIO 0
#endif
#ifndef NORM_BLOCKED
#define NORM_BLOCKED 1
#endif
#ifndef WGM_PROJ
#define WGM_PROJ 8
#endif
#ifndef ATT_EARLY
#define ATT_EARLY 0
#endif
#ifndef ATT_STAG
#define ATT_STAG 1
#endif
#ifndef ATT_NQ128
#define ATT_NQ128 8
#endif
#ifndef ATT_NQ192
#define ATT_NQ192 8
#endif
#ifndef ATT_SLEEP
#define ATT_SLEEP 0
#endif
#ifndef KSWZ_MASK
#define KSWZ_MASK 15
#endif
#ifndef ATT_KDMA
#define ATT_KDMA 1
#endif
#ifndef ATT_VDMA
#define ATT_VDMA 1
#endif
#ifndef ATT_PKMATH
#define ATT_PKMATH 0
#endif
#ifndef G1_HALFCTX
#define G1_HALFCTX 1
#endif
namespace pg8 {
#define PG8_LAS __attribute__((address_space(3)))
typedef unsigned short bf16_t;
typedef short bf16x8 __attribute__((ext_vector_type(8)));
typedef float f32x4 __attribute__((ext_vector_type(4)));
typedef unsigned u32x4 __attribute__((ext_vector_type(4)));
constexpr int BM = 256, BK = 64, HALF = 128, HTB = HALF * BK * 2  , STAGE_BYTES = 8 * HTB, NXCD = 8, WGM = 8;

__host__ __device__ __forceinline__ int lds_byte(int r, int c) { const int st = (r >> 4) * 2 + (c >> 5), rr = r & 15, cc = c & 31, ob = rr * 64 + cc * 2; return st * 1024 + (ob ^ (((ob >> 9) & 1) << 5)); }
__host__ __device__ __forceinline__ void stage_rc(int b, int& R, int& C) { const int st = b / 1024, sb = b % 1024, swz = sb ^ (((sb >> 9) & 1) << 5); R = (st >> 1) * 16 + swz / 64; C = (st & 1) * 32 + (swz % 64) / 2; }
__host__ __device__ __forceinline__ int perm32(int rho) { const int n = rho >> 4, i = rho & 15; return 8 * (i >> 2) + 4 * n + (i & 3); }

struct Unit { int pm, pn, koff, ks; };
struct Gemm { const bf16_t* A; const bf16_t* Bt; int M, N, K, ld; int lda; size_t kstepA; };

struct StaticOrder {
    int nM, nN, nwg, G, c, wgm = WGM;
    __host__ __device__ void init(int M, int N, int G_, int c_) { nM = M / BM; nN = N / BM; nwg = nM * nN; G = G_; c = c_; }
    __host__ __device__ bool next(int i, Unit& u) const {
        const long L = (long)i * G + c; if (L >= nwg) return false;
        int wgid = (int)L; { const int q = nwg / NXCD, r = nwg % NXCD, xcd = wgid % NXCD, off = wgid / NXCD; wgid = (xcd < r ? xcd * (q + 1) : r * (q + 1) + (xcd - r) * q) + off; }
        const int nig = wgm * nN, gid = wgid / nig, fm = gid * wgm, gsz = (nM - fm) < wgm ? (nM - fm) : wgm;
        u.pm = fm + ((wgid % nig) % gsz); u.pn = (wgid % nig) / gsz; u.koff = 0; u.ks = 0; return true;
    }
    __device__ __forceinline__ void a_ready(const Unit&) const {}
    __device__ __forceinline__ void done(const Unit&) const {}
};

typedef float f32x2_t __attribute__((ext_vector_type(2))); typedef __bf16 bf16x2_t __attribute__((ext_vector_type(2)));
__device__ __forceinline__ unsigned cvt_pk_bf16(float lo, float hi) { f32x2_t v = {lo, hi}; bf16x2_t b = __builtin_convertvector(v, bf16x2_t); return __builtin_bit_cast(unsigned, b); }

struct EpiPlain {
    static constexpr bool PERM = true, AFTER_DRAIN = false;
    bf16_t* O; int ldc;
    __device__ __forceinline__ void operator()(const f32x4 (&acc)[2][2][4][2], const Unit& u, int wr, int wc, int fr, int fq) const {
        const int row0 = u.pm * BM + wr * 64 + fr, col0 = u.pn * BM + wc * 32 + 8 * fq;
#pragma unroll
        for (int ai = 0; ai < 2; ++ai)
#pragma unroll
            for (int m = 0; m < 4; ++m) { bf16_t* rowp = O + (size_t)(row0 + ai * HALF + m * 16) * ldc + col0;
#pragma unroll
                for (int bj = 0; bj < 2; ++bj) { const f32x4 v0 = acc[ai][bj][m][0], v1 = acc[ai][bj][m][1];
                    u32x4 w; w.x = cvt_pk_bf16(v0[0], v0[1]); w.y = cvt_pk_bf16(v0[2], v0[3]); w.z = cvt_pk_bf16(v1[0], v1[1]); w.w = cvt_pk_bf16(v1[2], v1[3]);
                    *(u32x4*)(rowp + bj * HALF) = w; } }
    }
};
__device__ __forceinline__ u32x4 swiglu8(const f32x4 g0, const f32x4 g1, const f32x4 u0, const f32x4 u1) {
    float g[8] = {g0[0], g0[1], g0[2], g0[3], g1[0], g1[1], g1[2], g1[3]}, u[8] = {u0[0], u0[1], u0[2], u0[3], u1[0], u1[1], u1[2], u1[3]}, t[8];
#pragma unroll
    for (int k = 0; k < 8; ++k) t[k] = g[k] * -1.4426950408889634f;
#pragma unroll
    for (int k = 0; k < 8; ++k) t[k] = __builtin_amdgcn_exp2f(t[k]);
#pragma unroll
    for (int k = 0; k < 8; ++k) t[k] = 1.0f + t[k];
#pragma unroll
    for (int k = 0; k < 8; ++k) t[k] = __builtin_amdgcn_rcpf(t[k]);
#pragma unroll
    for (int k = 0; k < 8; ++k) t[k] = (g[k] * t[k]) * u[k];
    u32x4 w; w.x = cvt_pk_bf16(t[0], t[1]); w.y = cvt_pk_bf16(t[2], t[3]); w.z = cvt_pk_bf16(t[4], t[5]); w.w = cvt_pk_bf16(t[6], t[7]); return w;
}
template <bool HALFM> struct EpiSwiGLU_T {
    static constexpr bool PERM = true, AFTER_DRAIN = false;
    bf16_t* H; int ldh;
    __device__ __forceinline__ void operator()(const f32x4 (&acc)[2][2][4][2], const Unit& u, int wr, int wc, int fr, int fq) const {
        const int row0 = u.pm * BM + (HALFM ? u.ks * HALF : 0) + wr * 64 + fr, col0 = u.pn * HALF + wc * 32 + 8 * fq;
#pragma unroll
        for (int ai = 0; ai < (HALFM ? 1 : 2); ++ai)
#pragma unroll
            for (int m = 0; m < 4; ++m) {
                bf16_t* rowp = H_TILED ? H + ((size_t)(col0 >> 6) * ldh + (row0 + ai * HALF + m * 16)) * 64 + (col0 & 63) : H + (size_t)(row0 + ai * HALF + m * 16) * ldh + col0;
                const u32x4 w = swiglu8(acc[ai][0][m][0], acc[ai][0][m][1], acc[ai][1][m][0], acc[ai][1][m][1]);
                if (NT_H) __builtin_nontemporal_store(w, (u32x4*)rowp); else *(u32x4*)rowp = w; }
    }
};
typedef EpiSwiGLU_T<false> EpiSwiGLU;
struct EpiResid {
    static constexpr bool PERM = true, AFTER_DRAIN = false;
    bf16_t* X; const float* modl; int gidx; float coef;
    __device__ __forceinline__ void operator()(const f32x4 (&acc)[2][2][4][2], const Unit& u, int wr, int wc, int fr, int fq) const {
        const int b = u.pm / 33, v = (u.pm - b * 33 == 0) ? 2 : b;
        const float* gate = modl + (size_t)(v * 9 + gidx) * 2048;
        const int row0 = u.pm * BM + wr * 64 + fr, col0 = u.pn * BM + wc * 32 + 8 * fq;
        f32x4 gv[2][2];
#pragma unroll
        for (int bj = 0; bj < 2; ++bj)
#pragma unroll
            for (int n = 0; n < 2; ++n) gv[bj][n] = *(const f32x4*)(gate + col0 + bj * HALF + n * 4) * coef;
#pragma unroll
        for (int ai = 0; ai < 2; ++ai) {
            u32x4 xo[4][2];
#pragma unroll
            for (int m = 0; m < 4; ++m)
#pragma unroll
                for (int bj = 0; bj < 2; ++bj) xo[m][bj] = *(const u32x4*)(X + (size_t)(row0 + ai * HALF + m * 16) * 2048 + col0 + bj * HALF);
#pragma unroll
            for (int m = 0; m < 4; ++m)
#pragma unroll
                for (int bj = 0; bj < 2; ++bj) { const u32x4 x4 = xo[m][bj];
                    const f32x4 d0 = gv[bj][0] * acc[ai][bj][m][0], d1 = gv[bj][1] * acc[ai][bj][m][1];
                    u32x4 w;
                    w.x = cvt_pk_bf16(__builtin_bit_cast(float, x4.x << 16) + d0[0], __builtin_bit_cast(float, x4.x & 0xffff0000u) + d0[1]);
                    w.y = cvt_pk_bf16(__builtin_bit_cast(float, x4.y << 16) + d0[2], __builtin_bit_cast(float, x4.y & 0xffff0000u) + d0[3]);
                    w.z = cvt_pk_bf16(__builtin_bit_cast(float, x4.z << 16) + d1[0], __builtin_bit_cast(float, x4.z & 0xffff0000u) + d1[1]);
                    w.w = cvt_pk_bf16(__builtin_bit_cast(float, x4.w << 16) + d1[2], __builtin_bit_cast(float, x4.w & 0xffff0000u) + d1[3]);
                    *(u32x4*)(X + (size_t)(row0 + ai * HALF + m * 16) * 2048 + col0 + bj * HALF) = w; }
            asm volatile("" ::: "memory"); }
    }
};

struct PanelOrder : StaticOrder {
    int r0 = 0, r1 = 1 << 30;
    bool skip; bool rev = false;
    __host__ __device__ void init(int N, int G_, int c_, bool skip_) {
#if defined(__HIP_DEVICE_COMPILE__)
        asm volatile("" : "+s"(G_), "+s"(c_));
#endif
        skip = skip_; StaticOrder::init((skip_ ? 64 : 66) * BM, N, G_, c_); }
    __host__ __device__ bool next(int i, Unit& u) const { if (i + r0 >= r1 || !StaticOrder::next(i + r0, u)) return false; if (rev) u.pm = nM - 1 - u.pm; if (skip) u.pm += 1 + (u.pm >= 32 ? 1 : 0); return true; }
};
struct CtxSplitOrder {
    int S, nN, klen, c;
    __host__ __device__ bool next(int i, Unit& u) const { if (i > 0 || c >= 2 * nN * S) return false; const int ks = c % S, rest = c / S; u.pn = rest % nN; u.pm = (rest / nN) * 33; u.koff = ks * klen; u.ks = ks; return true; }
    __device__ __forceinline__ void a_ready(const Unit&) const {}
    __device__ __forceinline__ void done(const Unit&) const {}
};
struct CtxHalfOrder {
    int nN, c;
    __host__ __device__ bool next(int i, Unit& u) const { if (i > 0 || c >= 4 * nN) return false; u.pn = c % nN; const int hp = c / nN; u.pm = (hp >> 1) * 33; u.ks = hp & 1; u.koff = 0; return true; }
    __device__ __forceinline__ void a_ready(const Unit&) const {}
    __device__ __forceinline__ void done(const Unit&) const {}
};
struct EpiPartial {
    static constexpr bool PERM = false, AFTER_DRAIN = false;
    float* P; int ldp;
    __device__ __forceinline__ void operator()(const f32x4 (&acc)[2][2][4][2], const Unit& u, int wr, int wc, int fr, int fq) const {
        const int crow0 = (u.pm == 0 ? 0 : 256) + wr * 64 + fr, col0 = u.pn * BM + wc * 32 + 4 * fq;
        float* base = P + ((size_t)u.ks * 512 + crow0) * ldp + col0;
#pragma unroll
        for (int ai = 0; ai < 2; ++ai)
#pragma unroll
            for (int m = 0; m < 4; ++m) { float* rowp = base + (size_t)(ai * HALF + m * 16) * ldp;
#pragma unroll
                for (int bj = 0; bj < 2; ++bj)
#pragma unroll
                    for (int n = 0; n < 2; ++n) *(f32x4*)(rowp + bj * HALF + n * 16) = acc[ai][bj][m][n]; }
    }
};

template <class Epi, class Sched, bool ALIGN_EPI = false, bool SP2 = false, bool HALFM = false>
__device__ __forceinline__ void gemm_phase(PG8_LAS unsigned char* lds, const Gemm g, const Sched& S, const Epi& E, const int tid_in) {
    int tid_ = tid_in; asm volatile("" : "+v"(tid_));
    const int tid = tid_, wid = __builtin_amdgcn_readfirstlane(tid >> 6), lane = tid & 63, wr = wid >> 2, wc = wid & 3, fr = lane & 15, fq = lane >> 4;
    const int K = g.K, nt = K / BK;
    unsigned voffA[2], voffB[2];
#pragma unroll
    for (int i = 0; i < 2; ++i) { int R, C; stage_rc(tid * 16 + i * 8192, R, C); const int Rb = Epi::PERM ? ((R & ~31) + perm32(R & 31)) : R;
        voffA[i] = (unsigned)(R * g.lda + C) * 2u; voffB[i] = (unsigned)(Rb * g.ld + C) * 2u; }
    const size_t kstep = (size_t)(BK * 2);
    const size_t kstepA = g.kstepA, hstepA = (size_t)HALF * g.lda * 2, tstepA = 2 * hstepA;
    const size_t hstep = (size_t)HALF * g.ld * 2;
    const size_t tstep = 2 * hstep;
    const unsigned ldsw = (unsigned)wid * 1024u;
    const int aoff = lds_byte(wr * 64 + fr, fq * 8), boff = lds_byte(wc * 32 + fr, fq * 8);
#define PG8_SA(b, h) (((b) * 2 + (h)) * HTB)
#define PG8_SB(b, h) ((4 + (b) * 2 + (h)) * HTB)
#define PG8_STAGE(bufoff, gbase, voff) do { _Pragma("unroll") for (int _i = 0; _i < 2; ++_i) \
        __builtin_amdgcn_global_load_lds((const unsigned*)((const char*)(gbase) + (voff)[_i]), (PG8_LAS unsigned*)(lds + (bufoff) + ldsw + _i * 8192), 16, 0, 0); } while (0)
#define PG8_LDA(dst, b, h) do { _Pragma("unroll") for (int m = 0; m < 4; ++m) _Pragma("unroll") for (int k = 0; k < 2; ++k) dst[m][k] = *(const PG8_LAS bf16x8*)(lds + PG8_SA(b, h) + aoff + m * 2048 + k * 1024); } while (0)
#define PG8_LDB(dst, b, h) do { _Pragma("unroll") for (int n = 0; n < 2; ++n) _Pragma("unroll") for (int k = 0; k < 2; ++k) dst[n][k] = *(const PG8_LAS bf16x8*)(lds + PG8_SB(b, h) + boff + n * 2048 + k * 1024); } while (0)
#define PG8_MMA(ai, bj, At, Bt) do { __builtin_amdgcn_s_setprio(1); _Pragma("unroll") for (int m = 0; m < 4; ++m) _Pragma("unroll") for (int n = 0; n < 2; ++n) _Pragma("unroll") for (int k = 0; k < 2; ++k) \
        acc[ai][bj][m][n] = __builtin_amdgcn_mfma_f32_16x16x32_bf16(Bt[n][k], At[m][k], acc[ai][bj][m][n], 0, 0, 0); __builtin_amdgcn_s_setprio(0); } while (0)
#define PG8_WAIT_V(n) asm volatile("s_waitcnt vmcnt(" #n ")" ::: "memory")
#define PG8_WV do { if constexpr (HALFM) PG8_WAIT_V(6); else PG8_WAIT_V(8); } while (0)
#define PG8_WAIT_L(n) asm volatile("s_waitcnt lgkmcnt(" #n ")" ::: "memory")
#define PG8_BAR __builtin_amdgcn_s_barrier()
#define PG8_SCHED __builtin_amdgcn_sched_barrier(0)
    Unit cur, nxt; int ui = 0;
    if (!S.next(0, cur)) return;
    f32x4 acc[2][2][4][2];
#pragma unroll
    for (int a = 0; a < 2; ++a)
#pragma unroll
        for (int b = 0; b < 2; ++b)
#pragma unroll
            for (int m = 0; m < 4; ++m)
#pragma unroll
                for (int n = 0; n < 2; ++n) acc[a][b][m][n] = (f32x4){0.f, 0.f, 0.f, 0.f};
    bf16x8 At[4][2], B0[2][2], B1[2][2];
    static_assert(!HALFM || SP2, "HALFM is written for the two-super-phase loop");
    const char* cA = (const char*)g.A + (size_t)cur.pm * tstepA + (size_t)(cur.koff >> 6) * kstepA + (HALFM ? (size_t)cur.ks * hstepA : (size_t)0); const char* cB = (const char*)g.Bt + (size_t)cur.pn * tstep + (size_t)cur.koff * 2;
    S.a_ready(cur);
    if constexpr (SP2) {
        PG8_STAGE(PG8_SB(0, 0), cB, voffB); PG8_STAGE(PG8_SB(0, 1), cB + hstep, voffB); PG8_STAGE(PG8_SA(0, 0), cA, voffA); if constexpr (!HALFM) PG8_STAGE(PG8_SA(0, 1), cA + hstepA, voffA);
        if (wr == 1) PG8_BAR;
        if constexpr (HALFM) PG8_WAIT_V(0); else PG8_WAIT_V(2);
        PG8_BAR;
        PG8_STAGE(PG8_SB(1, 0), cB + kstep, voffB); PG8_STAGE(PG8_SA(1, 0), cA + kstepA, voffA); PG8_STAGE(PG8_SB(1, 1), cB + hstep + kstep, voffB);
        PG8_WAIT_V(6); PG8_BAR;
    } else {
        PG8_STAGE(PG8_SB(0, 0), cB, voffB); PG8_STAGE(PG8_SA(0, 0), cA, voffA); PG8_STAGE(PG8_SB(0, 1), cB + hstep, voffB); PG8_STAGE(PG8_SA(0, 1), cA + hstepA, voffA);
        if (wr == 1) PG8_BAR;
        PG8_WAIT_V(4); PG8_BAR;
        PG8_STAGE(PG8_SB(1, 0), cB + kstep, voffB); PG8_STAGE(PG8_SA(1, 0), cA + kstepA, voffA); PG8_STAGE(PG8_SB(1, 1), cB + hstep + kstep, voffB);
        PG8_WAIT_V(6); PG8_BAR;
    }
    for (;;) {
        const bool has_next = S.next(ui + 1, nxt);
        const char* nA = has_next ? (const char*)g.A + (size_t)nxt.pm * tstepA + (size_t)(nxt.koff >> 6) * kstepA + (HALFM ? (size_t)nxt.ks * hstepA : (size_t)0) : cA; const char* nB = has_next ? (const char*)g.Bt + (size_t)nxt.pn * tstep + (size_t)nxt.koff * 2 : cB;
        for (int t = 0; t < nt; t += 2) {
            const bool last = (t == nt - 2);
            const char* a1 = cA + (size_t)(t + 1) * kstepA;
            const char* a2 = last ? nA : cA + (size_t)(t + 2) * kstepA; const char* b2 = last ? nB : cB + (size_t)(t + 2) * kstep;
            const char* a3 = a2 + kstepA; const char* b3 = b2 + kstep;
            if (last && has_next) S.a_ready(nxt);
            if constexpr (SP2) {
            PG8_LDB(B0, 0, 0); PG8_LDB(B1, 0, 1); PG8_SCHED; PG8_LDA(At, 0, 0); if constexpr (!HALFM) PG8_STAGE(PG8_SA(1, 1), a1 + hstepA, voffA);
            PG8_WV; PG8_WAIT_L(0); PG8_BAR; PG8_MMA(0, 0, At, B0); PG8_MMA(0, 1, At, B1); PG8_BAR; PG8_SCHED;
            if constexpr (!HALFM) PG8_LDA(At, 0, 1); PG8_STAGE(PG8_SB(0, 0), b2, voffB); PG8_STAGE(PG8_SB(0, 1), b2 + hstep, voffB); PG8_STAGE(PG8_SA(0, 0), a2, voffA);
            PG8_WV; PG8_WAIT_L(0); PG8_BAR; if constexpr (!HALFM) { PG8_MMA(1, 0, At, B0); PG8_MMA(1, 1, At, B1); } PG8_BAR; PG8_SCHED;
            PG8_LDB(B0, 1, 0); PG8_LDB(B1, 1, 1); PG8_SCHED; PG8_LDA(At, 1, 0); if constexpr (!HALFM) PG8_STAGE(PG8_SA(0, 1), a2 + hstepA, voffA);
            PG8_WV; PG8_WAIT_L(0); PG8_BAR; PG8_MMA(0, 0, At, B0); PG8_MMA(0, 1, At, B1); PG8_BAR; PG8_SCHED;
            if constexpr (!HALFM) PG8_LDA(At, 1, 1); PG8_STAGE(PG8_SB(1, 0), b3, voffB); PG8_STAGE(PG8_SB(1, 1), b3 + hstep, voffB); PG8_STAGE(PG8_SA(1, 0), a3, voffA);
            PG8_WV; PG8_WAIT_L(0); PG8_BAR; if constexpr (!HALFM) { PG8_MMA(1, 0, At, B0); PG8_MMA(1, 1, At, B1); } PG8_BAR; PG8_SCHED;
            } else {
            PG8_LDB(B0, 0, 0); PG8_SCHED; PG8_LDA(At, 0, 0); PG8_STAGE(PG8_SA(1, 1), a1 + hstepA, voffA);
            PG8_WAIT_L(8); PG8_BAR; PG8_WAIT_L(0); PG8_MMA(0, 0, At, B0); PG8_BAR; PG8_SCHED;
            PG8_LDB(B1, 0, 1); PG8_STAGE(PG8_SB(0, 0), b2, voffB);
            PG8_BAR; PG8_WAIT_L(0); PG8_MMA(0, 1, At, B1); PG8_BAR;
            PG8_LDA(At, 0, 1); PG8_STAGE(PG8_SA(0, 0), a2, voffA);
            PG8_BAR; PG8_WAIT_L(0); PG8_MMA(1, 0, At, B0); PG8_BAR; PG8_SCHED;
            PG8_STAGE(PG8_SB(0, 1), b2 + hstep, voffB);
            PG8_WAIT_V(6); PG8_BAR; PG8_MMA(1, 1, At, B1); PG8_BAR;
            PG8_LDB(B0, 1, 0); PG8_SCHED; PG8_LDA(At, 1, 0); PG8_STAGE(PG8_SA(0, 1), a2 + hstepA, voffA);
            PG8_WAIT_L(8); PG8_BAR; PG8_WAIT_L(0); PG8_MMA(0, 0, At, B0); PG8_BAR; PG8_SCHED;
            PG8_LDB(B1, 1, 1); PG8_STAGE(PG8_SB(1, 0), b3, voffB);
            PG8_BAR; PG8_WAIT_L(0); PG8_MMA(0, 1, At, B1); PG8_BAR;
            PG8_LDA(At, 1, 1); PG8_STAGE(PG8_SA(1, 0), a3, voffA);
            PG8_BAR; PG8_WAIT_L(0); PG8_MMA(1, 0, At, B0); PG8_BAR; PG8_SCHED;
            PG8_STAGE(PG8_SB(1, 1), b3 + hstep, voffB);
            PG8_WAIT_V(6); PG8_BAR; PG8_MMA(1, 1, At, B1); PG8_BAR;
            }
        }
        if constexpr (ALIGN_EPI) { if (wr == 0) PG8_BAR; }
        if constexpr (!Epi::AFTER_DRAIN) { E(acc, cur, wr, wc, fr, fq); S.done(cur); }
        if (!has_next) break;
#pragma unroll
        for (int a = 0; a < 2; ++a)
#pragma unroll
            for (int b = 0; b < 2; ++b)
#pragma unroll
                for (int m = 0; m < 4; ++m)
#pragma unroll
                    for (int n = 0; n < 2; ++n) acc[a][b][m][n] = (f32x4){0.f, 0.f, 0.f, 0.f};
        cur = nxt; cA = nA; cB = nB; ++ui;
        if constexpr (ALIGN_EPI) { if (wr == 1) PG8_BAR; }
    }
    PG8_WAIT_V(0);
    if constexpr (!ALIGN_EPI) { if (wr == 0) PG8_BAR; }
    PG8_BAR;
    if constexpr (Epi::AFTER_DRAIN) { E.fused(acc, cur, wr, wc, fr, fq, lds, wid, lane); S.done(cur); }
#undef PG8_SA
#undef PG8_WV
#undef PG8_SB
#undef PG8_STAGE
#undef PG8_LDA
#undef PG8_LDB
#undef PG8_MMA
#undef PG8_WAIT_V
#undef PG8_WAIT_L
#undef PG8_BAR
#undef PG8_SCHED
}
}
#ifndef PG8_SP2
#define PG8_SP2 true
#endif
#ifndef PG8_ALIGN
#define PG8_ALIGN true
#endif

namespace att {
typedef unsigned short bf16_t;
using bf16x8 = __attribute__((ext_vector_type(8))) short;
using s16x4  = __attribute__((ext_vector_type(4))) short;
using f32x16 = __attribute__((ext_vector_type(16))) float;
using u32x4  = __attribute__((ext_vector_type(4))) unsigned;
constexpr int NW = 8, QBLK = 32, KVBLK = 64;
constexpr int SHM_V = 16384, SHM_K = 16384, SHM_KR = 8192;
constexpr int NVB = ATT_VDMA ? 3 : 2;
constexpr int NKB = (ATT_VDMA == 2) ? 3 : 2;
constexpr int OFF_V = 0, OFF_K = NVB * SHM_V, OFF_KR = OFF_K + NKB * SHM_K, OFF_WS = OFF_KR + NKB * SHM_KR, OFF_QR = OFF_WS + NW * 64 * 4, QR_WAVE = (ATT_VDMA == 2) ? 4096 : 7168, LDS_BYTES = OFF_QR + NW * QR_WAVE;
#ifndef ATTN_THR
#define ATTN_THR 8.f
#endif
constexpr float THR = ATTN_THR;
#define KSWZ(row, colB) ((row) * 256 + ((colB) ^ (((row) & KSWZ_MASK) << 4)))
#define KRSWZ(row, colB) ((row) * 128 + ((colB) ^ ((((row) >> 1) & 7) << 4)))
#define SBAR() __builtin_amdgcn_sched_barrier(0)
__device__ __forceinline__ int crow(int r, int hi) { return (r & 3) + 8 * (r >> 2) + 4 * hi; }
__device__ __forceinline__ unsigned cvtpk(float lo, float hi) { unsigned r; asm volatile("v_cvt_pk_bf16_f32 %0, %1, %2" : "=v"(r) : "v"(lo), "v"(hi)); return r; }
template <int DQK> struct Cfg { static constexpr float SCALE = (DQK == 128) ? 0.08838834764831845f : 0.07216878364870323f; };

template <int DQK>
__device__ __forceinline__ void partialSM(f32x16& p0, f32x16& p1, float& m_reg, float& mn, float& alpha) {
  constexpr float SCALE = Cfg<DQK>::SCALE, C = SCALE * 1.4426950408889634f;
  float pmax = p0[0];
#pragma unroll
  for (int r = 1; r < 16; ++r) pmax = fmaxf(pmax, p0[r]);
#pragma unroll
  for (int r = 0; r < 16; ++r) pmax = fmaxf(pmax, p1[r]);
  { auto rr = __builtin_amdgcn_permlane32_swap(__float_as_uint(pmax), __float_as_uint(pmax), false, false);
    pmax = fmaxf(__uint_as_float(rr[0]), __uint_as_float(rr[1])); }
  if (__builtin_expect(__all(pmax - m_reg <= THR / SCALE), 1)) { mn = m_reg; alpha = 1.f; }
  else { mn = fmaxf(m_reg, pmax); alpha = __builtin_amdgcn_exp2f((m_reg - mn) * C); m_reg = mn; }
  const float mnC = -mn * C;
  if constexpr (ATT_PKMATH) {
    typedef float f32x2_ __attribute__((ext_vector_type(2)));
    const f32x2_ c2 = {C, C}, m2 = {mnC, mnC};
#pragma unroll
    for (int r = 0; r < 16; r += 2) { f32x2_ v = {p0[r], p0[r + 1]}; v = __builtin_elementwise_fma(v, c2, m2); p0[r] = v.x; p0[r + 1] = v.y; }
#pragma unroll
    for (int r = 0; r < 16; r += 2) { f32x2_ v = {p1[r], p1[r + 1]}; v = __builtin_elementwise_fma(v, c2, m2); p1[r] = v.x; p1[r + 1] = v.y; }
  } else {
#pragma unroll
  for (int r = 0; r < 16; ++r) p0[r] = fmaf(p0[r], C, mnC);
#pragma unroll
  for (int r = 0; r < 16; ++r) p1[r] = fmaf(p1[r], C, mnC);
  }
#pragma unroll
  for (int r = 0; r < 16; ++r) p0[r] = __builtin_amdgcn_exp2f(p0[r]);
}
__device__ __forceinline__ void finishSM(f32x16& p0, f32x16& p1, float alpha, float& l_reg, bf16x8& pa0, bf16x8& pa1, bf16x8& pa2, bf16x8& pa3) {
#pragma unroll
  for (int r = 0; r < 16; ++r) p1[r] = __builtin_amdgcn_exp2f(p1[r]);
  float ps = 0;
#pragma unroll
  for (int r = 0; r < (ATT_PKMATH ? 0 : 16); ++r) ps += p0[r];
#pragma unroll
  for (int r = 0; r < (ATT_PKMATH ? 0 : 16); ++r) ps += p1[r];
  if constexpr (ATT_PKMATH) {
    typedef float f32x2_ __attribute__((ext_vector_type(2)));
    f32x2_ s2 = {p0[0], p0[1]};
#pragma unroll
    for (int r = 2; r < 16; r += 2) s2 += (f32x2_){p0[r], p0[r + 1]};
#pragma unroll
    for (int r = 0; r < 16; r += 2) s2 += (f32x2_){p1[r], p1[r + 1]};
    ps = s2.x + s2.y;
  }
  { auto rr = __builtin_amdgcn_permlane32_swap(__float_as_uint(ps), __float_as_uint(ps), false, false);
    ps = __uint_as_float(rr[0]) + __uint_as_float(rr[1]); }
  l_reg = l_reg * alpha + ps;
#define PK4(P, BASE, OUT) do { unsigned a0 = cvtpk(P[BASE + 0], P[BASE + 1]), a1 = cvtpk(P[BASE + 2], P[BASE + 3]);   \
    unsigned b0 = cvtpk(P[BASE + 4], P[BASE + 5]), b1 = cvtpk(P[BASE + 6], P[BASE + 7]);                              \
    auto r0 = __builtin_amdgcn_permlane32_swap(a0, b0, false, false); auto r1 = __builtin_amdgcn_permlane32_swap(a1, b1, false, false); \
    u32x4 w = {r0[0], r1[0], r0[1], r1[1]}; OUT = *reinterpret_cast<bf16x8*>(&w); } while (0)
  PK4(p0, 0, pa0); PK4(p0, 8, pa1); PK4(p1, 0, pa2); PK4(p1, 8, pa3);
#undef PK4
}
template <int DQK>
__device__ __forceinline__ void qkt(f32x16& p0, f32x16& p1, const char* Ks, const char* Krs, const bf16x8* qr, const char* qrl, int r32, int hi) {
  p0 = f32x16{}; p1 = f32x16{};
  if (ATT_PRIO & 1) __builtin_amdgcn_s_setprio(1);
#pragma unroll
  for (int d0 = 0; d0 < 8; ++d0) { const int cb = (d0 * 16 + hi * 8) * 2;
    const bf16x8 b0 = *reinterpret_cast<const bf16x8*>(Ks + KSWZ(r32, cb));
    const bf16x8 b1 = *reinterpret_cast<const bf16x8*>(Ks + KSWZ(32 + r32, cb));
    bf16x8 qv;
    constexpr int NQR = (DQK == 192) ? ATT_NQ192 : ATT_NQ128;
    if (d0 >= NQR) qv = *reinterpret_cast<const bf16x8*>(qrl + (4 + d0 - NQR) * 1024); else qv = qr[d0 < NQR ? d0 : 0];
    p0 = __builtin_amdgcn_mfma_f32_32x32x16_bf16(b0, qv, p0, 0, 0, 0);
    p1 = __builtin_amdgcn_mfma_f32_32x32x16_bf16(b1, qv, p1, 0, 0, 0); }
  if constexpr (DQK == 192) {
#pragma unroll
    for (int d0 = 0; d0 < 4; ++d0) { const int cb = (d0 * 16 + hi * 8) * 2;
      const bf16x8 b0 = *reinterpret_cast<const bf16x8*>(Krs + KRSWZ(r32, cb));
      const bf16x8 b1 = *reinterpret_cast<const bf16x8*>(Krs + KRSWZ(32 + r32, cb));
      const bf16x8 qv = *reinterpret_cast<const bf16x8*>(qrl + d0 * 1024);
      p0 = __builtin_amdgcn_mfma_f32_32x32x16_bf16(b0, qv, p0, 0, 0, 0);
      p1 = __builtin_amdgcn_mfma_f32_32x32x16_bf16(b1, qv, p1, 0, 0, 0); }
  }
  if (ATT_PRIO & 1) __builtin_amdgcn_s_setprio(0);
}
__device__ __forceinline__ void wmask(f32x16& p0, f32x16& p1, int dbase, int hi) {
#pragma unroll
  for (int r = 0; r < 16; ++r) { const int d0 = dbase + (r & 3) + 8 * (r >> 2) + 4 * hi, d1 = d0 + 32;
    if (d0 > 128 || d0 < -128) p0[r] = -1e30f;
    if (d1 > 128 || d1 < -128) p1[r] = -1e30f; }
}
__device__ __forceinline__ int v_st(int k, int c) { const int kk = (k & ~0xC) | ((k & 4) << 1) | ((k & 8) >> 1); return ((kk >> 3) * 4 + (c >> 5)) * 512 + ((kk & 7) * 32 + (c & 31)) * 2; }
__device__ __forceinline__ int v_rd_base(int lane) { return ((lane & 3) << 3) | (((lane >> 2) & 3) << 6) | (((lane >> 4) & 1) << 5) | (((lane >> 5) & 1) << 8); }
constexpr int v_rd_off(int d0, int ks, int half) { return d0 * 512 + ks * 4096 + half * 2048; }
template <int OFF> __device__ __forceinline__ s16x4 tr_read(int vb) {
  s16x4 r; asm volatile("ds_read_b64_tr_b16 %0, %1 offset:%2" : "=&v"(r) : "v"(vb), "i"(OFF) : "memory"); return r;
}
template <int D0> __device__ __forceinline__ void pv_one(f32x16& od, int vb, bf16x8 pa0, bf16x8 pa1, bf16x8 pa2, bf16x8 pa3) {
  const s16x4 l0 = tr_read<v_rd_off(D0, 0, 0)>(vb), h0 = tr_read<v_rd_off(D0, 0, 1)>(vb), l1 = tr_read<v_rd_off(D0, 1, 0)>(vb), h1 = tr_read<v_rd_off(D0, 1, 1)>(vb);
  const s16x4 l2 = tr_read<v_rd_off(D0, 2, 0)>(vb), h2 = tr_read<v_rd_off(D0, 2, 1)>(vb), l3 = tr_read<v_rd_off(D0, 3, 0)>(vb), h3 = tr_read<v_rd_off(D0, 3, 1)>(vb);
  asm volatile("s_waitcnt lgkmcnt(0)" ::: "memory"); SBAR();
  if (ATT_PRIO & 2) __builtin_amdgcn_s_setprio(1);
#define PK(L, H) (bf16x8){L[0], L[1], L[2], L[3], H[0], H[1], H[2], H[3]}
  od = __builtin_amdgcn_mfma_f32_32x32x16_bf16(pa0, PK(l0, h0), od, 0, 0, 0);
  od = __builtin_amdgcn_mfma_f32_32x32x16_bf16(pa1, PK(l1, h1), od, 0, 0, 0);
  od = __builtin_amdgcn_mfma_f32_32x32x16_bf16(pa2, PK(l2, h2), od, 0, 0, 0);
  od = __builtin_amdgcn_mfma_f32_32x32x16_bf16(pa3, PK(l3, h3), od, 0, 0, 0);
  if (ATT_PRIO & 2) __builtin_amdgcn_s_setprio(0);
#undef PK
}
__device__ __forceinline__ void pv_d0(f32x16* o, int vb, bf16x8 pa0, bf16x8 pa1, bf16x8 pa2, bf16x8 pa3) {
  pv_one<0>(o[0], vb, pa0, pa1, pa2, pa3); pv_one<1>(o[1], vb, pa0, pa1, pa2, pa3); pv_one<2>(o[2], vb, pa0, pa1, pa2, pa3); pv_one<3>(o[3], vb, pa0, pa1, pa2, pa3);
}

template <int DQK, int LDQ, int LDK, int LDV, int LDO, int SDEPTH>
__device__ __forceinline__ void attn_unit(const bf16_t* __restrict__ Qb, const bf16_t* __restrict__ Kh, const bf16_t* __restrict__ Krp, const bf16_t* __restrict__ Vh,
                                          bf16_t* __restrict__ Ob, const int NT, const int base1, const int wmode, const int qpos0, const float m_init, const float l_init, const float* rope_tbl, const float* gq, char* lds, const int tid_in) {
  constexpr int NQ = (DQK == 192) ? ATT_NQ192 : ATT_NQ128;
  int tid_ = tid_in; asm volatile("" : "+v"(tid_));
  const int tid = tid_, wid = tid >> 6, lane = tid & 63, r32 = lane & 31, hi = lane >> 5;
  char* V_lds = lds + OFF_V; char* K_lds = lds + OFF_K; char* KR_lds = lds + OFF_KR;
  float* ws = (float*)(lds + OFF_WS) + wid * 64; float* li_l = ws; float* al_l = ws + 32;
  float m_reg = m_init, l_reg = l_init; f32x16 o[4] = {}; bf16x8 qall[8];
  const bf16_t* Qw = Qb + (long)(wid * QBLK + r32) * LDQ + hi * 8;
#pragma unroll
  for (int d0 = 0; d0 < 8; ++d0) qall[d0] = *reinterpret_cast<const bf16x8*>(Qw + d0 * 16);
  if constexpr (DQK == 128) {
    if (rope_tbl) {
      float x[8][8];
#pragma unroll
      for (int d0 = 0; d0 < 8; ++d0) { const u32x4 w = __builtin_bit_cast(u32x4, qall[d0]);
#pragma unroll
        for (int i = 0; i < 4; ++i) { x[d0][2 * i] = __builtin_bit_cast(float, w[i] << 16); x[d0][2 * i + 1] = __builtin_bit_cast(float, w[i] & 0xffff0000u); } }
      if (gq) { float ss = 0.f;
#pragma unroll
        for (int d0 = 0; d0 < 8; ++d0)
#pragma unroll
          for (int i = 0; i < 8; ++i) ss += x[d0][i] * x[d0][i];
        { auto rr = __builtin_amdgcn_permlane32_swap(__float_as_uint(ss), __float_as_uint(ss), false, false); ss = __uint_as_float(rr[0]) + __uint_as_float(rr[1]); }
        const float r = 1.0f / sqrtf(ss * (1.0f / 128.0f) + 1e-6f);
#pragma unroll
        for (int d0 = 0; d0 < 8; ++d0)
#pragma unroll
          for (int i = 0; i < 8; ++i) x[d0][i] *= r * gq[16 * d0 + 8 * hi + i]; }
      const int t = qpos0 + wid * QBLK + r32;
#pragma unroll
      for (int a = 0; a < 2; ++a) { const int pos = a == 0 ? (t >> 6) : (t & 63);
#pragma unroll
        for (int e = 0; e < 2; ++e) { const float* ct = rope_tbl + (a == 0 ? 0 : 8192) + pos * 32 + 16 * e + 8 * hi; const float* st = ct + (a == 0 ? 4096 : 2048);
#pragma unroll
          for (int i = 0; i < 8; ++i) { const float c = ct[i], s_ = st[i], x1 = x[4 * a + e][i], x2 = x[4 * a + 2 + e][i]; x[4 * a + e][i] = x1 * c - x2 * s_; x[4 * a + 2 + e][i] = x2 * c + x1 * s_; } } }
#pragma unroll
      for (int d0 = 0; d0 < 8; ++d0) { u32x4 w;
#pragma unroll
        for (int i = 0; i < 4; ++i) w[i] = cvtpk(x[d0][2 * i], x[d0][2 * i + 1]);
        qall[d0] = __builtin_bit_cast(bf16x8, w); }
    }
  }
  char* qrl = lds + OFF_QR + wid * QR_WAVE + lane * 16;
  bf16x8 qr[NQ];
#pragma unroll
  for (int d0 = 0; d0 < NQ; ++d0) qr[d0] = qall[d0];
#pragma unroll
  for (int d0 = NQ; d0 < 8; ++d0) *reinterpret_cast<bf16x8*>(qrl + (4 + d0 - NQ) * 1024) = qall[d0];
  if constexpr (DQK == 192) {
    bf16x8 qf[4];
#pragma unroll
    for (int d0 = 0; d0 < 4; ++d0) qf[d0] = *reinterpret_cast<const bf16x8*>(Qw + 128 + d0 * 16);
    if (rope_tbl) {
      const int t = qpos0 + wid * QBLK + r32;
#pragma unroll
      for (int a = 0; a < 2; ++a) { const int pos = a == 0 ? (t >> 6) : (t & 63);
        const float* ct = rope_tbl + (a == 0 ? 12288 : 16384) + pos * 16 + hi * 8; const float* st = ct + (a == 0 ? 2048 : 1024);
        u32x4 w1 = __builtin_bit_cast(u32x4, qf[2 * a]), w2 = __builtin_bit_cast(u32x4, qf[2 * a + 1]), o1, o2;
#pragma unroll
        for (int i = 0; i < 4; ++i) { const float c0 = ct[2 * i], c1 = ct[2 * i + 1], s0 = st[2 * i], s1 = st[2 * i + 1];
          const float x1l = __builtin_bit_cast(float, w1[i] << 16), x1h = __builtin_bit_cast(float, w1[i] & 0xffff0000u), x2l = __builtin_bit_cast(float, w2[i] << 16), x2h = __builtin_bit_cast(float, w2[i] & 0xffff0000u);
          o1[i] = cvtpk(x1l * c0 - x2l * s0, x1h * c1 - x2h * s1); o2[i] = cvtpk(x2l * c0 + x1l * s0, x2h * c1 + x1h * s1); }
        qf[2 * a] = __builtin_bit_cast(bf16x8, o1); qf[2 * a + 1] = __builtin_bit_cast(bf16x8, o2); }
    }
#pragma unroll
    for (int d0 = 0; d0 < 4; ++d0) *reinterpret_cast<bf16x8*>(qrl + d0 * 1024) = qf[d0];
  }
  const int sr = tid >> 4, sc = (tid & 15) * 8, vst0 = v_st(sr, sc), vst1 = v_st(32 + sr, sc);
  const int krr = tid >> 3, krc = (tid & 7) * 8;
  const int vb0 = (int)(uintptr_t)V_lds + v_rd_base(lane);
  const int dq = -(qpos0 + wid * QBLK + r32) - 256;
  struct { bf16x8 vs0, vs1, ks0, ks1, kr; } sr_[SDEPTH];
  static_assert(!(ATT_KDMA && SDEPTH != 1), "LDS-DMA staging of K needs SDEPTH 1");
  typedef __attribute__((address_space(3))) unsigned lds_u32;
  const int widu = __builtin_amdgcn_readfirstlane(wid);
  const int kd_row = widu * 4 + (lane >> 4), kd_col = ((lane & 15) ^ (kd_row & KSWZ_MASK)) * 8;
  const int kd_off = kd_row * LDK + kd_col;
  const int kr_row = widu * 8 + (lane >> 3), kr_off = kr_row * 64 + (((lane & 7) ^ ((kr_row >> 1) & 7)) * 8);
  const unsigned lds_base = (unsigned)(uintptr_t)lds;
#define KROW(j) ((j) < 4 ? (j) * 64 : base1 + ((j) - 4) * 64)
#define SLOAD(i, k0, b) do { const int k0_ = (k0); sr_[i].vs0 = *reinterpret_cast<const bf16x8*>(&Vh[(long)(k0_ + sr) * LDV + sc]); sr_[i].vs1 = *reinterpret_cast<const bf16x8*>(&Vh[(long)(k0_ + 32 + sr) * LDV + sc]); \
    if constexpr (ATT_KDMA) { \
      __builtin_amdgcn_global_load_lds((const unsigned*)(Kh + (long)k0_ * LDK + kd_off), (lds_u32*)(uintptr_t)(lds_base + OFF_K + (b) * SHM_K + widu * 1024), 16, 0, 0); \
      __builtin_amdgcn_global_load_lds((const unsigned*)(Kh + (long)(k0_ + 32) * LDK + kd_off), (lds_u32*)(uintptr_t)(lds_base + OFF_K + (b) * SHM_K + 8192 + widu * 1024), 16, 0, 0); \
      if constexpr (DQK == 192) __builtin_amdgcn_global_load_lds((const unsigned*)(Krp + (long)k0_ * 64 + kr_off), (lds_u32*)(uintptr_t)(lds_base + OFF_KR + (b) * SHM_KR + widu * 1024), 16, 0, 0); \
    } else { \
    sr_[i].ks0 = *reinterpret_cast<const bf16x8*>(&Kh[(long)(k0_ + sr) * LDK + sc]); sr_[i].ks1 = *reinterpret_cast<const bf16x8*>(&Kh[(long)(k0_ + 32 + sr) * LDK + sc]); \
    if constexpr (DQK == 192) sr_[i].kr = *reinterpret_cast<const bf16x8*>(&Krp[(long)(k0_ + krr) * 64 + krc]); } } while (0)
#define SWRITE(b, i) do { *(bf16x8*)(V_lds + (b) * SHM_V + vst0) = sr_[i].vs0; *(bf16x8*)(V_lds + (b) * SHM_V + vst1) = sr_[i].vs1; \
    if constexpr (!ATT_KDMA) { const int kc = sc * 2; \
    *(bf16x8*)(K_lds + (b) * SHM_K + KSWZ(sr, kc)) = sr_[i].ks0; *(bf16x8*)(K_lds + (b) * SHM_K + KSWZ(32 + sr, kc)) = sr_[i].ks1; \
    if constexpr (DQK == 192) *(bf16x8*)(KR_lds + (b) * SHM_KR + KRSWZ(krr, krc * 2)) = sr_[i].kr; } } while (0)
#define SWAIT() do { if constexpr (SDEPTH == 1) asm volatile("s_waitcnt vmcnt(0)" ::: "memory"); else if constexpr (DQK == 192) asm volatile("s_waitcnt vmcnt(5)" ::: "memory"); else asm volatile("s_waitcnt vmcnt(4)" ::: "memory"); } while (0)
#define RESC(a) do { if (__any((a) < 1.f)) { if (hi == 0) al_l[r32] = (a); asm volatile("s_waitcnt lgkmcnt(0)" ::: "memory"); \
    _Pragma("unroll") for (int d = 0; d < 4; ++d) _Pragma("unroll") for (int r = 0; r < 16; ++r) o[d][r] *= al_l[crow(r, hi)]; } } while (0)
#define MASK(P0, P1, j) do { if (wmode && (j) >= 4) wmask(P0, P1, KROW(j) + dq, hi); } while (0)
  if (ATT_PRIO & 4) { if (__builtin_amdgcn_readfirstlane(wid) >= 4) __builtin_amdgcn_s_setprio(1); }
  f32x16 pA0, pA1, pB0, pB1; float mnA, mnB, alA, alB; bf16x8 pa0, pa1, pa2, pa3;
  if constexpr (ATT_VDMA == 2) {
  static_assert(ATT_KDMA && SDEPTH == 1 && (4 + 8 - NQ) * 1024 <= QR_WAVE + 4096 * (DQK == 128), "ATT_VDMA 2: all nope fragments of Q in VGPRs");
  const int vk0 = (widu >> 1) * 8 + ((lane & 31) >> 2), vkey = (vk0 & ~0xC) | ((vk0 & 4) << 1) | ((vk0 & 8) >> 1);
  const int vd_off = vkey * LDV + ((widu & 1) * 2 + (lane >> 5)) * 32 + (lane & 3) * 8;
  constexpr int NDMA = (DQK == 192) ? 5 : 4;
#define DMA_K(k0, ks) do { const int k0_ = (k0); const int ks_ = (ks); \
      __builtin_amdgcn_global_load_lds((const unsigned*)(Kh + (long)k0_ * LDK + kd_off), (lds_u32*)(uintptr_t)(lds_base + OFF_K + ks_ * SHM_K + widu * 1024), 16, 0, 0); \
      __builtin_amdgcn_global_load_lds((const unsigned*)(Kh + (long)(k0_ + 32) * LDK + kd_off), (lds_u32*)(uintptr_t)(lds_base + OFF_K + ks_ * SHM_K + 8192 + widu * 1024), 16, 0, 0); \
      if constexpr (DQK == 192) __builtin_amdgcn_global_load_lds((const unsigned*)(Krp + (long)k0_ * 64 + kr_off), (lds_u32*)(uintptr_t)(lds_base + OFF_KR + ks_ * SHM_KR + widu * 1024), 16, 0, 0); } while (0)
#define DMA_V(k0, vs) do { const int k0_ = (k0); const int vs_ = (vs); \
      __builtin_amdgcn_global_load_lds((const unsigned*)(Vh + (long)k0_ * LDV + vd_off), (lds_u32*)(uintptr_t)(lds_base + OFF_V + vs_ * SHM_V + widu * 1024), 16, 0, 0); \
      __builtin_amdgcn_global_load_lds((const unsigned*)(Vh + (long)(k0_ + 32) * LDV + vd_off), (lds_u32*)(uintptr_t)(lds_base + OFF_V + vs_ * SHM_V + 8192 + widu * 1024), 16, 0, 0); } while (0)
#define VM0_SYNC() do { asm volatile("s_waitcnt vmcnt(0)" ::: "memory"); __syncthreads(); } while (0)
#define VMN_SYNC() do { if constexpr (DQK == 192) asm volatile("s_waitcnt vmcnt(5)" ::: "memory"); else asm volatile("s_waitcnt vmcnt(4)" ::: "memory"); __syncthreads(); } while (0)
#define R3_PREV(s_) ((s_) >= 1 ? (s_) - 1 : 2)
#define R3_NEXT(s_) ((s_) == 2 ? 0 : (s_) + 1)
#define KT(t) KROW((t) < NT ? (t) : NT - 1)
  DMA_K(0, 0); DMA_V(0, 0); DMA_K(KROW(1), 1); DMA_V(KROW(1), 1); DMA_K(KROW(2), 2); VM0_SYNC();
  qkt<DQK>(pA0, pA1, K_lds, KR_lds, qr, qrl, r32, hi); partialSM<DQK>(pA0, pA1, m_reg, mnA, alA);
  __syncthreads();
  const bool stag = ((DQK == 128) ? (ATT_STAG & 1) : (ATT_STAG & 2)) && (__builtin_amdgcn_readfirstlane(wid) >= 4);
  int sp = 0;
  if (!stag) {
  for (int j = 1; j + 1 < NT; j += 2) {
    { const int kq = R3_NEXT(sp);
    SBAR(); qkt<DQK>(pB0, pB1, K_lds + kq * SHM_K, KR_lds + kq * SHM_KR, qr, qrl, r32, hi); MASK(pB0, pB1, j);
    finishSM(pA0, pA1, alA, l_reg, pa0, pa1, pa2, pa3); SBAR();
    DMA_K(KT(j + 2), sp); DMA_V(KROW(j + 1), R3_PREV(sp)); SBAR();
    pv_d0(o, vb0 + sp * SHM_V, pa0, pa1, pa2, pa3); partialSM<DQK>(pB0, pB1, m_reg, mnB, alB);
    VMN_SYNC(); RESC(alB); sp = kq; }
    { const int kq = R3_NEXT(sp);
    SBAR(); qkt<DQK>(pA0, pA1, K_lds + kq * SHM_K, KR_lds + kq * SHM_KR, qr, qrl, r32, hi); MASK(pA0, pA1, j + 1);
    finishSM(pB0, pB1, alB, l_reg, pa0, pa1, pa2, pa3); SBAR();
    DMA_K(KT(j + 3), sp); DMA_V(KROW(j + 2), R3_PREV(sp)); SBAR();
    pv_d0(o, vb0 + sp * SHM_V, pa0, pa1, pa2, pa3); partialSM<DQK>(pA0, pA1, m_reg, mnA, alA);
    VMN_SYNC(); RESC(alA); sp = kq; }
  }
  } else {
  for (int j = 1; j + 1 < NT; j += 2) {
    { const int kq = R3_NEXT(sp);
    SBAR(); finishSM(pA0, pA1, alA, l_reg, pa0, pa1, pa2, pa3); SBAR();
    qkt<DQK>(pB0, pB1, K_lds + kq * SHM_K, KR_lds + kq * SHM_KR, qr, qrl, r32, hi); MASK(pB0, pB1, j); SBAR();
    DMA_K(KT(j + 2), sp); DMA_V(KROW(j + 1), R3_PREV(sp)); SBAR();
    partialSM<DQK>(pB0, pB1, m_reg, mnB, alB); SBAR(); pv_d0(o, vb0 + sp * SHM_V, pa0, pa1, pa2, pa3);
    VMN_SYNC(); RESC(alB); sp = kq; }
    { const int kq = R3_NEXT(sp);
    SBAR(); finishSM(pB0, pB1, alB, l_reg, pa0, pa1, pa2, pa3); SBAR();
    qkt<DQK>(pA0, pA1, K_lds + kq * SHM_K, KR_lds + kq * SHM_KR, qr, qrl, r32, hi); MASK(pA0, pA1, j + 1); SBAR();
    DMA_K(KT(j + 3), sp); DMA_V(KROW(j + 2), R3_PREV(sp)); SBAR();
    partialSM<DQK>(pA0, pA1, m_reg, mnA, alA); SBAR(); pv_d0(o, vb0 + sp * SHM_V, pa0, pa1, pa2, pa3);
    VMN_SYNC(); RESC(alA); sp = kq; }
  }
  }
  { const int kq = R3_NEXT(sp);
  SBAR(); qkt<DQK>(pB0, pB1, K_lds + kq * SHM_K, KR_lds + kq * SHM_KR, qr, qrl, r32, hi); MASK(pB0, pB1, NT - 1);
  finishSM(pA0, pA1, alA, l_reg, pa0, pa1, pa2, pa3); SBAR();
  pv_d0(o, vb0 + sp * SHM_V, pa0, pa1, pa2, pa3); partialSM<DQK>(pB0, pB1, m_reg, mnB, alB);
  VM0_SYNC(); RESC(alB); sp = kq; }
  finishSM(pB0, pB1, alB, l_reg, pa0, pa1, pa2, pa3); SBAR();
  pv_d0(o, vb0 + sp * SHM_V, pa0, pa1, pa2, pa3);
#undef DMA_K
#undef DMA_V
#undef VM0_SYNC
#undef VMN_SYNC
#undef R3_PREV
#undef R3_NEXT
#undef KT
  } else if constexpr (ATT_VDMA == 1) {
  static_assert(ATT_KDMA && SDEPTH == 1, "ATT_VDMA builds on ATT_KDMA");
  const int vk0 = (widu >> 1) * 8 + ((lane & 31) >> 2), vkey = (vk0 & ~0xC) | ((vk0 & 4) << 1) | ((vk0 & 8) >> 1);
  const int vd_off = vkey * LDV + ((widu & 1) * 2 + (lane >> 5)) * 32 + (lane & 3) * 8;
#define DMA_KV(k0, kb, vsl) do { const int k0_ = (k0); \
      __builtin_amdgcn_global_load_lds((const unsigned*)(Kh + (long)k0_ * LDK + kd_off), (lds_u32*)(uintptr_t)(lds_base + OFF_K + (kb) * SHM_K + widu * 1024), 16, 0, 0); \
      __builtin_amdgcn_global_load_lds((const unsigned*)(Kh + (long)(k0_ + 32) * LDK + kd_off), (lds_u32*)(uintptr_t)(lds_base + OFF_K + (kb) * SHM_K + 8192 + widu * 1024), 16, 0, 0); \
      if constexpr (DQK == 192) __builtin_amdgcn_global_load_lds((const unsigned*)(Krp + (long)k0_ * 64 + kr_off), (lds_u32*)(uintptr_t)(lds_base + OFF_KR + (kb) * SHM_KR + widu * 1024), 16, 0, 0); \
      __builtin_amdgcn_global_load_lds((const unsigned*)(Vh + (long)k0_ * LDV + vd_off), (lds_u32*)(uintptr_t)(lds_base + OFF_V + (vsl) + widu * 1024), 16, 0, 0); \
      __builtin_amdgcn_global_load_lds((const unsigned*)(Vh + (long)(k0_ + 32) * LDV + vd_off), (lds_u32*)(uintptr_t)(lds_base + OFF_V + (vsl) + 8192 + widu * 1024), 16, 0, 0); } while (0)
#define VM0_SYNC() do { asm volatile("s_waitcnt vmcnt(0)" ::: "memory"); __syncthreads(); } while (0)
#define VS_DMA(sp_) (((sp_) >= 1 ? (sp_) - 1 : 2) * SHM_V)
#define VS_NEXT(sp_) ((sp_) == 2 ? 0 : (sp_) + 1)
  DMA_KV(0, 0, 0); VM0_SYNC();
  qkt<DQK>(pA0, pA1, K_lds, KR_lds, qr, qrl, r32, hi); partialSM<DQK>(pA0, pA1, m_reg, mnA, alA);
  DMA_KV(KROW(1), 1, SHM_V); VM0_SYNC();
  const bool stag = ((DQK == 128) ? (ATT_STAG & 1) : (ATT_STAG & 2)) && (__builtin_amdgcn_readfirstlane(wid) >= 4);
  int sp = 0;
  if (!stag) {
  for (int j = 1; j + 1 < NT; j += 2) {
    SBAR(); qkt<DQK>(pB0, pB1, K_lds + SHM_K, KR_lds + SHM_KR, qr, qrl, r32, hi); MASK(pB0, pB1, j);
    finishSM(pA0, pA1, alA, l_reg, pa0, pa1, pa2, pa3); SBAR();
    DMA_KV(KROW(j + 1), 0, VS_DMA(sp)); SBAR();
    pv_d0(o, vb0 + sp * SHM_V, pa0, pa1, pa2, pa3); partialSM<DQK>(pB0, pB1, m_reg, mnB, alB);
    VM0_SYNC(); RESC(alB); sp = VS_NEXT(sp);
    SBAR(); qkt<DQK>(pA0, pA1, K_lds, KR_lds, qr, qrl, r32, hi); MASK(pA0, pA1, j + 1);
    finishSM(pB0, pB1, alB, l_reg, pa0, pa1, pa2, pa3); SBAR();
    DMA_KV(KROW(j + 2), 1, VS_DMA(sp)); SBAR();
    pv_d0(o, vb0 + sp * SHM_V, pa0, pa1, pa2, pa3); partialSM<DQK>(pA0, pA1, m_reg, mnA, alA);
    VM0_SYNC(); RESC(alA); sp = VS_NEXT(sp);
  }
  } else {
  for (int j = 1; j + 1 < NT; j += 2) {
    SBAR(); finishSM(pA0, pA1, alA, l_reg, pa0, pa1, pa2, pa3); SBAR();
    qkt<DQK>(pB0, pB1, K_lds + SHM_K, KR_lds + SHM_KR, qr, qrl, r32, hi); MASK(pB0, pB1, j); SBAR();
    DMA_KV(KROW(j + 1), 0, VS_DMA(sp)); SBAR();
    partialSM<DQK>(pB0, pB1, m_reg, mnB, alB); SBAR(); pv_d0(o, vb0 + sp * SHM_V, pa0, pa1, pa2, pa3);
    VM0_SYNC(); RESC(alB); sp = VS_NEXT(sp);
    SBAR(); finishSM(pB0, pB1, alB, l_reg, pa0, pa1, pa2, pa3); SBAR();
    qkt<DQK>(pA0, pA1, K_lds, KR_lds, qr, qrl, r32, hi); MASK(pA0, pA1, j + 1); SBAR();
    DMA_KV(KROW(j + 2), 1, VS_DMA(sp)); SBAR();
    partialSM<DQK>(pA0, pA1, m_reg, mnA, alA); SBAR(); pv_d0(o, vb0 + sp * SHM_V, pa0, pa1, pa2, pa3);
    VM0_SYNC(); RESC(alA); sp = VS_NEXT(sp);
  }
  }
  SBAR(); qkt<DQK>(pB0, pB1, K_lds + SHM_K, KR_lds + SHM_KR, qr, qrl, r32, hi); MASK(pB0, pB1, NT - 1);
  finishSM(pA0, pA1, alA, l_reg, pa0, pa1, pa2, pa3); SBAR();
  pv_d0(o, vb0 + sp * SHM_V, pa0, pa1, pa2, pa3); partialSM<DQK>(pB0, pB1, m_reg, mnB, alB);
  RESC(alB); sp = VS_NEXT(sp);
  finishSM(pB0, pB1, alB, l_reg, pa0, pa1, pa2, pa3); SBAR();
  pv_d0(o, vb0 + sp * SHM_V, pa0, pa1, pa2, pa3);
#undef DMA_KV
#undef VM0_SYNC
#undef VS_DMA
#undef VS_NEXT
  } else {
  constexpr int SE = 0, SO = SDEPTH - 1;
  SLOAD(SE, 0, 0); asm volatile("s_waitcnt vmcnt(0)" ::: "memory"); SWRITE(0, SE); __syncthreads();
  qkt<DQK>(pA0, pA1, K_lds, KR_lds, qr, qrl, r32, hi); partialSM<DQK>(pA0, pA1, m_reg, mnA, alA);
  SLOAD(SO, KROW(1), 1); if constexpr (SDEPTH == 2) { if (2 < NT) SLOAD(SE, KROW(2), 0); }
  SWAIT(); SWRITE(1, SO); __syncthreads();
  const bool stag = ((DQK == 128) ? (ATT_STAG & 1) : (ATT_STAG & 2)) && (__builtin_amdgcn_readfirstlane(wid) >= 4);
  if (!stag) {
  for (int j = 1; j + 1 < NT; j += 2) {
    SBAR(); qkt<DQK>(pB0, pB1, K_lds + SHM_K, KR_lds + SHM_KR, qr, qrl, r32, hi); MASK(pB0, pB1, j);
    finishSM(pA0, pA1, alA, l_reg, pa0, pa1, pa2, pa3); SBAR();
    SLOAD(SO, KROW(j + SDEPTH), 0); SBAR();
    pv_d0(o, vb0, pa0, pa1, pa2, pa3); partialSM<DQK>(pB0, pB1, m_reg, mnB, alB);
    __syncthreads(); SWAIT(); SWRITE(0, SE);
    RESC(alB); __syncthreads();
    SBAR(); qkt<DQK>(pA0, pA1, K_lds, KR_lds, qr, qrl, r32, hi); MASK(pA0, pA1, j + 1);
    finishSM(pB0, pB1, alB, l_reg, pa0, pa1, pa2, pa3); SBAR();
    if (SDEPTH == 1 || j + 3 < NT) SLOAD(SE, KROW(j + 1 + SDEPTH), 1); SBAR();
    pv_d0(o, vb0 + SHM_V, pa0, pa1, pa2, pa3); partialSM<DQK>(pA0, pA1, m_reg, mnA, alA);
    __syncthreads(); SWAIT(); SWRITE(1, SO);
    RESC(alA); __syncthreads();
  }
  } else {
  for (int j = 1; j + 1 < NT; j += 2) {
    SBAR(); finishSM(pA0, pA1, alA, l_reg, pa0, pa1, pa2, pa3); SBAR();
    qkt<DQK>(pB0, pB1, K_lds + SHM_K, KR_lds + SHM_KR, qr, qrl, r32, hi); MASK(pB0, pB1, j); SBAR();
    SLOAD(SO, KROW(j + SDEPTH), 0); SBAR();
    partialSM<DQK>(pB0, pB1, m_reg, mnB, alB); SBAR(); pv_d0(o, vb0, pa0, pa1, pa2, pa3);
    __syncthreads(); SWAIT(); SWRITE(0, SE);
    RESC(alB); __syncthreads();
    SBAR(); finishSM(pB0, pB1, alB, l_reg, pa0, pa1, pa2, pa3); SBAR();
    qkt<DQK>(pA0, pA1, K_lds, KR_lds, qr, qrl, r32, hi); MASK(pA0, pA1, j + 1); SBAR();
    if (SDEPTH == 1 || j + 3 < NT) SLOAD(SE, KROW(j + 1 + SDEPTH), 1); SBAR();
    partialSM<DQK>(pA0, pA1, m_reg, mnA, alA); SBAR(); pv_d0(o, vb0 + SHM_V, pa0, pa1, pa2, pa3);
    __syncthreads(); SWAIT(); SWRITE(1, SO);
    RESC(alA); __syncthreads();
  }
  }
  SBAR(); qkt<DQK>(pB0, pB1, K_lds + SHM_K, KR_lds + SHM_KR, qr, qrl, r32, hi); MASK(pB0, pB1, NT - 1);
  finishSM(pA0, pA1, alA, l_reg, pa0, pa1, pa2, pa3); SBAR();
  pv_d0(o, vb0, pa0, pa1, pa2, pa3); partialSM<DQK>(pB0, pB1, m_reg, mnB, alB);
  __syncthreads(); RESC(alB);
  finishSM(pB0, pB1, alB, l_reg, pa0, pa1, pa2, pa3); SBAR();
  pv_d0(o, vb0 + SHM_V, pa0, pa1, pa2, pa3);
  }
  if (ATT_PRIO & 4) __builtin_amdgcn_s_setprio(0);
  if (hi == 0) li_l[r32] = l_reg; asm volatile("s_waitcnt lgkmcnt(0)" ::: "memory");
  float rli[16];
#pragma unroll
  for (int r = 0; r < 16; ++r) rli[r] = __builtin_amdgcn_rcpf(li_l[crow(r, hi)]);
  __syncthreads();
  { bf16_t* stg = (bf16_t*)(lds + wid * 8192);
#pragma unroll
    for (int r = 0; r < 16; r += 2) { const int orow = crow(r, hi);
#pragma unroll
      for (int d0 = 0; d0 < 4; ++d0) { const unsigned pk = cvtpk(o[d0][r] * rli[r], o[d0][r + 1] * rli[r + 1]);
        stg[orow * 128 + d0 * 32 + r32] = (bf16_t)(pk & 0xffffu); stg[(orow + 1) * 128 + d0 * 32 + r32] = (bf16_t)(pk >> 16); } }
    asm volatile("s_waitcnt lgkmcnt(0)" ::: "memory");
    bf16_t* Ow = Ob + (long)(wid * QBLK) * LDO;
#pragma unroll
    for (int i = 0; i < 8; ++i) { const int ch = i * 64 + lane, row = ch >> 4, c8 = (ch & 15) * 8;
      const u32x4 v = *(const u32x4*)(stg + row * 128 + c8); *(u32x4*)(Ow + (long)row * LDO + c8) = v; }
  }
  __syncthreads();
#undef KROW
#undef SLOAD
#undef SWRITE
#undef SWAIT
#undef RESC
#undef MASK
}
#undef KSWZ
#undef KRSWZ
#undef SBAR
}

constexpr int NWAVES = 8;
constexpr size_t MiB = 1u << 20;
constexpr size_t WS_CTL = 0, CTL_ZERO_BYTES = 2 * MiB;
constexpr size_t WS_MOD = 1 * MiB;
constexpr size_t WS_TBL = 2 * MiB;
constexpr size_t SZ_WGU = (size_t)2 * DFF * DM * 2, SZ_WDN = (size_t)DM * DFF * 2;
constexpr size_t WS_WGU = 4 * MiB;
constexpr size_t WS_WDN = WS_WGU + 8 * SZ_WGU;
constexpr size_t SZ_WINAB = (size_t)AB_IN * DM * 2, SZ_WSQ = (size_t)DM * DM * 2, SZ_WINC = (size_t)C_IN_PAD * DM * 2, SZ_WUQ = (size_t)MLA_QOUT * QRANK * 2, SZ_WUKV = (size_t)MLA_KVOUT * KVRANK * 2;
constexpr size_t WS_WINAB = WS_WDN + 8 * SZ_WDN;
constexpr size_t WS_WOUTAB = WS_WINAB + 2 * SZ_WINAB;
constexpr size_t WS_WINC = WS_WOUTAB + 2 * SZ_WSQ;
constexpr size_t WS_WUQ = WS_WINC + 2 * SZ_WINC;
constexpr size_t WS_WUKV = WS_WUQ + 2 * SZ_WUQ;
constexpr size_t WS_WOUTC = WS_WUKV + 2 * SZ_WUKV;
constexpr size_t WS_X = WS_WOUTC + 2 * SZ_WSQ;
constexpr size_t WS_XN = WS_X + (size_t)MROWS * DM * 4;
constexpr size_t WS_H = WS_XN + (size_t)MROWS * DM * 2;
constexpr size_t WS_QKV = WS_H + (size_t)MROWS * DFF * 2;
constexpr size_t WS_KV = WS_QKV + (size_t)MROWS * 3072 * 2;
constexpr size_t WS_CQ = WS_KV + (size_t)MROWS * 4096 * 2;
constexpr size_t WS_CQN = WS_CQ + (size_t)MROWS * 1024 * 2;
constexpr size_t WS_CKVN = WS_CQN + (size_t)MROWS * 512 * 2;
constexpr size_t WS_KR = WS_CKVN + (size_t)MROWS * 256 * 2;
constexpr size_t WS_O = WS_KR + (size_t)MROWS * 64 * 2;
constexpr size_t WS_PARTC = WS_O + (size_t)MROWS * DM * 2;
constexpr size_t WS_PIN = WS_PARTC + (size_t)11 * 512 * DM * 4;
constexpr size_t WS_END = WS_PIN + (size_t)8 * 512 * 3072 * 4;
static_assert(WS_WGU % 256 == 0 && WS_X % 256 == 0 && WS_O % 256 == 0, "alignment");
constexpr int T_HRC = 0, T_HRS = 4096, T_HCC = 8192, T_HCS = 10240, T_MRC = 12288, T_MRS = 14336, T_MCC = 16384, T_MCS = 17408, T_END = 18432;
constexpr int CW_BAR = 4096;
constexpr int RING_OFF = 0, RING_BYTES = 131072, LDS_BYTES = 163840, LDSCTL_OFF = LDS_BYTES - 1024, MISC_OFF = LDSCTL_OFF + 320;
static_assert(att::LDS_BYTES <= LDSCTL_OFF, "attention scratch vs control words");

#define GAS __attribute__((address_space(1)))
#define LAS __attribute__((address_space(3)))
typedef unsigned short bf16;
typedef unsigned v4u __attribute__((ext_vector_type(4)));
typedef unsigned v2u __attribute__((ext_vector_type(2)));
typedef float f32x4 __attribute__((ext_vector_type(4)));
typedef GAS unsigned gu32;
#define RLX_AGENT __ATOMIC_RELAXED, __HIP_MEMORY_SCOPE_AGENT
#define LDS_WAIT() asm volatile("s_waitcnt lgkmcnt(0)" ::: "memory")
__device__ __forceinline__ unsigned f2bf(float f) { unsigned u = __builtin_bit_cast(unsigned, f); return (u + 0x7fffu + ((u >> 16) & 1u)) >> 16; }
__device__ __forceinline__ unsigned pk2(float lo, float hi) { return f2bf(lo) | (f2bf(hi) << 16); }
__device__ __forceinline__ float bf2f(unsigned short h) { return __builtin_bit_cast(float, (unsigned)h << 16); }
__device__ __forceinline__ float bflo(unsigned w) { return __builtin_bit_cast(float, w << 16); }
__device__ __forceinline__ float bfhi(unsigned w) { return __builtin_bit_cast(float, w & 0xffff0000u); }
__device__ __forceinline__ float wave_sum(float v) {
    const int l4 = lane_id_fresh() << 2;
#pragma unroll
    for (int o = 1; o < 64; o <<= 1) v += __builtin_bit_cast(float, __builtin_amdgcn_ds_bpermute(l4 ^ (o << 2), __builtin_bit_cast(int, v)));
    return v;
}

#define XB_TMO      128
#define XB_XCNT(j)  (256  + 64 * (j))
#define XB_XSUB(j)  (1280 + 64 * (j))
#define XB_XGEN(j)  (2304 + 64 * (j))
#define XB_TOP      3328
#define XB_TOPGEN   3392
#define XCD_BAR_WORDS 3456
#define XB_SPIN_CAP (1u << 18)

__device__ __forceinline__ unsigned xb_ld(unsigned* p)              { return __hip_atomic_load(p, __ATOMIC_RELAXED, __HIP_MEMORY_SCOPE_AGENT); }
__device__ __forceinline__ unsigned xb_add(unsigned* p, unsigned v) { return __hip_atomic_fetch_add(p, v, __ATOMIC_RELAXED, __HIP_MEMORY_SCOPE_AGENT); }
__device__ __forceinline__ unsigned xb_xcc_id() { return (unsigned)__builtin_amdgcn_s_getreg((3 << 11) | 20) & 0xFu; }
#define XB_SPIN(cond, bar) do { unsigned _sp = 0; while (cond) { __builtin_amdgcn_s_sleep(1); \
    if ((++_sp & 255u) == 0u) { if (xb_ld(&(bar)[XB_TMO])) break; if (_sp > XB_SPIN_CAP) { atomicAdd(&(bar)[XB_TMO], 1u); break; } } } } while (0)

struct XcdBarrier {
    unsigned* bar; unsigned x;
    volatile LAS unsigned* st;
};

__device__ __forceinline__ XcdBarrier xcd_barrier_post(unsigned* bar, volatile LAS unsigned* st, const bool t0) {
    XcdBarrier b; b.bar = bar; b.x = xb_xcc_id(); b.st = st;
    if (t0) (void)xb_add(&bar[XB_XCNT(b.x)], 1u);
    return b;
}
__device__ __forceinline__ void xcd_barrier_complete(unsigned* bar, unsigned x, unsigned& nloc, unsigned& nx) {
    const unsigned G = gridDim.x * gridDim.y * gridDim.z;
    unsigned sum, cnt, mine, sp = 0u;
    for (;;) {
        sum = 0u; cnt = 0u; mine = 0u;
#pragma unroll
        for (unsigned j = 0; j < 16; ++j) { const unsigned c = xb_ld(&bar[XB_XCNT(j)]); sum += c; cnt += (c > 0u) ? 1u : 0u; mine = (j == x) ? c : mine; }
        if (sum == G) break;
        __builtin_amdgcn_s_sleep(1);
        if ((++sp & 255u) == 0u) { if (xb_ld(&bar[XB_TMO])) break; if (sp > XB_SPIN_CAP) { atomicAdd(&bar[XB_TMO], 1u); break; } }
    }
    nloc = mine > 0u ? mine : 1u; nx = cnt > 0u ? cnt : 1u;
}

__device__ __forceinline__ void xcd_barrier(const XcdBarrier& b, const bool t0) {
    asm volatile("s_waitcnt vmcnt(0)" ::: "memory");
    __syncthreads();
    if (t0) {
        unsigned* bar = b.bar;
        __builtin_amdgcn_s_waitcnt(0);
        unsigned nloc = b.st[0], nx = b.st[1];
        if (nloc == 0u) { xcd_barrier_complete(bar, b.x, nloc, nx); b.st[0] = nloc; b.st[1] = nx; }
        const unsigned old = xb_add(&bar[XB_XSUB(b.x)], 1u);
        const unsigned gen = old / nloc;
        if (old + 1u == (gen + 1u) * nloc) {
            __builtin_amdgcn_fence(__ATOMIC_RELEASE, "agent");
            asm volatile("s_waitcnt vmcnt(0)" ::: "memory");
            const unsigned og = xb_add(&bar[XB_TOP], 1u);
            const unsigned tg = og / nx;
            if (og + 1u == (tg + 1u) * nx) xb_add(&bar[XB_TOPGEN], 1u);
            else XB_SPIN(xb_ld(&bar[XB_TOPGEN]) == tg, bar);
            __builtin_amdgcn_fence(__ATOMIC_ACQUIRE, "agent");
            xb_add(&bar[XB_XGEN(b.x)], 1u);
            asm volatile("s_waitcnt vmcnt(0)" ::: "memory");
        } else {
            XB_SPIN(xb_ld(&bar[XB_XGEN(b.x)]) == gen, bar);
            __builtin_amdgcn_fence(__ATOMIC_ACQUIRE, "agent");
            asm volatile("s_waitcnt vmcnt(0)" ::: "memory");
        }
    }
    __syncthreads();
}
__device__ __forceinline__ void p0_mod(const float* __restrict__ c, const float* __restrict__ cctx, const float* __restrict__ wmod, float* PART,
                                       LAS unsigned char* lds, int tid, int wave, int lane) {
    LAS float* sv = (LAS float*)lds;
    LAS float* red = (LAS float*)(lds + 24576);
    for (int i = tid; i < 3 * 2048; i += 512) { const int v = i >> 11, k = i & 2047; const float x = v < 2 ? c[v * 2048 + k] : cctx[k]; sv[i] = x / (1.0f + expf(-x)); }
    __syncthreads();
    for (int t = blockIdx.x; t < 2304; t += gridDim.x) {
        const int l = t / 576, rem = t - l * 576, nch = rem >> 3, kch = rem & 7;
        const int k0 = kch * 256 + wave * 32;
        const float* W = wmod + ((size_t)l * 2048 + k0) * 18432 + nch * 256 + lane * 4;
        f32x4 a0 = {0.f, 0.f, 0.f, 0.f}, a1 = a0, a2 = a0;
#pragma unroll 8
        for (int kk = 0; kk < 32; ++kk) { const f32x4 w = NT_W ? __builtin_nontemporal_load((const f32x4*)(W + (size_t)kk * 18432)) : *(const f32x4*)(W + (size_t)kk * 18432);
            a0 += sv[k0 + kk] * w; a1 += sv[2048 + k0 + kk] * w; a2 += sv[4096 + k0 + kk] * w; }
#pragma unroll
        for (int j = 0; j < 4; ++j) { red[(wave * 12 + j) * 64 + lane] = a0[j]; red[(wave * 12 + 4 + j) * 64 + lane] = a1[j]; red[(wave * 12 + 8 + j) * 64 + lane] = a2[j]; }
        __syncthreads();
        for (int idx = tid; idx < 768; idx += 512) { const int v = idx >> 8, cc = idx & 255, ln = cc >> 2, j = cc & 3; float s = 0.f;
#pragma unroll
            for (int w = 0; w < 8; ++w) s += red[(w * 12 + v * 4 + j) * 64 + ln];
            PART[(size_t)((l * 8 + kch) * 3 + v) * 18432 + nch * 256 + cc] = s; }
        __syncthreads();
    }
}
__device__ __forceinline__ void p0_mod_sum(const float* PART, const float* __restrict__ bmod, float* MOD, int gtid, int NT_) {
    for (int i = gtid; i < DEPTH * 3 * 18432; i += NT_) { const int l = i / (3 * 18432), r = i - l * 3 * 18432, v = r / 18432, n = r - v * 18432;
        float s = bmod[(size_t)l * 18432 + n];
#pragma unroll
        for (int k = 0; k < 8; ++k) s += PART[(size_t)((l * 8 + k) * 3 + v) * 18432 + n];
        MOD[i] = s; }
}
template <int MAP>
__device__ __forceinline__ void p0_transpose_item(const float* __restrict__ W, int K, int N, bf16* WT, LAS float* scr, int item, int lane) {
    const int nblk = N / 32, kb = item / nblk, nb = item - kb * nblk, k0 = 64 * kb, n0 = 32 * nb;
#pragma unroll 16
    for (int i = 0; i < 32; ++i) { const int kk = 2 * i + (lane >> 5); const float* wp = W + (size_t)(k0 + kk) * N + n0 + (lane & 31); scr[kk * 33 + (lane & 31)] = NT_W ? __builtin_nontemporal_load(wp) : *wp; }
    LDS_WAIT(); asm volatile("" ::: "memory");
    int r0 = n0;
    if (MAP == 1) { r0 = n0 < DFF ? (n0 / 128) * 256 + (n0 % 128) : ((n0 - DFF) / 128) * 256 + 128 + ((n0 - DFF) % 128); }
    const int c = lane & 7;
#pragma unroll
    for (int j = 0; j < 4; ++j) { const int n = (lane >> 3) + 8 * j; const LAS float* s = scr + (8 * c) * 33 + n;
        v4u o; o.x = pk2(s[0 * 33], s[1 * 33]); o.y = pk2(s[2 * 33], s[3 * 33]); o.z = pk2(s[4 * 33], s[5 * 33]); o.w = pk2(s[6 * 33], s[7 * 33]);
        *(GAS v4u*)(WT + (size_t)(r0 + n) * K + k0 + 8 * c) = o; }
    LDS_WAIT(); asm volatile("" ::: "memory");
}
__device__ __forceinline__ double my_exp(double y) {
    const double t = y * (1.0 / 1024.0); double e = 1.0, term = 1.0;
#pragma unroll
    for (int i = 1; i <= 10; ++i) { term *= t * (1.0 / i); e += term; }
#pragma unroll
    for (int i = 0; i < 10; ++i) e *= e;
    return e;
}
__device__ __forceinline__ void my_sincos(double x, double& s, double& c) {
    const double k = __builtin_rint(x * 0.15915494309189535);
    const double r = (x - k * 6.283185307179586) - k * 2.4492935982947064e-16;
    const double r2 = r * r; double cs = 1.0, sn = r, tc = 1.0, ts = r;
#pragma unroll
    for (int i = 1; i <= 16; ++i) { tc *= -r2 * (1.0 / ((2.0 * i - 1.0) * (2.0 * i))); cs += tc; ts *= -r2 * (1.0 / ((2.0 * i) * (2.0 * i + 1.0))); sn += ts; }
    s = sn; c = cs;
}

__device__ __forceinline__ void convert_layer(const float* __restrict__ wgu, const float* __restrict__ wdn, const float* __restrict__ winab, const float* __restrict__ woutab, const float* __restrict__ winc,
                                              const float* __restrict__ wuq, const float* __restrict__ wukv, const float* __restrict__ woutc, unsigned char* ws,
                                              int ly, int part, int nparts, int widx, int nw, LAS float* scr, int lane) {
    constexpr int I_GU = 32 * 352, I_DN = 88 * 64, I_INAB = 32 * 96, I_SQ = 32 * 64, I_INC = 32 * 26, I_UQ = 8 * 96, I_UKV = 4 * 128;
    const bool odd = (ly & 1) != 0; const int mi = ly >> 1;
    const int NI = 2 * I_GU + 2 * I_DN + (odd ? I_INC + I_UQ + I_UKV + I_SQ : I_INAB + I_SQ);
    const int lo = (int)((long)NI * part / nparts), hi = (int)((long)NI * (part + 1) / nparts);
    for (int it = lo + widx; it < hi; it += nw) {
        int r = it;
        if (r < 2 * I_GU) { const int m = 2 * ly + r / I_GU; p0_transpose_item<1>(wgu + (size_t)m * DM * 2 * DFF, DM, 2 * DFF, (bf16*)(ws + WS_WGU) + (size_t)m * 2 * DFF * DM, scr, r % I_GU, lane); continue; } r -= 2 * I_GU;
        if (r < 2 * I_DN) { const int m = 2 * ly + r / I_DN; p0_transpose_item<0>(wdn + (size_t)m * DFF * DM, DFF, DM, (bf16*)(ws + WS_WDN) + (size_t)m * DM * DFF, scr, r % I_DN, lane); continue; } r -= 2 * I_DN;
        if (!odd) {
            if (r < I_INAB) { p0_transpose_item<0>(winab + (size_t)mi * DM * AB_IN, DM, AB_IN, (bf16*)(ws + WS_WINAB) + (size_t)mi * AB_IN * DM, scr, r, lane); continue; } r -= I_INAB;
            p0_transpose_item<0>(woutab + (size_t)mi * DM * DM, DM, DM, (bf16*)(ws + WS_WOUTAB) + (size_t)mi * DM * DM, scr, r, lane);
        } else {
            if (r < I_INC) { p0_transpose_item<0>(winc + (size_t)mi * DM * C_IN, DM, C_IN, (bf16*)(ws + WS_WINC) + (size_t)mi * C_IN_PAD * DM, scr, r, lane); continue; } r -= I_INC;
            if (r < I_UQ) { p0_transpose_item<0>(wuq + (size_t)mi * QRANK * MLA_QOUT, QRANK, MLA_QOUT, (bf16*)(ws + WS_WUQ) + (size_t)mi * MLA_QOUT * QRANK, scr, r, lane); continue; } r -= I_UQ;
            if (r < I_UKV) { p0_transpose_item<0>(wukv + (size_t)mi * KVRANK * MLA_KVOUT, KVRANK, MLA_KVOUT, (bf16*)(ws + WS_WUKV) + (size_t)mi * MLA_KVOUT * KVRANK, scr, r, lane); continue; } r -= I_UKV;
            p0_transpose_item<0>(woutc + (size_t)mi * DM * DM, DM, DM, (bf16*)(ws + WS_WOUTC) + (size_t)mi * DM * DM, scr, r, lane);
        }
    }
}

__device__ __forceinline__ int blk_xr(int q, int NGW) { if (!NORM_BLOCKED || NGW != 2048) return q; const int k = q >> 11, w = q & 2047; return (w >> 8) * 2048 + k * 256 + (w & 255); }

__device__ __forceinline__ void norm_phase(const float* __restrict__ xin, const float* __restrict__ cin, bf16* X, bf16* XN, const float* __restrict__ g, const float* modl, int jmod, bool first,
                                           const float* PART, int pS, const float* pgate, float pcoef, int gw, int NGW, int lane) {
    asm volatile("" : "+v"(lane));
    for (int q = gw; q < (NORM_BLOCKED ? NB * SEQ + NGW : MROWS); q += NGW) {
        int row = q;
        if (NORM_BLOCKED) {
            if (q < NB * SEQ) { const int k = q / NGW, w = q - k * NGW, xr = (w >> 8) * 2048 + k * 256 + (w & 255); row = (xr >> 13) * RPB + CTXL + (xr & (SEQ - 1)); }
            else { const int w = q - NB * SEQ; if (w & 3) continue; const int cr = w >> 2; if (cr >= NB * CTXL) continue; row = (cr >> 8) * RPB + (cr & (CTXL - 1)); }
        }
        const int b = row >= RPB ? 1 : 0, rr = row - b * RPB; const bool isctx = rr < CTXL; const int v = isctx ? 2 : b;
        f32x4 x[4][2]; float ss = 0.f;
        if (first) { const float* src = isctx ? cin + (size_t)(b * CTXL + rr) * DM : xin + (size_t)(b * SEQ + rr - CTXL) * DM;
#pragma unroll
            for (int i = 0; i < 4; ++i) { x[i][0] = *(const f32x4*)(src + 8 * (lane + 64 * i)); x[i][1] = *(const f32x4*)(src + 8 * (lane + 64 * i) + 4); } }
        else { const bf16* src = X + (size_t)row * DM;
#pragma unroll
            for (int i = 0; i < 4; ++i) { const v4u w = *(const v4u*)(src + 8 * (lane + 64 * i));
                x[i][0] = (f32x4){bflo(w.x), bfhi(w.x), bflo(w.y), bfhi(w.y)}; x[i][1] = (f32x4){bflo(w.z), bfhi(w.z), bflo(w.w), bfhi(w.w)}; } }
        const bool pend = isctx && pS > 0;
        if (pend) { const float* pp = PART + (size_t)(b * CTXL + rr) * DM + 8 * lane;
            f32x4 sacc[4][2];
#pragma unroll
            for (int i = 0; i < 4; ++i) { sacc[i][0] = (f32x4){0.f, 0.f, 0.f, 0.f}; sacc[i][1] = sacc[i][0]; }
            for (int k0 = 0; k0 < pS; k0 += 4) { f32x4 t[4][4][2];
#pragma unroll
                for (int kk = 0; kk < 4; ++kk) { const int k = (k0 + kk < pS) ? k0 + kk : k0;
#pragma unroll
                    for (int i = 0; i < 4; ++i) { t[kk][i][0] = *(const f32x4*)(pp + (size_t)k * 512 * DM + 512 * i); t[kk][i][1] = *(const f32x4*)(pp + (size_t)k * 512 * DM + 512 * i + 4); } }
#pragma unroll
                for (int kk = 0; kk < 4; ++kk) if (k0 + kk < pS) {
#pragma unroll
                    for (int i = 0; i < 4; ++i) { sacc[i][0] += t[kk][i][0]; sacc[i][1] += t[kk][i][1]; } } }
#pragma unroll
            for (int i = 0; i < 4; ++i) { x[i][0] += (*(const f32x4*)(pgate + 8 * (lane + 64 * i)) * pcoef) * sacc[i][0]; x[i][1] += (*(const f32x4*)(pgate + 8 * (lane + 64 * i) + 4) * pcoef) * sacc[i][1]; } }
        if (first || pend) { bf16* xo = X + (size_t)row * DM;
#pragma unroll
            for (int i = 0; i < 4; ++i) { v4u o; o.x = pk2(x[i][0].x, x[i][0].y); o.y = pk2(x[i][0].z, x[i][0].w); o.z = pk2(x[i][1].x, x[i][1].y); o.w = pk2(x[i][1].z, x[i][1].w);
                *(v4u*)(xo + 8 * (lane + 64 * i)) = o;
                x[i][0] = (f32x4){bflo(o.x), bfhi(o.x), bflo(o.y), bfhi(o.y)}; x[i][1] = (f32x4){bflo(o.z), bfhi(o.z), bflo(o.w), bfhi(o.w)}; } }
#pragma unroll
        for (int i = 0; i < 4; ++i)
#pragma unroll
            for (int h = 0; h < 2; ++h) ss += (x[i][h].x * x[i][h].x + x[i][h].y * x[i][h].y) + (x[i][h].z * x[i][h].z + x[i][h].w * x[i][h].w);
        ss = wave_sum(ss);
        const float r = 1.0f / sqrtf(ss * (1.0f / DM) + EPS);
        const float* sh = modl + (size_t)(v * 9 + 3 * jmod) * DM; const float* sc = sh + DM;
        bf16* orow = XN + (size_t)row * DM;
#pragma unroll
        for (int i = 0; i < 4; ++i) { const int col = 8 * (lane + 64 * i); f32x4 y[2];
#pragma unroll
            for (int h = 0; h < 2; ++h) { const f32x4 gg = *(const f32x4*)(g + col + 4 * h), s1 = *(const f32x4*)(sc + col + 4 * h), s0 = *(const f32x4*)(sh + col + 4 * h);
                y[h] = x[i][h] * r * gg * (1.0f + s1) + s0; }
            v4u o; o.x = pk2(y[0].x, y[0].y); o.y = pk2(y[0].z, y[0].w); o.z = pk2(y[1].x, y[1].y); o.w = pk2(y[1].z, y[1].w); *(v4u*)(orow + col) = o; }
    }
}
__device__ __forceinline__ void final_phase(const bf16* X, float* out, const float* __restrict__ g, int gw, int NGW, int lane) {
    asm volatile("" : "+v"(lane));
    for (int r0 = gw; r0 < NB * SEQ; r0 += NGW) {
        const int rx = blk_xr(r0, NGW); const int b = rx >= SEQ ? 1 : 0, t = rx - b * SEQ; const size_t row = (size_t)b * RPB + CTXL + t;
        const bf16* src = X + row * DM;
        f32x4 x[4][2]; float ss = 0.f;
#pragma unroll
        for (int i = 0; i < 4; ++i) { const v4u w = *(const v4u*)(src + 8 * (lane + 64 * i));
            x[i][0] = (f32x4){bflo(w.x), bfhi(w.x), bflo(w.y), bfhi(w.y)}; x[i][1] = (f32x4){bflo(w.z), bfhi(w.z), bflo(w.w), bfhi(w.w)};
#pragma unroll
            for (int h = 0; h < 2; ++h) ss += (x[i][h].x * x[i][h].x + x[i][h].y * x[i][h].y) + (x[i][h].z * x[i][h].z + x[i][h].w * x[i][h].w); }
        ss = wave_sum(ss);
        const float r = 1.0f / sqrtf(ss * (1.0f / DM) + EPS);
        float* o = out + (size_t)rx * DM;
#pragma unroll
        for (int i = 0; i < 4; ++i)
#pragma unroll
            for (int h = 0; h < 2; ++h) { const int col = 8 * (lane + 64 * i) + 4 * h; *(f32x4*)(o + col) = x[i][h] * r * *(const f32x4*)(g + col); }
    }
}
__device__ __forceinline__ void pass_ab(const bf16* QKVs, bf16* QKV, const float* PIN, const float* __restrict__ gq, const float* __restrict__ gk, const float* tbl, int gw, int NGW, int lane) {
    asm volatile("" : "+v"(lane));
    const int a = lane >> 5, f = lane & 31;
    const float gq1 = gq[a * 64 + f], gq2 = gq[a * 64 + 32 + f], gk1 = gk[a * 64 + f], gk2 = gk[a * 64 + 32 + f];
    for (int base = gw; base < NB * SEQ; base += 4 * NGW) {
        float x1[4][4], x2[4][4], cs[4], sn[4]; bf16* rowp[4]; bool ok[4];
#pragma unroll
        for (int j = 0; j < 4; ++j) { const int xr = base + j * NGW; ok[j] = xr < NB * SEQ; const int xc = blk_xr(ok[j] ? xr : gw, NGW); const int b = xc >> 13, t = xc & (SEQ - 1);
            const size_t row = (size_t)b * RPB + CTXL + t; const int pos = a == 0 ? (t >> 6) : (t & 63);
            cs[j] = tbl[(a == 0 ? T_HRC : T_HCC) + pos * 32 + f]; sn[j] = tbl[(a == 0 ? T_HRS : T_HCS) + pos * 32 + f];
            rowp[j] = QKV + row * AB_IN + a * 64 + f; const bf16* rows = QKVs + row * AB_IN + a * 64 + f;
#pragma unroll
            for (int q = 0; q < 4; ++q) { const int hd = q < 2 ? 8 + q : 18 + q; x1[j][q] = bf2f(rows[hd * 128]); x2[j][q] = bf2f(rows[hd * 128 + 32]); } }
#pragma unroll
        for (int j = 0; j < 4; ++j)
#pragma unroll
            for (int q = 0; q < 2; ++q) { const float ss = wave_sum(x1[j][q] * x1[j][q] + x2[j][q] * x2[j][q]); const float r = 1.0f / sqrtf(ss * (1.0f / 128.0f) + EPS); x1[j][q] *= r * gk1; x2[j][q] *= r * gk2; }
#pragma unroll
        for (int j = 0; j < 4; ++j) if (ok[j]) {
#pragma unroll
            for (int q = 0; q < 4; ++q) { const int hd = q < 2 ? 8 + q : 18 + q;
                rowp[j][hd * 128] = (bf16)f2bf(x1[j][q] * cs[j] - x2[j][q] * sn[j]); rowp[j][hd * 128 + 32] = (bf16)f2bf(x2[j][q] * cs[j] + x1[j][q] * sn[j]); } }
    }
    for (int cr = gw; cr < NB * CTXL; cr += NGW) {
        const int b = cr >> 8, rr = cr & (CTXL - 1); const size_t row = (size_t)b * RPB + rr;
        bf16* rowp = QKV + row * AB_IN + a * 64 + f;
        const float* pp = PIN + (size_t)cr * AB_IN + a * 64 + f;
#pragma unroll 4
        for (int hd = 0; hd < 24; ++hd) { float x1 = 0.f, x2 = 0.f;
#pragma unroll
            for (int k = 0; k < 8; ++k) { x1 += pp[(size_t)k * 512 * AB_IN + hd * 128]; x2 += pp[(size_t)k * 512 * AB_IN + hd * 128 + 32]; }
            if (hd < 10) { const float ss = wave_sum(x1 * x1 + x2 * x2); const float r = 1.0f / sqrtf(ss * (1.0f / 128.0f) + EPS);
                x1 *= r * (hd < 8 ? gq1 : gk1); x2 *= r * (hd < 8 ? gq2 : gk2); }
            rowp[hd * 128] = (bf16)f2bf(x1); rowp[hd * 128 + 32] = (bf16)f2bf(x2); }
    }
}
__device__ __forceinline__ void pass_mla1(const bf16* CQ, const float* PIN, bf16* CQN, bf16* CKVN, bf16* KR, const float* __restrict__ gcq, const float* __restrict__ gckv, const float* tbl, int gw, int NGW, int lane) {
    asm volatile("" : "+v"(lane));
    for (int q = gw; q < ((NORM_BLOCKED && NGW == 2048) ? NB * SEQ + NGW : MROWS); q += NGW) {
        int row = q;
        if (NORM_BLOCKED && NGW == 2048) {
            if (q < NB * SEQ) { const int xr = blk_xr(q, NGW); row = (xr >> 13) * RPB + CTXL + (xr & (SEQ - 1)); }
            else { const int w = q - NB * SEQ; if (w & 3) continue; const int cr = w >> 2; row = (cr >> 8) * RPB + (cr & (CTXL - 1)); }
        }
        const int b = row >= RPB ? 1 : 0, rr = row - b * RPB; const bool isctx = rr < CTXL; const int t = rr - CTXL;
        const bf16* rp = CQ + (size_t)row * C_IN_PAD; const float* pp = PIN + (size_t)(b * CTXL + rr) * C_IN_PAD;
        { float x[8];
          if (!isctx) { const v4u w = *(const v4u*)(rp + lane * 8); x[0] = bflo(w.x); x[1] = bfhi(w.x); x[2] = bflo(w.y); x[3] = bfhi(w.y); x[4] = bflo(w.z); x[5] = bfhi(w.z); x[6] = bflo(w.w); x[7] = bfhi(w.w); }
          else { f32x4 s0 = {0.f, 0.f, 0.f, 0.f}, s1 = s0;
#pragma unroll
              for (int k = 0; k < 8; ++k) { s0 += *(const f32x4*)(pp + (size_t)k * 512 * C_IN_PAD + lane * 8); s1 += *(const f32x4*)(pp + (size_t)k * 512 * C_IN_PAD + lane * 8 + 4); }
              x[0] = s0.x; x[1] = s0.y; x[2] = s0.z; x[3] = s0.w; x[4] = s1.x; x[5] = s1.y; x[6] = s1.z; x[7] = s1.w; }
          float ss = 0.f;
#pragma unroll
          for (int i = 0; i < 8; ++i) ss += x[i] * x[i];
          ss = wave_sum(ss); const float r = 1.0f / sqrtf(ss * (1.0f / QRANK) + EPS);
          const f32x4 g0 = *(const f32x4*)(gcq + lane * 8), g1 = *(const f32x4*)(gcq + lane * 8 + 4);
          v4u o; o.x = pk2(x[0] * r * g0.x, x[1] * r * g0.y); o.y = pk2(x[2] * r * g0.z, x[3] * r * g0.w); o.z = pk2(x[4] * r * g1.x, x[5] * r * g1.y); o.w = pk2(x[6] * r * g1.z, x[7] * r * g1.w);
          *(v4u*)(CQN + (size_t)row * QRANK + lane * 8) = o; }
        { float x[4];
          if (!isctx) { const v2u w = *(const v2u*)(rp + 512 + lane * 4); x[0] = bflo(w.x); x[1] = bfhi(w.x); x[2] = bflo(w.y); x[3] = bfhi(w.y); }
          else { f32x4 s0 = {0.f, 0.f, 0.f, 0.f};
#pragma unroll
              for (int k = 0; k < 8; ++k) s0 += *(const f32x4*)(pp + (size_t)k * 512 * C_IN_PAD + 512 + lane * 4);
              x[0] = s0.x; x[1] = s0.y; x[2] = s0.z; x[3] = s0.w; }
          float ss = (x[0] * x[0] + x[1] * x[1]) + (x[2] * x[2] + x[3] * x[3]);
          ss = wave_sum(ss); const float r = 1.0f / sqrtf(ss * (1.0f / KVRANK) + EPS);
          const f32x4 g0 = *(const f32x4*)(gckv + lane * 4);
          v2u o; o.x = pk2(x[0] * r * g0.x, x[1] * r * g0.y); o.y = pk2(x[2] * r * g0.z, x[3] * r * g0.w);
          *(v2u*)(CKVN + (size_t)row * KVRANK + lane * 4) = o; }
        if (lane < 32) { const int a = lane >> 4, f = lane & 15;
          float x1, x2;
          if (!isctx) { x1 = bf2f(rp[768 + a * 32 + f]); x2 = bf2f(rp[768 + a * 32 + 16 + f]); }
          else { x1 = 0.f; x2 = 0.f;
#pragma unroll
              for (int k = 0; k < 8; ++k) { x1 += pp[(size_t)k * 512 * C_IN_PAD + 768 + a * 32 + f]; x2 += pp[(size_t)k * 512 * C_IN_PAD + 768 + a * 32 + 16 + f]; } }
          float cs = 1.f, sn = 0.f;
          if (!isctx) { const int pos = a == 0 ? (t >> 6) : (t & 63); cs = tbl[(a == 0 ? T_MRC : T_MCC) + pos * 16 + f]; sn = tbl[(a == 0 ? T_MRS : T_MCS) + pos * 16 + f]; }
          bf16* kr = KR + (size_t)row * 64 + a * 32 + f;
          kr[0] = (bf16)f2bf(x1 * cs - x2 * sn); kr[16] = (bf16)f2bf(x2 * cs + x1 * sn); }
    }
}
__device__ __forceinline__ void pass_mla2(const bf16* Qs, bf16* Q, const float* tbl, int gw, int NGW, int lane) {
    asm volatile("" : "+v"(lane));
    for (int row = gw; row < MROWS; row += NGW) {
        const int b = row >= RPB ? 1 : 0, rr = row - b * RPB; if (rr < CTXL) continue; const int t = rr - CTXL;
        bf16* rp = Q + (size_t)row * MLA_QOUT; const bf16* rs = Qs + (size_t)row * MLA_QOUT;
#pragma unroll
        for (int it = 0; it < 8; ++it) { const int P = it * 64 + lane, h = P >> 5, p = P & 31, a = p >> 4, f = p & 15;
            const int pos = a == 0 ? (t >> 6) : (t & 63);
            const float cs = tbl[(a == 0 ? T_MRC : T_MCC) + pos * 16 + f], sn = tbl[(a == 0 ? T_MRS : T_MCS) + pos * 16 + f];
            bf16* q = rp + h * 192 + 128 + a * 32 + f; const bf16* qs = rs + h * 192 + 128 + a * 32 + f;
            const float x1 = bf2f(qs[0]), x2 = bf2f(qs[16]);
            q[0] = (bf16)f2bf(x1 * cs - x2 * sn); q[16] = (bf16)f2bf(x2 * cs + x1 * sn); }
    }
}

struct Args { const float* in[21]; float* out; unsigned char* ws; };
#define INP(k) ({ int k_ = (k); asm volatile("" : "+s"(k_)); args.in[k_]; })
#define WSP(T, off) ({ size_t o_ = (off); asm volatile("" : "+s"(o_)); (T*)(args.ws + o_); })
#define MOD WSP(float, WS_MOD)
#define TBL WSP(float, WS_TBL)
#define WGU WSP(bf16, WS_WGU)
#define WDN WSP(bf16, WS_WDN)
#define WINAB WSP(bf16, WS_WINAB)
#define WOUTAB WSP(bf16, WS_WOUTAB)
#define WINC WSP(bf16, WS_WINC)
#define WUQ WSP(bf16, WS_WUQ)
#define WUKV WSP(bf16, WS_WUKV)
#define WOUTC WSP(bf16, WS_WOUTC)
#define X WSP(bf16, WS_X)
#define XN WSP(bf16, WS_XN)
#define H WSP(bf16, WS_H)
#define QKV WSP(bf16, WS_QKV)
#define KV WSP(bf16, WS_KV)
#define CQ WSP(bf16, WS_CQ)
#define CQN WSP(bf16, WS_CQN)
#define CKVN WSP(bf16, WS_CKVN)
#define KR WSP(bf16, WS_KR)
#define O WSP(bf16, WS_O)
__global__ void __launch_bounds__(NWAVES * 64, 2) fwd(Args args) {
    extern __shared__ __attribute__((aligned(16))) unsigned char lds[];
    LAS unsigned char* L = (LAS unsigned char*)lds;
#if CODE_SHIFT >= 1
    asm volatile("s_nop 0");
#endif
#if CODE_SHIFT >= 2
    asm volatile("s_nop 0");
#endif
#if CODE_SHIFT >= 3
    asm volatile("s_nop 0");
#endif
#if CODE_SHIFT >= 4
    asm volatile("s_nop 0");
#endif
#if CODE_SHIFT >= 5
    asm volatile("s_nop 0");
#endif
#if CODE_SHIFT >= 6
    asm volatile("s_nop 0");
#endif
#if CODE_SHIFT >= 7
    asm volatile("s_nop 0");
#endif
#if CODE_SHIFT >= 8
    asm volatile("s_nop 0\n\ts_nop 0\n\ts_nop 0\n\ts_nop 0\n\ts_nop 0\n\ts_nop 0\n\ts_nop 0\n\ts_nop 0");
#endif
    volatile LAS unsigned* MISC = (volatile LAS unsigned*)(L + MISC_OFF);
    const int wave = __builtin_amdgcn_readfirstlane((int)threadIdx.x >> 6);
#define lane lane_id_fresh()
#define tid (wave * 64 + lane_id_fresh())
    const int G = gridDim.x, bx = blockIdx.x, vcu = (G % 8 == 0) ? (bx % 8) * (G / 8) + bx / 8 : bx;
    const int gw = vcu * NWAVES + wave, NGW = G * NWAVES;
    unsigned* ctl = (unsigned*)(args.ws + WS_CTL);
    for (int u = tid; u < (LDS_BYTES - LDSCTL_OFF) / 4; u += NWAVES * 64) ((LAS unsigned*)(L + LDSCTL_OFF))[u] = 0u;
    __syncthreads();
    (void)xcd_barrier_post((unsigned*)(ctl + CW_BAR), MISC + 8, tid == 0);
#if PROBE_WAIT_MASK
#define GRID_BAR(c) do { XcdBarrier bar_; bar_.bar = WSP(unsigned, WS_CTL) + CW_BAR; bar_.x = xb_xcc_id(); bar_.st = (volatile LAS unsigned*)(L + MISC_OFF) + 8; \
    const unsigned long long t0_ = __builtin_amdgcn_s_memrealtime(); xcd_barrier(bar_, tid == 0); const unsigned long long t1_ = __builtin_amdgcn_s_memrealtime(); \
    if (((PROBE_WAIT_MASK >> (c)) & 1) && tid == 0) { volatile LAS unsigned* w_ = (volatile LAS unsigned*)(L + MISC_OFF) + 16; *w_ = *w_ + (unsigned)(t1_ - t0_); } } while (0)
#else
#define GRID_BAR(c) do { XcdBarrier bar_; bar_.bar = WSP(unsigned, WS_CTL) + CW_BAR; bar_.x = xb_xcc_id(); bar_.st = (volatile LAS unsigned*)(L + MISC_OFF) + 8; xcd_barrier(bar_, tid == 0); if (PROBE_BAR) xcd_barrier(bar_, tid == 0); } while (0)
#endif

    {
        for (int rep_ = 0; rep_ < 1 + PROBE_MOD; ++rep_)
        p0_mod(INP(1), INP(3), INP(4), WSP(float, WS_H), L, tid, wave, lane);
        LAS float* scr = (LAS float*)(L + RING_OFF + wave * 16384);
        for (int rep_ = 0; rep_ < 1 + PROBE_TR; ++rep_)
        for (int ly = 0; ly < (DEFER_CONV ? 1 : DEPTH); ++ly)
            convert_layer(INP(7), INP(8), INP(9), INP(13), INP(14), INP(17), INP(18), INP(19), args.ws, ly, 0, 1, gw, NGW, scr, lane);
        { constexpr int PER = (C_IN_PAD - C_IN) * DM * 2 / 16;
          for (int i = gw * 64 + lane; i < 2 * PER; i += NGW * 64) { const int m = i / PER, j = i - m * PER;
              *(v4u*)((unsigned char*)WINC + (size_t)m * SZ_WINC + (size_t)C_IN * DM * 2 + (size_t)j * 16) = (v4u){0u, 0u, 0u, 0u}; } }
        for (int e = gw * 64 + lane; e < 9216; e += NGW * 64) {
            int p, f, nf, oc, os;
            if (e < 6144) { p = e >> 5; f = e & 31; nf = 32; if (p < 128) { oc = T_HRC + p * 32 + f; os = T_HRS + p * 32 + f; } else { oc = T_HCC + (p - 128) * 32 + f; os = T_HCS + (p - 128) * 32 + f; } }
            else { const int e2 = e - 6144; p = e2 >> 4; f = e2 & 15; nf = 16; if (p < 128) { oc = T_MRC + p * 16 + f; os = T_MRS + p * 16 + f; } else { oc = T_MCC + (p - 128) * 16 + f; os = T_MCS + (p - 128) * 16 + f; } }
            const int pos = p < 128 ? p : p - 128;
            const double inv = my_exp(-((double)f / (double)nf) * 9.210340371976184);
            double s, c; my_sincos((double)pos * inv, s, c);
            TBL[oc] = (float)c; TBL[os] = (float)s;
        }
    }
    GRID_BAR(5);
    p0_mod_sum(WSP(float, WS_H), INP(5), MOD, gw * 64 + lane, NGW * 64);
    GRID_BAR(5);

    int pS = 0; const float* pgate = nullptr; float pcoef = 0.f;
    for (int l = 0; l < DEPTH; ++l) {
        const float* modl = MOD + (size_t)l * 3 * 9 * DM;
        const int li = l >> 1; const bool even = (l & 1) == 0;
        for (int half = 0; half < 2; ++half) {
            if (half == 1) {
                norm_phase(nullptr, nullptr, X, XN, INP(6) + (size_t)(l * 3 + 1) * DM, modl, 1, false, WSP(float, WS_PARTC), pS, pgate, pcoef, gw, NGW, lane);
                pS = 0;
                GRID_BAR(0);
                {
                    const int N = even ? AB_IN : C_IN_PAD;
                    const bf16* Wi = even ? WINAB + (size_t)li * AB_IN * DM : WINC + (size_t)li * C_IN_PAD * DM;
                    {   pg8::Gemm gs{XN, Wi, MROWS, N, 256, DM, DM, (size_t)128};
                        pg8::CtxSplitOrder Sc{8, N / 256, 256, bx};
                        pg8::EpiPartial Ep{WSP(float, WS_PIN), N};
                        pg8::gemm_phase<pg8::EpiPartial, pg8::CtxSplitOrder, false, PG8_SP2>(L + RING_OFF, gs, Sc, Ep, tid); }
                    pg8::Gemm g{XN, Wi, MROWS, N, DM, DM, DM, (size_t)128};
                    pg8::PanelOrder S; S.init(N, G, bx, true); S.wgm = WGM_PROJ;
                    pg8::EpiPlain E{even ? QKV : CQ, N};
                    for (int rep_ = 0; rep_ < 1 + PROBE_INPROJ; ++rep_)
                    pg8::gemm_phase<pg8::EpiPlain, pg8::PanelOrder, PG8_ALIGN, PG8_SP2>(L + RING_OFF, g, S, E, tid);
                }
                GRID_BAR(4);
                if (even) {
                    if (PROBE_PASS) pass_ab(QKV, KV, WSP(float, WS_PIN), INP(10) + li * 128, INP(11) + li * 128, TBL, gw, NGW, lane);
                    pass_ab(QKV, QKV, WSP(float, WS_PIN), INP(10) + li * 128, INP(11) + li * 128, TBL, gw, NGW, lane);
                    GRID_BAR(0);
                    for (int rep_ = 0; rep_ < 1 + PROBE_ATTAB; ++rep_) {
                    int vc = vcu; asm volatile("" : "+s"(vc));
                    for (int it = 0; it < 5; ++it) {
                        int type, b, h, qb = 0;
                        if (it < 4) { type = it >> 1; b = it & 1; h = vc >> 5; qb = vc & 31; }
                        else { if (vc >= 32) break; type = 2 + ((vc >> 3) & 1); b = vc >> 4; h = vc & 7; }
                        const bool isB = (type & 1) != 0; const int kvh = h >> 2;
                        const int qcol = (isB ? 1536 : 0) + 128 * h, kcol = (isB ? 2560 : 1024) + 128 * kvh, vcol = (isB ? 2816 : 1280) + 128 * kvh, ocol = (isB ? 1024 : 0) + 128 * h;
                        const size_t rowb = (size_t)b * RPB, qrow = rowb + (type < 2 ? CTXL + 256 * qb : 0);
                        int NT = 4, base1 = 256, wmode = 0, qpos0 = 0;
                        if (type == 0) NT = 132;
                        else if (type == 1) { const int bs = (256 * qb - 128) < 0 ? 0 : (256 * qb - 128), be = (256 * qb + 384) > SEQ ? SEQ : (256 * qb + 384); NT = 4 + (be - bs) / 64; base1 = 256 + bs; wmode = 1; qpos0 = 256 * qb; }
                        float m_init = -1e30f, l_init = 0.f;
                        if (isB) { m_init = INP(12)[li * 8 + h] * 11.313708498984761f; l_init = 1.f; }
                        att::attn_unit<128, 3072, 3072, 3072, 2048, ATT_SD128>(QKV + qrow * AB_IN + qcol, QKV + rowb * AB_IN + kcol, nullptr, QKV + rowb * AB_IN + vcol, O + qrow * DM + ocol,
                                                                   NT, base1, wmode, type < 2 ? 256 * qb : 0, m_init, l_init, type < 2 ? (const float*)TBL : nullptr, (type == 0) ? INP(10) + li * 128 : nullptr, (char*)lds + RING_OFF, tid);
                    }
                    }
                } else {
                    if (PROBE_PASS) pass_mla1(CQ, WSP(float, WS_PIN), CQN, CKVN, KR, INP(15) + li * QRANK, INP(16) + li * KVRANK, TBL, gw, NGW, lane);
                    pass_mla1(CQ, WSP(float, WS_PIN), CQN, CKVN, KR, INP(15) + li * QRANK, INP(16) + li * KVRANK, TBL, gw, NGW, lane);
                    GRID_BAR(0);
                    {   pg8::Gemm g{CQN, WUQ + (size_t)li * MLA_QOUT * QRANK, MROWS, MLA_QOUT, QRANK, QRANK, QRANK, (size_t)128};
                        pg8::PanelOrder S; S.init(MLA_QOUT, G, bx, false); S.wgm = WGM_PROJ;
                        pg8::EpiPlain E{QKV, MLA_QOUT};
                        for (int rep_ = 0; rep_ < 1 + PROBE_UQKV; ++rep_)
                        pg8::gemm_phase<pg8::EpiPlain, pg8::PanelOrder, PG8_ALIGN, PG8_SP2>(L + RING_OFF, g, S, E, tid); }
                    {   pg8::Gemm g{CKVN, WUKV + (size_t)li * MLA_KVOUT * KVRANK, MROWS, MLA_KVOUT, KVRANK, KVRANK, KVRANK, (size_t)128};
                        pg8::PanelOrder S; S.init(MLA_KVOUT, G, bx, false); S.wgm = WGM_PROJ;
                        pg8::EpiPlain E{KV, MLA_KVOUT};
                        for (int rep_ = 0; rep_ < 1 + PROBE_UQKV; ++rep_)
                        pg8::gemm_phase<pg8::EpiPlain, pg8::PanelOrder, PG8_ALIGN, PG8_SP2>(L + RING_OFF, g, S, E, tid); }
                    GRID_BAR(4);
                    const bool need_ctx = l < DEPTH - 1;
                    for (int rep_ = 0; rep_ < 1 + PROBE_ATTMLA; ++rep_) {
                    int vc = vcu; asm volatile("" : "+s"(vc));
                    for (int it = 0; it < 5; ++it) {
                        int b, h, qb = 0; bool cx = false;
                        if (it < 4) { b = it >> 1; h = (it & 1) * 8 + (vc >> 5); qb = vc & 31; }
                        else { if (!need_ctx || vc >= 32) break; b = vc >> 4; h = vc & 15; cx = true; }
                        const size_t rowb = (size_t)b * RPB, qrow = rowb + (cx ? 0 : CTXL + 256 * qb);
                        att::attn_unit<192, 3072, 4096, 4096, 2048, ATT_SD192>(QKV + qrow * MLA_QOUT + 192 * h, KV + rowb * MLA_KVOUT + 256 * h, KR + rowb * 64, KV + rowb * MLA_KVOUT + 256 * h + 128, O + qrow * DM + 128 * h,
                                                                   cx ? 4 : 132, 256, 0, 256 * qb, -1e30f, 0.f, cx ? nullptr : (const float*)TBL, nullptr, (char*)lds + RING_OFF, tid);
                    }
                    }
                }
                GRID_BAR(3);
                {
                    const bf16* Wo = even ? WOUTAB + (size_t)li * DM * DM : WOUTC + (size_t)li * DM * DM;
                    if (l < DEPTH - 1) {
                        pg8::Gemm gs{O, Wo, MROWS, DM, 256, DM, DM, (size_t)128};
                        pg8::CtxSplitOrder Sc{8, DM / 256, 256, bx};
                        pg8::EpiPartial Ep{WSP(float, WS_PARTC), DM};
                        pg8::gemm_phase<pg8::EpiPartial, pg8::CtxSplitOrder, false, PG8_SP2>(L + RING_OFF, gs, Sc, Ep, tid);
                        pS = 8; pgate = modl + (size_t)(2 * 9 + 5) * DM; pcoef = 1.0f;
                    }
                    pg8::Gemm g{O, Wo, MROWS, DM, DM, DM, DM, (size_t)128};
                    pg8::PanelOrder S; S.init(DM, G, bx, true); S.wgm = WGM_G2;
                    pg8::EpiResid E{X, modl, 5, 1.0f / (1 + PROBE_OUTPROJ)};
                    for (int rep_ = 0; rep_ < 1 + PROBE_OUTPROJ; ++rep_)
                    pg8::gemm_phase<pg8::EpiResid, pg8::PanelOrder, PG8_ALIGN, PG8_SP2>(L + RING_OFF, g, S, E, tid);
                    if (PROBE_OUTPLAIN) { pg8::EpiPlain E2{WSP(bf16, WS_END), DM};
                        pg8::gemm_phase<pg8::EpiPlain, pg8::PanelOrder, PG8_ALIGN, PG8_SP2>(L + RING_OFF, g, S, E2, tid); }
                }
                GRID_BAR(4);
            }
            const int j = 2 * half, wi = l * 2 + half;
            const bool ctx_live = !(l == DEPTH - 1 && half == 1);
            for (int rep_ = 0; rep_ < 1 + PROBE_NORM; ++rep_)
            norm_phase(INP(0), INP(2), X, XN, INP(6) + (size_t)(l * 3 + j) * DM, modl, j, l == 0 && half == 0, WSP(float, WS_PARTC), rep_ == 0 ? pS : 0, pgate, pcoef, gw, NGW, lane);
            pS = 0;
            GRID_BAR(0);
            {   pg8::Gemm g{XN, WGU + (size_t)wi * 2 * DFF * DM, MROWS, 2 * DFF, DM, DM, DM, (size_t)128};
                pg8::PanelOrder S; S.init(2 * DFF, G, bx, G1_HALFCTX ? true : !ctx_live); S.wgm = WGM_G1;
                pg8::EpiSwiGLU E{H, H_TILED ? MROWS : DFF};
                for (int rep_ = 0; rep_ < 1 + PROBE_G1; ++rep_)
                for (int cut_ = 0; cut_ < G1_CUTS; ++cut_) {
                    S.r0 = cut_ * (12 / G1_CUTS); S.r1 = (cut_ + 1) * (12 / G1_CUTS);
                    if (cut_ > 0) GRID_BAR(1);
                    pg8::gemm_phase<pg8::EpiSwiGLU, pg8::PanelOrder, PG8_ALIGN, PG8_SP2>(L + RING_OFF, g, S, E, tid); }
                if (G1_HALFCTX && ctx_live) {
                    pg8::CtxHalfOrder Sh{2 * DFF / 256, bx};
                    pg8::EpiSwiGLU_T<true> Eh{H, H_TILED ? MROWS : DFF};
                    pg8::gemm_phase<pg8::EpiSwiGLU_T<true>, pg8::CtxHalfOrder, false, true, true>(L + RING_OFF, g, Sh, Eh, tid); }
                if (PROBE_G1PLAIN) { pg8::EpiPlain E2{WSP(bf16, WS_END), 2 * DFF};
                    pg8::gemm_phase<pg8::EpiPlain, pg8::PanelOrder, PG8_ALIGN, PG8_SP2>(L + RING_OFF, g, S, E2, tid); }
                if (DEFER_CONV && l + 1 < DEPTH && bx >= 88) {
                    int lane_ = lane; asm volatile("" : "+v"(lane_));
                    convert_layer(INP(7), INP(8), INP(9), INP(13), INP(14), INP(17), INP(18), INP(19), args.ws, l + 1, half, 2, (bx - 88) * NWAVES + wave, 168 * NWAVES, (LAS float*)(L + RING_OFF + wave * 16384), lane_); } }
            GRID_BAR(1);
            {
                const bf16* Wd = WDN + (size_t)wi * DM * DFF;
                if (ctx_live) {
                    pg8::Gemm gs{H, Wd, MROWS, DM, 512, DFF, H_TILED ? 64 : DFF, H_TILED ? (size_t)MROWS * 128 : (size_t)128};
                    pg8::CtxSplitOrder Sc{11, DM / 256, 512, bx};
                    pg8::EpiPartial Ep{WSP(float, WS_PARTC), DM};
                    pg8::gemm_phase<pg8::EpiPartial, pg8::CtxSplitOrder, false, PG8_SP2>(L + RING_OFF, gs, Sc, Ep, tid);
                    pS = 11; pgate = modl + (size_t)(2 * 9 + 3 * j + 2) * DM; pcoef = 0.5f;
                }
                pg8::Gemm g{H, Wd, MROWS, DM, DFF, DFF, H_TILED ? 64 : DFF, H_TILED ? (size_t)MROWS * 128 : (size_t)128};
                pg8::PanelOrder S; S.init(DM, G, bx, true); S.rev = REV_G2; S.wgm = WGM_G2;
                pg8::EpiResid E{X, modl, 3 * j + 2, 0.5f / (1 + PROBE_G2)};
                for (int rep_ = 0; rep_ < 1 + PROBE_G2; ++rep_)
                pg8::gemm_phase<pg8::EpiResid, pg8::PanelOrder, PG8_ALIGN, PG8_SP2>(L + RING_OFF, g, S, E, tid); }
            GRID_BAR(2);
        }
    }
    final_phase(X, args.out, INP(20), gw, NGW, lane);
#if PROBE_WAIT_MASK
    if (tid == 0) __hip_atomic_fetch_add(WSP(unsigned, WS_CTL) + 2048, *((volatile LAS unsigned*)(L + MISC_OFF) + 16), __ATOMIC_RELAXED, __HIP_MEMORY_SCOPE_AGENT);
    GRID_BAR(7);
    if (bx == 0 && tid == 0) { const unsigned tot = __hip_atomic_load(WSP(unsigned, WS_CTL) + 2048, __ATOMIC_RELAXED, __HIP_MEMORY_SCOPE_AGENT); const float us_ = (float)tot / (float)G * 0.01f; args.out[0] += floorf((us_ + PROBE_WAIT_OFF) / PROBE_WAIT_Q) * PROBE_WAIT_Q; }
#endif
#undef GRID_BAR
#undef lane
#undef tid
}
#undef MOD
#undef TBL
#undef WGU
#undef WDN
#undef WINAB
#undef WOUTAB
#undef WINC
#undef WUQ
#undef WUKV
#undef WOUTC
#undef X
#undef XN
#undef H
#undef QKV
#undef KV
#undef CQ
#undef CQN
#undef CKVN
#undef KR
#undef O

extern "C" void kernel_launch(void* const* d_in, const int* in_sizes, int n_in, void* d_out, int out_size, void* d_ws, size_t ws_size, hipStream_t stream) {
    static int grid = 0;
    if (grid == 0) {
        if (n_in != 21 || in_sizes[0] != NB * SEQ * DM || out_size != NB * SEQ * DM || ws_size < WS_END) {
            fprintf(stderr, "kernel_launch: shape mismatch: n_in %d in0 %d out %d ws %zu (need %zu)\n", n_in, n_in > 0 ? in_sizes[0] : -1, out_size, ws_size, (size_t)WS_END); grid = -1; return; }
        int dev = 0, cus = 0, per_cu = 0;
        if (hipGetDevice(&dev) != hipSuccess || hipDeviceGetAttribute(&cus, hipDeviceAttributeMultiprocessorCount, dev) != hipSuccess) { fprintf(stderr, "kernel_launch: device query failed\n"); grid = -1; return; }
        if (hipFuncSetAttribute((const void*)fwd, hipFuncAttributeMaxDynamicSharedMemorySize, LDS_BYTES) != hipSuccess) { fprintf(stderr, "kernel_launch: hipFuncSetAttribute failed\n"); grid = -1; return; }
        if (hipOccupancyMaxActiveBlocksPerMultiprocessor(&per_cu, (const void*)fwd, NWAVES * 64, LDS_BYTES) != hipSuccess || per_cu < 1)
            fprintf(stderr, "kernel_launch: note: occupancy query reports %d workgroups per CU\n", per_cu);
        (void)hipGetLastError();
        grid = cus;
    }
    if (grid < 0) return;
    if (hipMemsetAsync((char*)d_ws + WS_CTL, 0, CTL_ZERO_BYTES, stream) != hipSuccess) { fprintf(stderr, "kernel_launch: memset failed\n"); return; }
    Args a{};
    for (int i = 0; i < 21; ++i) a.in[i] = (const float*)d_in[i];
    a.out = (float*)d_out; a.ws = (unsigned char*)d_ws;
    hipLaunchKernelGGL(fwd, dim3(grid), dim3(NWAVES * 64), LDS_BYTES, stream, a);
    const hipError_t le = hipPeekAtLastError();
    if (le != hipSuccess) fprintf(stderr, "kernel_launch: launch failed: %s\n", hipGetErrorName(le));
}
```

```cpp
#define ATT_NEGM 1
#define ATT_NQ128 1
#define ATT_NQ192 8
#include <hip/hip_runtime.h>
#include <cstdio>
#include <cstdint>

constexpr int DM = 2048, NB = 2, SEQ = 8192, CTXL = 256, DEPTH = 4, DFF = 5632, NMOD = 9, GRID_W = 64;
constexpr int RPB = CTXL + SEQ;
constexpr int MROWS = NB * RPB;
constexpr int PPB = RPB / 256;
constexpr int AB_IN = 3072, C_IN = 832, C_IN_PAD = 1024, QRANK = 512, KVRANK = 256, MLA_QOUT = 3072, MLA_KVOUT = 4096;
constexpr float EPS = 1e-6f;

__device__ __forceinline__ int lane_id_fresh() { unsigned z = 0u; asm volatile("" : "+v"(z)); return (int)__builtin_amdgcn_mbcnt_hi(~0u, __builtin_amdgcn_mbcnt_lo(~0u, z)); }

#ifndef DIS_A128
#define DIS_A128 0
#endif
#ifndef DIS_A192
#define DIS_A192 0
#endif
#ifndef DIS_G1
#define DIS_G1 0
#endif
#ifndef DIS_G2
#define DIS_G2 0
#endif
#ifndef DIS_G3
#define DIS_G3 0
#endif
#ifndef DIS_G4
#define DIS_G4 0
#endif
#ifndef DIS_G5
#define DIS_G5 0
#endif
#ifndef DIS_G6
#define DIS_G6 0
#endif
#ifndef ATT_SD128
#define ATT_SD128 1
#endif
#ifndef ATT_SD192
#define ATT_SD192 1
#endif
#ifndef PROBE_ATTAB
#define PROBE_ATTAB 0
#endif
#ifndef PROBE_ATTMLA
#define PROBE_ATTMLA 0
#endif
#ifndef PROBE_G1
#define PROBE_G1 0
#endif
#ifndef PROBE_NORM
#define PROBE_NORM 0
#endif
#ifndef PROBE_TR
#define PROBE_TR 0
#endif
#ifndef PROBE_G2
#define PROBE_G2 0
#endif
#ifndef PROBE_PASS
#define PROBE_PASS 0
#endif
#ifndef PROBE_MOD
#define PROBE_MOD 0
#endif
#ifndef PROBE_INPROJ
#define PROBE_INPROJ 0
#endif
#ifndef PROBE_UQKV
#define PROBE_UQKV 0
#endif
#ifndef PROBE_OUTPROJ
#define PROBE_OUTPROJ 0
#endif
#ifndef PROBE_BAR
#define PROBE_BAR 0
#endif
#ifndef PROBE_WAIT_MASK
#define PROBE_WAIT_MASK 0
#endif
#ifndef PROBE_WAIT_Q
#define PROBE_WAIT_Q 200.0f
#endif
#ifndef PROBE_WAIT_OFF
#define PROBE_WAIT_OFF 0.0f
#endif
#ifndef REV_G2
#define REV_G2 (LOCAL_SEAMS ? false : true)
#endif
#ifndef WGM_G2
#define WGM_G2 4
#endif
#ifndef NT_H
#define NT_H 0
#endif
#ifndef DEFER_CONV
#define DEFER_CONV 0
#endif
#ifndef PROBE_OUTPLAIN
#define PROBE_OUTPLAIN 0
#endif
#ifndef PROBE_G1PLAIN
#define PROBE_G1PLAIN 0
#endif
#ifndef H_TILED
#define H_TILED 1
#endif
#ifndef G1_CUTS
#define G1_CUTS 1
#endif
#ifndef NT_W
#define NT_W 0
#endif
#ifndef WGM_G1
#define WGM_G1 4
#endif
#ifndef CODE_SHIFT
#define CODE_SHIFT 0
#endif
#ifndef ATT_PRIO
#define ATT_PRIO 0
#endif
#ifndef NORM_BLOCKED
#define NORM_BLOCKED 1
#endif
#ifndef WGM_PROJ
#define WGM_PROJ 8
#endif
#ifndef ATT_EARLY
#define ATT_EARLY 0
#endif
#ifndef ATT_STAG
#define ATT_STAG 1
#endif
#ifndef ATT_NQ128
#define ATT_NQ128 8
#endif
#ifndef ATT_NQ192
#define ATT_NQ192 8
#endif
#ifndef ATT_SLEEP
#define ATT_SLEEP 0
#endif
#ifndef KSWZ_MASK
#define KSWZ_MASK 15
#endif
#ifndef ATT_KDMA
#define ATT_KDMA 1
#endif
#ifndef ATT_VDMA
#define ATT_VDMA 1
#endif
#ifndef ATT_PKMATH
#define ATT_PKMATH 0
#endif
#ifndef G1_HALFCTX
#define G1_HALFCTX 1
#endif
#ifndef NORM_NRB
#define NORM_NRB 1
#endif
#ifndef UP_HALFCTX
#define UP_HALFCTX 1
#endif
#ifndef PROBE_ABL
#define PROBE_ABL 0
#endif
#ifndef ATT_ILV
#define ATT_ILV 0
#endif
#ifndef PROBE_WAIT_LOCAL
#define PROBE_WAIT_LOCAL 0
#endif
#ifndef LOCAL_SEAMS
#define LOCAL_SEAMS 0
#endif
#ifndef PROBE_LOCALFLAG
#define PROBE_LOCALFLAG 0
#endif
#ifndef ATT_QPF
#define ATT_QPF 0
#endif
#ifndef ATT_NEGM
#define ATT_NEGM 0
#endif
namespace pg8 {
#define PG8_LAS __attribute__((address_space(3)))
typedef unsigned short bf16_t;
typedef short bf16x8 __attribute__((ext_vector_type(8)));
typedef float f32x4 __attribute__((ext_vector_type(4)));
typedef unsigned u32x4 __attribute__((ext_vector_type(4)));
constexpr int BM = 256, BK = 64, HALF = 128, HTB = HALF * BK * 2  , STAGE_BYTES = 8 * HTB, NXCD = 8, WGM = 8;

__host__ __device__ __forceinline__ int lds_byte(int r, int c) { const int st = (r >> 4) * 2 + (c >> 5), rr = r & 15, cc = c & 31, ob = rr * 64 + cc * 2; return st * 1024 + (ob ^ (((ob >> 9) & 1) << 5)); }
__host__ __device__ __forceinline__ void stage_rc(int b, int& R, int& C) { const int st = b / 1024, sb = b % 1024, swz = sb ^ (((sb >> 9) & 1) << 5); R = (st >> 1) * 16 + swz / 64; C = (st & 1) * 32 + (swz % 64) / 2; }
__host__ __device__ __forceinline__ int perm32(int rho) { const int n = rho >> 4, i = rho & 15; return 8 * (i >> 2) + 4 * n + (i & 3); }

struct Unit { int pm, pn, koff, ks; };
struct Gemm { const bf16_t* A; const bf16_t* Bt; int M, N, K, ld; int lda; size_t kstepA; };

struct StaticOrder {
    int nM, nN, nwg, G, c, wgm = WGM;
    __host__ __device__ void init(int M, int N, int G_, int c_) { nM = M / BM; nN = N / BM; nwg = nM * nN; G = G_; c = c_; }
    __host__ __device__ bool next(int i, Unit& u) const {
        const long L = (long)i * G + c; if (L >= nwg) return false;
        int wgid = (int)L; { const int q = nwg / NXCD, r = nwg % NXCD, xcd = wgid % NXCD, off = wgid / NXCD; wgid = (xcd < r ? xcd * (q + 1) : r * (q + 1) + (xcd - r) * q) + off; }
        const int nig = wgm * nN, gid = wgid / nig, fm = gid * wgm, gsz = (nM - fm) < wgm ? (nM - fm) : wgm;
        u.pm = fm + ((wgid % nig) % gsz); u.pn = (wgid % nig) / gsz; u.koff = 0; u.ks = 0; return true;
    }
    __device__ __forceinline__ void a_ready(const Unit&) const {}
    __device__ __forceinline__ void done(const Unit&) const {}
};

typedef float f32x2_t __attribute__((ext_vector_type(2))); typedef __bf16 bf16x2_t __attribute__((ext_vector_type(2)));
__device__ __forceinline__ unsigned cvt_pk_bf16(float lo, float hi) { f32x2_t v = {lo, hi}; bf16x2_t b = __builtin_convertvector(v, bf16x2_t); return __builtin_bit_cast(unsigned, b); }

template <bool HALFM> struct EpiPlain_T {
    static constexpr bool PERM = true, AFTER_DRAIN = false;
    bf16_t* O; int ldc;
    __device__ __forceinline__ void operator()(const f32x4 (&acc)[2][2][4][2], const Unit& u, int wr, int wc, int fr, int fq) const {
        const int row0 = u.pm * BM + (HALFM ? u.ks * HALF : 0) + wr * 64 + fr, col0 = u.pn * BM + wc * 32 + 8 * fq;
#pragma unroll
        for (int ai = 0; ai < (HALFM ? 1 : 2); ++ai)
#pragma unroll
            for (int m = 0; m < 4; ++m) { bf16_t* rowp = O + (size_t)(row0 + ai * HALF + m * 16) * ldc + col0;
#pragma unroll
                for (int bj = 0; bj < 2; ++bj) { const f32x4 v0 = acc[ai][bj][m][0], v1 = acc[ai][bj][m][1];
                    u32x4 w; w.x = cvt_pk_bf16(v0[0], v0[1]); w.y = cvt_pk_bf16(v0[2], v0[3]); w.z = cvt_pk_bf16(v1[0], v1[1]); w.w = cvt_pk_bf16(v1[2], v1[3]);
                    *(u32x4*)(rowp + bj * HALF) = w; } }
    }
};
typedef EpiPlain_T<false> EpiPlain;
__device__ __forceinline__ u32x4 swiglu8(const f32x4 g0, const f32x4 g1, const f32x4 u0, const f32x4 u1) {
    float g[8] = {g0[0], g0[1], g0[2], g0[3], g1[0], g1[1], g1[2], g1[3]}, u[8] = {u0[0], u0[1], u0[2], u0[3], u1[0], u1[1], u1[2], u1[3]}, t[8];
#pragma unroll
    for (int k = 0; k < 8; ++k) t[k] = g[k] * -1.4426950408889634f;
#pragma unroll
    for (int k = 0; k < 8; ++k) t[k] = __builtin_amdgcn_exp2f(t[k]);
#pragma unroll
    for (int k = 0; k < 8; ++k) t[k] = 1.0f + t[k];
#pragma unroll
    for (int k = 0; k < 8; ++k) t[k] = __builtin_amdgcn_rcpf(t[k]);
#pragma unroll
    for (int k = 0; k < 8; ++k) t[k] = (g[k] * t[k]) * u[k];
    u32x4 w; w.x = cvt_pk_bf16(t[0], t[1]); w.y = cvt_pk_bf16(t[2], t[3]); w.z = cvt_pk_bf16(t[4], t[5]); w.w = cvt_pk_bf16(t[6], t[7]); return w;
}
template <bool HALFM> struct EpiSwiGLU_T {
    static constexpr bool PERM = true, AFTER_DRAIN = false;
    bf16_t* H; int ldh;
    __device__ __forceinline__ void operator()(const f32x4 (&acc)[2][2][4][2], const Unit& u, int wr, int wc, int fr, int fq) const {
        const int row0 = u.pm * BM + (HALFM ? u.ks * HALF : 0) + wr * 64 + fr, col0 = u.pn * HALF + wc * 32 + 8 * fq;
#pragma unroll
        for (int ai = 0; ai < (HALFM ? 1 : 2); ++ai)
#pragma unroll
            for (int m = 0; m < 4; ++m) {
                bf16_t* rowp = H_TILED ? H + ((size_t)(col0 >> 6) * ldh + (row0 + ai * HALF + m * 16)) * 64 + (col0 & 63) : H + (size_t)(row0 + ai * HALF + m * 16) * ldh + col0;
                const u32x4 w = swiglu8(acc[ai][0][m][0], acc[ai][0][m][1], acc[ai][1][m][0], acc[ai][1][m][1]);
                if (NT_H) __builtin_nontemporal_store(w, (u32x4*)rowp); else *(u32x4*)rowp = w; }
    }
};
typedef EpiSwiGLU_T<false> EpiSwiGLU;
struct EpiResid {
    static constexpr bool PERM = true, AFTER_DRAIN = false;
    bf16_t* X; const float* modl; int gidx; float coef;
    __device__ __forceinline__ void operator()(const f32x4 (&acc)[2][2][4][2], const Unit& u, int wr, int wc, int fr, int fq) const {
        const int b = u.pm / 33, v = (u.pm - b * 33 == 0) ? 2 : b;
        const float* gate = modl + (size_t)(v * 9 + gidx) * 2048;
        const int row0 = u.pm * BM + wr * 64 + fr, col0 = u.pn * BM + wc * 32 + 8 * fq;
        f32x4 gv[2][2];
#pragma unroll
        for (int bj = 0; bj < 2; ++bj)
#pragma unroll
            for (int n = 0; n < 2; ++n) gv[bj][n] = *(const f32x4*)(gate + col0 + bj * HALF + n * 4) * coef;
#pragma unroll
        for (int ai = 0; ai < 2; ++ai) {
            u32x4 xo[4][2];
#pragma unroll
            for (int m = 0; m < 4; ++m)
#pragma unroll
                for (int bj = 0; bj < 2; ++bj) xo[m][bj] = *(const u32x4*)(X + (size_t)(row0 + ai * HALF + m * 16) * 2048 + col0 + bj * HALF);
#pragma unroll
            for (int m = 0; m < 4; ++m)
#pragma unroll
                for (int bj = 0; bj < 2; ++bj) { const u32x4 x4 = xo[m][bj];
                    const f32x4 d0 = gv[bj][0] * acc[ai][bj][m][0], d1 = gv[bj][1] * acc[ai][bj][m][1];
                    u32x4 w;
                    w.x = cvt_pk_bf16(__builtin_bit_cast(float, x4.x << 16) + d0[0], __builtin_bit_cast(float, x4.x & 0xffff0000u) + d0[1]);
                    w.y = cvt_pk_bf16(__builtin_bit_cast(float, x4.y << 16) + d0[2], __builtin_bit_cast(float, x4.y & 0xffff0000u) + d0[3]);
                    w.z = cvt_pk_bf16(__builtin_bit_cast(float, x4.z << 16) + d1[0], __builtin_bit_cast(float, x4.z & 0xffff0000u) + d1[1]);
                    w.w = cvt_pk_bf16(__builtin_bit_cast(float, x4.w << 16) + d1[2], __builtin_bit_cast(float, x4.w & 0xffff0000u) + d1[3]);
                    *(u32x4*)(X + (size_t)(row0 + ai * HALF + m * 16) * 2048 + col0 + bj * HALF) = w; }
            asm volatile("" ::: "memory"); }
    }
};

struct PanelOrder : StaticOrder {
    int r0 = 0, r1 = 1 << 30;
    bool skip; bool rev = false;
    __host__ __device__ void init(int N, int G_, int c_, bool skip_) {
#if defined(__HIP_DEVICE_COMPILE__)
        asm volatile("" : "+s"(G_), "+s"(c_));
#endif
        skip = skip_; StaticOrder::init((skip_ ? 64 : 66) * BM, N, G_, c_); }
    __host__ __device__ bool next(int i, Unit& u) const { if (i + r0 >= r1 || !StaticOrder::next(i + r0, u)) return false; if (rev) u.pm = nM - 1 - u.pm; if (skip) u.pm += 1 + (u.pm >= 32 ? 1 : 0); return true; }
};
struct CtxSplitOrder {
    int S, nN, klen, c;
    __host__ __device__ bool next(int i, Unit& u) const { if (i > 0 || c >= 2 * nN * S) return false; const int ks = c % S, rest = c / S; u.pn = rest % nN; u.pm = (rest / nN) * 33; u.koff = ks * klen; u.ks = ks; return true; }
    __device__ __forceinline__ void a_ready(const Unit&) const {}
    __device__ __forceinline__ void done(const Unit&) const {}
};
struct CtxHalfOrder {
    int nN, c;
    __host__ __device__ bool next(int i, Unit& u) const { if (i > 0 || c < 0 || c >= 4 * nN) return false; u.pn = c % nN; const int hp = c / nN; u.pm = (hp >> 1) * 33; u.ks = hp & 1; u.koff = 0; return true; }
    __device__ __forceinline__ void a_ready(const Unit&) const {}
    __device__ __forceinline__ void done(const Unit&) const {}
};
struct EpiPartial {
    static constexpr bool PERM = false, AFTER_DRAIN = false;
    float* P; int ldp;
    __device__ __forceinline__ void operator()(const f32x4 (&acc)[2][2][4][2], const Unit& u, int wr, int wc, int fr, int fq) const {
        const int crow0 = (u.pm == 0 ? 0 : 256) + wr * 64 + fr, col0 = u.pn * BM + wc * 32 + 4 * fq;
        float* base = P + ((size_t)u.ks * 512 + crow0) * ldp + col0;
#pragma unroll
        for (int ai = 0; ai < 2; ++ai)
#pragma unroll
            for (int m = 0; m < 4; ++m) { float* rowp = base + (size_t)(ai * HALF + m * 16) * ldp;
#pragma unroll
                for (int bj = 0; bj < 2; ++bj)
#pragma unroll
                    for (int n = 0; n < 2; ++n) *(f32x4*)(rowp + bj * HALF + n * 16) = acc[ai][bj][m][n]; }
    }
};

template <class Epi, class Sched, bool ALIGN_EPI = false, bool SP2 = false, bool HALFM = false>
__device__ __forceinline__ void gemm_phase(PG8_LAS unsigned char* lds, const Gemm g, const Sched& S, const Epi& E, const int tid_in) {
    int tid_ = tid_in; asm volatile("" : "+v"(tid_));
    const int tid = tid_, wid = __builtin_amdgcn_readfirstlane(tid >> 6), lane = tid & 63, wr = wid >> 2, wc = wid & 3, fr = lane & 15, fq = lane >> 4;
    const int K = g.K, nt = K / BK;
    unsigned voffA[2], voffB[2];
#pragma unroll
    for (int i = 0; i < 2; ++i) { int R, C; stage_rc(tid * 16 + i * 8192, R, C); const int Rb = Epi::PERM ? ((R & ~31) + perm32(R & 31)) : R;
        voffA[i] = (unsigned)(R * g.lda + C) * 2u; voffB[i] = (unsigned)(Rb * g.ld + C) * 2u; }
    const size_t kstep = (size_t)(BK * 2);
    const size_t kstepA = g.kstepA, hstepA = (size_t)HALF * g.lda * 2, tstepA = 2 * hstepA;
    const size_t hstep = (size_t)HALF * g.ld * 2;
    const size_t tstep = 2 * hstep;
    const unsigned ldsw = (unsigned)wid * 1024u;
    const int aoff = lds_byte(wr * 64 + fr, fq * 8), boff = lds_byte(wc * 32 + fr, fq * 8);
#define PG8_SA(b, h) (((b) * 2 + (h)) * HTB)
#define PG8_SB(b, h) ((4 + (b) * 2 + (h)) * HTB)
#define PG8_STAGE(bufoff, gbase, voff) do { _Pragma("unroll") for (int _i = 0; _i < 2; ++_i) \
        __builtin_amdgcn_global_load_lds((const unsigned*)((const char*)(gbase) + (voff)[_i]), (PG8_LAS unsigned*)(lds + (bufoff) + ldsw + _i * 8192), 16, 0, 0); } while (0)
#define PG8_LDA(dst, b, h) do { _Pragma("unroll") for (int m = 0; m < 4; ++m) _Pragma("unroll") for (int k = 0; k < 2; ++k) dst[m][k] = *(const PG8_LAS bf16x8*)(lds + PG8_SA(b, h) + aoff + m * 2048 + k * 1024); } while (0)
#define PG8_LDB(dst, b, h) do { _Pragma("unroll") for (int n = 0; n < 2; ++n) _Pragma("unroll") for (int k = 0; k < 2; ++k) dst[n][k] = *(const PG8_LAS bf16x8*)(lds + PG8_SB(b, h) + boff + n * 2048 + k * 1024); } while (0)
#define PG8_MMA(ai, bj, At, Bt) do { __builtin_amdgcn_s_setprio(1); _Pragma("unroll") for (int m = 0; m < 4; ++m) _Pragma("unroll") for (int n = 0; n < 2; ++n) _Pragma("unroll") for (int k = 0; k < 2; ++k) \
        acc[ai][bj][m][n] = __builtin_amdgcn_mfma_f32_16x16x32_bf16(Bt[n][k], At[m][k], acc[ai][bj][m][n], 0, 0, 0); __builtin_amdgcn_s_setprio(0); } while (0)
#define PG8_WAIT_V(n) asm volatile("s_waitcnt vmcnt(" #n ")" ::: "memory")
#define PG8_WV do { if constexpr (HALFM) PG8_WAIT_V(6); else PG8_WAIT_V(8); } while (0)
#define PG8_WAIT_L(n) asm volatile("s_waitcnt lgkmcnt(" #n ")" ::: "memory")
#define PG8_BAR __builtin_amdgcn_s_barrier()
#define PG8_SCHED __builtin_amdgcn_sched_barrier(0)
    Unit cur, nxt; int ui = 0;
    if (!S.next(0, cur)) return;
    f32x4 acc[2][2][4][2];
#pragma unroll
    for (int a = 0; a < 2; ++a)
#pragma unroll
        for (int b = 0; b < 2; ++b)
#pragma unroll
            for (int m = 0; m < 4; ++m)
#pragma unroll
                for (int n = 0; n < 2; ++n) acc[a][b][m][n] = (f32x4){0.f, 0.f, 0.f, 0.f};
    bf16x8 At[4][2], B0[2][2], B1[2][2];
    static_assert(!HALFM || SP2, "HALFM is written for the two-super-phase loop");
    const char* cA = (const char*)g.A + (size_t)cur.pm * tstepA + (size_t)(cur.koff >> 6) * kstepA + (HALFM ? (size_t)cur.ks * hstepA : (size_t)0); const char* cB = (const char*)g.Bt + (size_t)cur.pn * tstep + (size_t)cur.koff * 2;
    S.a_ready(cur);
    if constexpr (SP2) {
        PG8_STAGE(PG8_SB(0, 0), cB, voffB); PG8_STAGE(PG8_SB(0, 1), cB + hstep, voffB); PG8_STAGE(PG8_SA(0, 0), cA, voffA); if constexpr (!HALFM) PG8_STAGE(PG8_SA(0, 1), cA + hstepA, voffA);
        if (wr == 1) PG8_BAR;
        if constexpr (HALFM) PG8_WAIT_V(0); else PG8_WAIT_V(2);
        PG8_BAR;
        PG8_STAGE(PG8_SB(1, 0), cB + kstep, voffB); PG8_STAGE(PG8_SA(1, 0), cA + kstepA, voffA); PG8_STAGE(PG8_SB(1, 1), cB + hstep + kstep, voffB);
        PG8_WAIT_V(6); PG8_BAR;
    } else {
        PG8_STAGE(PG8_SB(0, 0), cB, voffB); PG8_STAGE(PG8_SA(0, 0), cA, voffA); PG8_STAGE(PG8_SB(0, 1), cB + hstep, voffB); PG8_STAGE(PG8_SA(0, 1), cA + hstepA, voffA);
        if (wr == 1) PG8_BAR;
        PG8_WAIT_V(4); PG8_BAR;
        PG8_STAGE(PG8_SB(1, 0), cB + kstep, voffB); PG8_STAGE(PG8_SA(1, 0), cA + kstepA, voffA); PG8_STAGE(PG8_SB(1, 1), cB + hstep + kstep, voffB);
        PG8_WAIT_V(6); PG8_BAR;
    }
    for (;;) {
        const bool has_next = S.next(ui + 1, nxt);
        const char* nA = has_next ? (const char*)g.A + (size_t)nxt.pm * tstepA + (size_t)(nxt.koff >> 6) * kstepA + (HALFM ? (size_t)nxt.ks * hstepA : (size_t)0) : cA; const char* nB = has_next ? (const char*)g.Bt + (size_t)nxt.pn * tstep + (size_t)nxt.koff * 2 : cB;
        for (int t = 0; t < nt; t += 2) {
            const bool last = (t == nt - 2);
            const char* a1 = cA + (size_t)(t + 1) * kstepA;
            const char* a2 = last ? nA : cA + (size_t)(t + 2) * kstepA; const char* b2 = last ? nB : cB + (size_t)(t + 2) * kstep;
            const char* a3 = a2 + kstepA; const char* b3 = b2 + kstep;
            if (last && has_next) S.a_ready(nxt);
            if constexpr (SP2) {
            PG8_LDB(B0, 0, 0); PG8_LDB(B1, 0, 1); PG8_SCHED; PG8_LDA(At, 0, 0); if constexpr (!HALFM) PG8_STAGE(PG8_SA(1, 1), a1 + hstepA, voffA);
            PG8_WV; PG8_WAIT_L(0); PG8_BAR; PG8_MMA(0, 0, At, B0); PG8_MMA(0, 1, At, B1); PG8_BAR; PG8_SCHED;
            if constexpr (!HALFM) PG8_LDA(At, 0, 1); PG8_STAGE(PG8_SB(0, 0), b2, voffB); PG8_STAGE(PG8_SB(0, 1), b2 + hstep, voffB); PG8_STAGE(PG8_SA(0, 0), a2, voffA);
            PG8_WV; PG8_WAIT_L(0); PG8_BAR; if constexpr (!HALFM) { PG8_MMA(1, 0, At, B0); PG8_MMA(1, 1, At, B1); } PG8_BAR; PG8_SCHED;
            PG8_LDB(B0, 1, 0); PG8_LDB(B1, 1, 1); PG8_SCHED; PG8_LDA(At, 1, 0); if constexpr (!HALFM) PG8_STAGE(PG8_SA(0, 1), a2 + hstepA, voffA);
            PG8_WV; PG8_WAIT_L(0); PG8_BAR; PG8_MMA(0, 0, At, B0); PG8_MMA(0, 1, At, B1); PG8_BAR; PG8_SCHED;
            if constexpr (!HALFM) PG8_LDA(At, 1, 1); PG8_STAGE(PG8_SB(1, 0), b3, voffB); PG8_STAGE(PG8_SB(1, 1), b3 + hstep, voffB); PG8_STAGE(PG8_SA(1, 0), a3, voffA);
            PG8_WV; PG8_WAIT_L(0); PG8_BAR; if constexpr (!HALFM) { PG8_MMA(1, 0, At, B0); PG8_MMA(1, 1, At, B1); } PG8_BAR; PG8_SCHED;
            } else {
            PG8_LDB(B0, 0, 0); PG8_SCHED; PG8_LDA(At, 0, 0); PG8_STAGE(PG8_SA(1, 1), a1 + hstepA, voffA);
            PG8_WAIT_L(8); PG8_BAR; PG8_WAIT_L(0); PG8_MMA(0, 0, At, B0); PG8_BAR; PG8_SCHED;
            PG8_LDB(B1, 0, 1); PG8_STAGE(PG8_SB(0, 0), b2, voffB);
            PG8_BAR; PG8_WAIT_L(0); PG8_MMA(0, 1, At, B1); PG8_BAR;
            PG8_LDA(At, 0, 1); PG8_STAGE(PG8_SA(0, 0), a2, voffA);
            PG8_BAR; PG8_WAIT_L(0); PG8_MMA(1, 0, At, B0); PG8_BAR; PG8_SCHED;
            PG8_STAGE(PG8_SB(0, 1), b2 + hstep, voffB);
            PG8_WAIT_V(6); PG8_BAR; PG8_MMA(1, 1, At, B1); PG8_BAR;
            PG8_LDB(B0, 1, 0); PG8_SCHED; PG8_LDA(At, 1, 0); PG8_STAGE(PG8_SA(0, 1), a2 + hstepA, voffA);
            PG8_WAIT_L(8); PG8_BAR; PG8_WAIT_L(0); PG8_MMA(0, 0, At, B0); PG8_BAR; PG8_SCHED;
            PG8_LDB(B1, 1, 1); PG8_STAGE(PG8_SB(1, 0), b3, voffB);
            PG8_BAR; PG8_WAIT_L(0); PG8_MMA(0, 1, At, B1); PG8_BAR;
            PG8_LDA(At, 1, 1); PG8_STAGE(PG8_SA(1, 0), a3, voffA);
            PG8_BAR; PG8_WAIT_L(0); PG8_MMA(1, 0, At, B0); PG8_BAR; PG8_SCHED;
            PG8_STAGE(PG8_SB(1, 1), b3 + hstep, voffB);
            PG8_WAIT_V(6); PG8_BAR; PG8_MMA(1, 1, At, B1); PG8_BAR;
            }
        }
        if constexpr (ALIGN_EPI) { if (wr == 0) PG8_BAR; }
        if constexpr (!Epi::AFTER_DRAIN) { E(acc, cur, wr, wc, fr, fq); S.done(cur); }
        if (!has_next) break;
#pragma unroll
        for (int a = 0; a < 2; ++a)
#pragma unroll
            for (int b = 0; b < 2; ++b)
#pragma unroll
                for (int m = 0; m < 4; ++m)
#pragma unroll
                    for (int n = 0; n < 2; ++n) acc[a][b][m][n] = (f32x4){0.f, 0.f, 0.f, 0.f};
        cur = nxt; cA = nA; cB = nB; ++ui;
        if constexpr (ALIGN_EPI) { if (wr == 1) PG8_BAR; }
    }
    PG8_WAIT_V(0);
    if constexpr (!ALIGN_EPI) { if (wr == 0) PG8_BAR; }
    PG8_BAR;
    if constexpr (Epi::AFTER_DRAIN) { E.fused(acc, cur, wr, wc, fr, fq, lds, wid, lane); S.done(cur); }
#undef PG8_SA
#undef PG8_WV
#undef PG8_SB
#undef PG8_STAGE
#undef PG8_LDA
#undef PG8_LDB
#undef PG8_MMA
#undef PG8_WAIT_V
#undef PG8_WAIT_L
#undef PG8_BAR
#undef PG8_SCHED
}
}
#ifndef PG8_SP2
#define PG8_SP2 true
#endif
#ifndef PG8_ALIGN
#define PG8_ALIGN true
#endif

namespace att {
typedef unsigned short bf16_t;
using bf16x8 = __attribute__((ext_vector_type(8))) short;
using s16x4  = __attribute__((ext_vector_type(4))) short;
using f32x16 = __attribute__((ext_vector_type(16))) float;
using u32x4  = __attribute__((ext_vector_type(4))) unsigned;
constexpr int NW = 8, QBLK = 32, KVBLK = 64;
constexpr int SHM_V = 16384, SHM_K = 16384, SHM_KR = 8192;
constexpr int NVB = ATT_VDMA ? 3 : 2;
constexpr int NKB = (ATT_VDMA == 2) ? 3 : 2;
constexpr int OFF_V = 0, OFF_K = NVB * SHM_V, OFF_KR = OFF_K + NKB * SHM_K, OFF_WS = OFF_KR + NKB * SHM_KR, OFF_QR = OFF_WS + NW * 64 * 4, QR_WAVE = (ATT_VDMA == 2) ? 4096 : 7168, LDS_BYTES = OFF_QR + NW * QR_WAVE;
#ifndef ATTN_THR
#define ATTN_THR 8.f
#endif
constexpr float THR = ATTN_THR;
#define KSWZ(row, colB) ((row) * 256 + ((colB) ^ (((row) & KSWZ_MASK) << 4)))
#define KRSWZ(row, colB) ((row) * 128 + ((colB) ^ ((((row) >> 1) & 7) << 4)))
#define SBAR() __builtin_amdgcn_sched_barrier(0)
__device__ __forceinline__ int crow(int r, int hi) { return (r & 3) + 8 * (r >> 2) + 4 * hi; }
__device__ __forceinline__ unsigned cvtpk(float lo, float hi) { unsigned r; asm volatile("v_cvt_pk_bf16_f32 %0, %1, %2" : "=v"(r) : "v"(lo), "v"(hi)); return r; }
template <int DQK> struct Cfg { static constexpr float SCALE = (DQK == 128) ? 0.08838834764831845f : 0.07216878364870323f; };

__device__ __forceinline__ bf16x8 scale_frag(bf16x8 v, float c) { const u32x4 w = __builtin_bit_cast(u32x4, v); u32x4 o;
#pragma unroll
  for (int i = 0; i < 4; ++i) o[i] = cvtpk(__builtin_bit_cast(float, w[i] << 16) * c, __builtin_bit_cast(float, w[i] & 0xffff0000u) * c);
  return __builtin_bit_cast(bf16x8, o); }
template <int DQK>
__device__ __forceinline__ void partialSM_negm(f32x16& negm, const bool force, f32x16& p0, f32x16& p1, float& alpha) {
  constexpr float THRL = THR * 1.4426950408889634f;
  float pmax = p0[0];
#pragma unroll
  for (int r = 1; r < 16; ++r) pmax = fmaxf(pmax, p0[r]);
#pragma unroll
  for (int r = 0; r < 16; ++r) pmax = fmaxf(pmax, p1[r]);
  { auto rr = __builtin_amdgcn_permlane32_swap(__float_as_uint(pmax), __float_as_uint(pmax), false, false);
    pmax = fmaxf(__uint_as_float(rr[0]), __uint_as_float(rr[1])); }
  if (__builtin_expect(!force && __all(pmax <= THRL), 1)) { alpha = 1.f; }
  else { const float d = force ? pmax : fmaxf(pmax, 0.f);
    alpha = force ? 1.f : __builtin_amdgcn_exp2f(-d);
#pragma unroll
    for (int r = 0; r < 16; ++r) { p0[r] -= d; p1[r] -= d; negm[r] -= d; } }
#pragma unroll
  for (int r = 0; r < 16; ++r) p0[r] = __builtin_amdgcn_exp2f(p0[r]);
}
template <int DQK>
__device__ __forceinline__ void partialSM(f32x16& p0, f32x16& p1, float& m_reg, float& mn, float& alpha) {
  constexpr float SCALE = Cfg<DQK>::SCALE, C = SCALE * 1.4426950408889634f;
  float pmax = p0[0];
#pragma unroll
  for (int r = 1; r < 16; ++r) pmax = fmaxf(pmax, p0[r]);
#pragma unroll
  for (int r = 0; r < 16; ++r) pmax = fmaxf(pmax, p1[r]);
  { auto rr = __builtin_amdgcn_permlane32_swap(__float_as_uint(pmax), __float_as_uint(pmax), false, false);
    pmax = fmaxf(__uint_as_float(rr[0]), __uint_as_float(rr[1])); }
  if (__builtin_expect(__all(pmax - m_reg <= THR / SCALE), 1)) { mn = m_reg; alpha = 1.f; }
  else { mn = fmaxf(m_reg, pmax); alpha = __builtin_amdgcn_exp2f((m_reg - mn) * C); m_reg = mn; }
  const float mnC = -mn * C;
  if constexpr (ATT_PKMATH) {
    typedef float f32x2_ __attribute__((ext_vector_type(2)));
    const f32x2_ c2 = {C, C}, m2 = {mnC, mnC};
#pragma unroll
    for (int r = 0; r < 16; r += 2) { f32x2_ v = {p0[r], p0[r + 1]}; v = __builtin_elementwise_fma(v, c2, m2); p0[r] = v.x; p0[r + 1] = v.y; }
#pragma unroll
    for (int r = 0; r < 16; r += 2) { f32x2_ v = {p1[r], p1[r + 1]}; v = __builtin_elementwise_fma(v, c2, m2); p1[r] = v.x; p1[r + 1] = v.y; }
  } else {
#pragma unroll
  for (int r = 0; r < 16; ++r) p0[r] = fmaf(p0[r], C, mnC);
#pragma unroll
  for (int r = 0; r < 16; ++r) p1[r] = fmaf(p1[r], C, mnC);
  }
#pragma unroll
  for (int r = 0; r < 16; ++r) p0[r] = __builtin_amdgcn_exp2f(p0[r]);
}
__device__ __forceinline__ void finishSM(f32x16& p0, f32x16& p1, float alpha, float& l_reg, bf16x8& pa0, bf16x8& pa1, bf16x8& pa2, bf16x8& pa3) {
#pragma unroll
  for (int r = 0; r < 16; ++r) p1[r] = __builtin_amdgcn_exp2f(p1[r]);
  float ps = 0;
#pragma unroll
  for (int r = 0; r < (ATT_PKMATH ? 0 : 16); ++r) ps += p0[r];
#pragma unroll
  for (int r = 0; r < (ATT_PKMATH ? 0 : 16); ++r) ps += p1[r];
  if constexpr (ATT_PKMATH) {
    typedef float f32x2_ __attribute__((ext_vector_type(2)));
    f32x2_ s2 = {p0[0], p0[1]};
#pragma unroll
    for (int r = 2; r < 16; r += 2) s2 += (f32x2_){p0[r], p0[r + 1]};
#pragma unroll
    for (int r = 0; r < 16; r += 2) s2 += (f32x2_){p1[r], p1[r + 1]};
    ps = s2.x + s2.y;
  }
  { auto rr = __builtin_amdgcn_permlane32_swap(__float_as_uint(ps), __float_as_uint(ps), false, false);
    ps = __uint_as_float(rr[0]) + __uint_as_float(rr[1]); }
  l_reg = l_reg * alpha + ps;
#define PK4(P, BASE, OUT) do { unsigned a0 = cvtpk(P[BASE + 0], P[BASE + 1]), a1 = cvtpk(P[BASE + 2], P[BASE + 3]);   \
    unsigned b0 = cvtpk(P[BASE + 4], P[BASE + 5]), b1 = cvtpk(P[BASE + 6], P[BASE + 7]);                              \
    auto r0 = __builtin_amdgcn_permlane32_swap(a0, b0, false, false); auto r1 = __builtin_amdgcn_permlane32_swap(a1, b1, false, false); \
    u32x4 w = {r0[0], r1[0], r0[1], r1[1]}; OUT = *reinterpret_cast<bf16x8*>(&w); } while (0)
  PK4(p0, 0, pa0); PK4(p0, 8, pa1); PK4(p1, 0, pa2); PK4(p1, 8, pa3);
#undef PK4
}
template <int DQK>
__device__ __forceinline__ void qkt(const f32x16& negm, f32x16& p0, f32x16& p1, const char* Ks, const char* Krs, const bf16x8* qr, const char* qrl, int r32, int hi) {
  constexpr bool NEGM_ = (ATT_NEGM == 1 && DQK == 128) || ATT_NEGM == 2;
  if constexpr (!NEGM_) { p0 = f32x16{}; p1 = f32x16{}; }
  if (ATT_PRIO & 1) __builtin_amdgcn_s_setprio(1);
#pragma unroll
  for (int d0 = 0; d0 < 8; ++d0) { const int cb = (d0 * 16 + hi * 8) * 2;
    const bf16x8 b0 = *reinterpret_cast<const bf16x8*>(Ks + KSWZ(r32, cb));
    const bf16x8 b1 = *reinterpret_cast<const bf16x8*>(Ks + KSWZ(32 + r32, cb));
    bf16x8 qv;
    constexpr int NQR = (DQK == 192) ? ATT_NQ192 : ATT_NQ128;
    if (d0 >= NQR) qv = *reinterpret_cast<const bf16x8*>(qrl + ((DQK == 192 ? 4 : 0) + d0 - NQR) * 1024); else qv = qr[d0 < NQR ? d0 : 0];
    if (NEGM_ && d0 == 0) {
      p0 = __builtin_amdgcn_mfma_f32_32x32x16_bf16(b0, qv, negm, 0, 0, 0);
      p1 = __builtin_amdgcn_mfma_f32_32x32x16_bf16(b1, qv, negm, 0, 0, 0);
    } else {
    p0 = __builtin_amdgcn_mfma_f32_32x32x16_bf16(b0, qv, p0, 0, 0, 0);
    p1 = __builtin_amdgcn_mfma_f32_32x32x16_bf16(b1, qv, p1, 0, 0, 0); } }
  if constexpr (DQK == 192) {
#pragma unroll
    for (int d0 = 0; d0 < 4; ++d0) { const int cb = (d0 * 16 + hi * 8) * 2;
      const bf16x8 b0 = *reinterpret_cast<const bf16x8*>(Krs + KRSWZ(r32, cb));
      const bf16x8 b1 = *reinterpret_cast<const bf16x8*>(Krs + KRSWZ(32 + r32, cb));
      const bf16x8 qv = *reinterpret_cast<const bf16x8*>(qrl + d0 * 1024);
      p0 = __builtin_amdgcn_mfma_f32_32x32x16_bf16(b0, qv, p0, 0, 0, 0);
      p1 = __builtin_amdgcn_mfma_f32_32x32x16_bf16(b1, qv, p1, 0, 0, 0); }
  }
  if (ATT_PRIO & 1) __builtin_amdgcn_s_setprio(0);
}
__device__ __forceinline__ void wmask(f32x16& p0, f32x16& p1, int dbase, int hi) {
#pragma unroll
  for (int r = 0; r < 16; ++r) { const int d0 = dbase + (r & 3) + 8 * (r >> 2) + 4 * hi, d1 = d0 + 32;
    if (d0 > 128 || d0 < -128) p0[r] = -1e30f;
    if (d1 > 128 || d1 < -128) p1[r] = -1e30f; }
}
__device__ __forceinline__ int v_st(int k, int c) { const int kk = (k & ~0xC) | ((k & 4) << 1) | ((k & 8) >> 1); return ((kk >> 3) * 4 + (c >> 5)) * 512 + ((kk & 7) * 32 + (c & 31)) * 2; }
__device__ __forceinline__ int v_rd_base(int lane) { return ((lane & 3) << 3) | (((lane >> 2) & 3) << 6) | (((lane >> 4) & 1) << 5) | (((lane >> 5) & 1) << 8); }
constexpr int v_rd_off(int d0, int ks, int half) { return d0 * 512 + ks * 4096 + half * 2048; }
template <int OFF> __device__ __forceinline__ s16x4 tr_read(int vb) {
  s16x4 r; asm volatile("ds_read_b64_tr_b16 %0, %1 offset:%2" : "=&v"(r) : "v"(vb), "i"(OFF) : "memory"); return r;
}
template <int D0> __device__ __forceinline__ void pv_one(f32x16& od, int vb, bf16x8 pa0, bf16x8 pa1, bf16x8 pa2, bf16x8 pa3) {
  const s16x4 l0 = tr_read<v_rd_off(D0, 0, 0)>(vb), h0 = tr_read<v_rd_off(D0, 0, 1)>(vb), l1 = tr_read<v_rd_off(D0, 1, 0)>(vb), h1 = tr_read<v_rd_off(D0, 1, 1)>(vb);
  const s16x4 l2 = tr_read<v_rd_off(D0, 2, 0)>(vb), h2 = tr_read<v_rd_off(D0, 2, 1)>(vb), l3 = tr_read<v_rd_off(D0, 3, 0)>(vb), h3 = tr_read<v_rd_off(D0, 3, 1)>(vb);
  asm volatile("s_waitcnt lgkmcnt(0)" ::: "memory"); SBAR();
  if (ATT_PRIO & 2) __builtin_amdgcn_s_setprio(1);
#define PK(L, H) (bf16x8){L[0], L[1], L[2], L[3], H[0], H[1], H[2], H[3]}
  od = __builtin_amdgcn_mfma_f32_32x32x16_bf16(pa0, PK(l0, h0), od, 0, 0, 0);
  od = __builtin_amdgcn_mfma_f32_32x32x16_bf16(pa1, PK(l1, h1), od, 0, 0, 0);
  od = __builtin_amdgcn_mfma_f32_32x32x16_bf16(pa2, PK(l2, h2), od, 0, 0, 0);
  od = __builtin_amdgcn_mfma_f32_32x32x16_bf16(pa3, PK(l3, h3), od, 0, 0, 0);
  if (ATT_PRIO & 2) __builtin_amdgcn_s_setprio(0);
#undef PK
}
__device__ __forceinline__ void pv_d0(f32x16* o, int vb, bf16x8 pa0, bf16x8 pa1, bf16x8 pa2, bf16x8 pa3) {
  pv_one<0>(o[0], vb, pa0, pa1, pa2, pa3); pv_one<1>(o[1], vb, pa0, pa1, pa2, pa3); pv_one<2>(o[2], vb, pa0, pa1, pa2, pa3); pv_one<3>(o[3], vb, pa0, pa1, pa2, pa3);
}

template <int DQK, int LDQ, int LDK, int LDV, int LDO, int SDEPTH>
__device__ __forceinline__ void attn_unit(const bf16_t* __restrict__ Qb, const bf16_t* __restrict__ Kh, const bf16_t* __restrict__ Krp, const bf16_t* __restrict__ Vh,
                                          bf16_t* __restrict__ Ob, const int NT, const int base1, const int wmode, const int qpos0, const float m_init, const float l_init, const float* rope_tbl, const float* gq, char* lds, const int tid_in) {
  constexpr int NQ = (DQK == 192) ? ATT_NQ192 : ATT_NQ128;
  int tid_ = tid_in; asm volatile("" : "+v"(tid_));
  const int tid = tid_, wid = tid >> 6, lane = tid & 63, r32 = lane & 31, hi = lane >> 5;
  char* V_lds = lds + OFF_V; char* K_lds = lds + OFF_K; char* KR_lds = lds + OFF_KR;
  float* ws = (float*)(lds + OFF_WS) + wid * 64; float* li_l = ws; float* al_l = ws + 32;
  float m_reg = m_init, l_reg = l_init; f32x16 o[4] = {}; bf16x8 qall[8];
  const bf16_t* Qw = Qb + (long)(wid * QBLK + r32) * LDQ + hi * 8;
#pragma unroll
  for (int d0 = 0; d0 < 8; ++d0) qall[d0] = *reinterpret_cast<const bf16x8*>(Qw + d0 * 16);
  if constexpr (DQK == 128) {
    if (rope_tbl) {
      float x[8][8];
#pragma unroll
      for (int d0 = 0; d0 < 8; ++d0) { const u32x4 w = __builtin_bit_cast(u32x4, qall[d0]);
#pragma unroll
        for (int i = 0; i < 4; ++i) { x[d0][2 * i] = __builtin_bit_cast(float, w[i] << 16); x[d0][2 * i + 1] = __builtin_bit_cast(float, w[i] & 0xffff0000u); } }
      if (gq) { float ss = 0.f;
#pragma unroll
        for (int d0 = 0; d0 < 8; ++d0)
#pragma unroll
          for (int i = 0; i < 8; ++i) ss += x[d0][i] * x[d0][i];
        { auto rr = __builtin_amdgcn_permlane32_swap(__float_as_uint(ss), __float_as_uint(ss), false, false); ss = __uint_as_float(rr[0]) + __uint_as_float(rr[1]); }
        const float r = 1.0f / sqrtf(ss * (1.0f / 128.0f) + 1e-6f);
#pragma unroll
        for (int d0 = 0; d0 < 8; ++d0)
#pragma unroll
          for (int i = 0; i < 8; ++i) x[d0][i] *= r * gq[16 * d0 + 8 * hi + i]; }
      const int t = qpos0 + wid * QBLK + r32;
#pragma unroll
      for (int a = 0; a < 2; ++a) { const int pos = a == 0 ? (t >> 6) : (t & 63);
#pragma unroll
        for (int e = 0; e < 2; ++e) { const float* ct = rope_tbl + (a == 0 ? 0 : 8192) + pos * 32 + 16 * e + 8 * hi; const float* st = ct + (a == 0 ? 4096 : 2048);
#pragma unroll
          for (int i = 0; i < 8; ++i) { const float c = ct[i], s_ = st[i], x1 = x[4 * a + e][i], x2 = x[4 * a + 2 + e][i]; x[4 * a + e][i] = x1 * c - x2 * s_; x[4 * a + 2 + e][i] = x2 * c + x1 * s_; } } }
#pragma unroll
      for (int d0 = 0; d0 < 8; ++d0) { u32x4 w;
#pragma unroll
        for (int i = 0; i < 4; ++i) w[i] = cvtpk(x[d0][2 * i], x[d0][2 * i + 1]);
        qall[d0] = __builtin_bit_cast(bf16x8, w); }
    }
  }
  constexpr bool NEGMU = (ATT_NEGM == 1 && DQK == 128) || ATT_NEGM == 2;
  if constexpr (NEGMU) {
#pragma unroll
    for (int d0 = 0; d0 < 8; ++d0) qall[d0] = scale_frag(qall[d0], Cfg<DQK>::SCALE * 1.4426950408889634f);
  }
  char* qrl = lds + OFF_QR + wid * QR_WAVE + lane * 16;
  bf16x8 qr[NQ];
#pragma unroll
  for (int d0 = 0; d0 < NQ; ++d0) qr[d0] = qall[d0];
#pragma unroll
  for (int d0 = NQ; d0 < 8; ++d0) *reinterpret_cast<bf16x8*>(qrl + ((DQK == 192 ? 4 : 0) + d0 - NQ) * 1024) = qall[d0];
  if constexpr (DQK == 192) {
    bf16x8 qf[4];
#pragma unroll
    for (int d0 = 0; d0 < 4; ++d0) qf[d0] = *reinterpret_cast<const bf16x8*>(Qw + 128 + d0 * 16);
    if (rope_tbl) {
      const int t = qpos0 + wid * QBLK + r32;
#pragma unroll
      for (int a = 0; a < 2; ++a) { const int pos = a == 0 ? (t >> 6) : (t & 63);
        const float* ct = rope_tbl + (a == 0 ? 12288 : 16384) + pos * 16 + hi * 8; const float* st = ct + (a == 0 ? 2048 : 1024);
        u32x4 w1 = __builtin_bit_cast(u32x4, qf[2 * a]), w2 = __builtin_bit_cast(u32x4, qf[2 * a + 1]), o1, o2;
#pragma unroll
        for (int i = 0; i < 4; ++i) { const float c0 = ct[2 * i], c1 = ct[2 * i + 1], s0 = st[2 * i], s1 = st[2 * i + 1];
          const float x1l = __builtin_bit_cast(float, w1[i] << 16), x1h = __builtin_bit_cast(float, w1[i] & 0xffff0000u), x2l = __builtin_bit_cast(float, w2[i] << 16), x2h = __builtin_bit_cast(float, w2[i] & 0xffff0000u);
          o1[i] = cvtpk(x1l * c0 - x2l * s0, x1h * c1 - x2h * s1); o2[i] = cvtpk(x2l * c0 + x1l * s0, x2h * c1 + x1h * s1); }
        qf[2 * a] = __builtin_bit_cast(bf16x8, o1); qf[2 * a + 1] = __builtin_bit_cast(bf16x8, o2); }
    }
    if constexpr (NEGMU) {
#pragma unroll
      for (int d0 = 0; d0 < 4; ++d0) qf[d0] = scale_frag(qf[d0], Cfg<DQK>::SCALE * 1.4426950408889634f); }
#pragma unroll
    for (int d0 = 0; d0 < 4; ++d0) *reinterpret_cast<bf16x8*>(qrl + d0 * 1024) = qf[d0];
  }
  const int sr = tid >> 4, sc = (tid & 15) * 8, vst0 = v_st(sr, sc), vst1 = v_st(32 + sr, sc);
  const int krr = tid >> 3, krc = (tid & 7) * 8;
  const int vb0 = (int)(uintptr_t)V_lds + v_rd_base(lane);
  const int dq = -(qpos0 + wid * QBLK + r32) - 256;
  struct { bf16x8 vs0, vs1, ks0, ks1, kr; } sr_[SDEPTH];
  static_assert(!(ATT_KDMA && SDEPTH != 1), "LDS-DMA staging of K needs SDEPTH 1");
  typedef __attribute__((address_space(3))) unsigned lds_u32;
  const int widu = __builtin_amdgcn_readfirstlane(wid);
  const int kd_row = widu * 4 + (lane >> 4), kd_col = ((lane & 15) ^ (kd_row & KSWZ_MASK)) * 8;
  const int kd_off = kd_row * LDK + kd_col;
  const int kr_row = widu * 8 + (lane >> 3), kr_off = kr_row * 64 + (((lane & 7) ^ ((kr_row >> 1) & 7)) * 8);
  const unsigned lds_base = (unsigned)(uintptr_t)lds;
#define KROW(j) ((j) < 4 ? (j) * 64 : base1 + ((j) - 4) * 64)
#define SLOAD(i, k0, b) do { const int k0_ = (k0); sr_[i].vs0 = *reinterpret_cast<const bf16x8*>(&Vh[(long)(k0_ + sr) * LDV + sc]); sr_[i].vs1 = *reinterpret_cast<const bf16x8*>(&Vh[(long)(k0_ + 32 + sr) * LDV + sc]); \
    if constexpr (ATT_KDMA) { \
      __builtin_amdgcn_global_load_lds((const unsigned*)(Kh + (long)k0_ * LDK + kd_off), (lds_u32*)(uintptr_t)(lds_base + OFF_K + (b) * SHM_K + widu * 1024), 16, 0, 0); \
      __builtin_amdgcn_global_load_lds((const unsigned*)(Kh + (long)(k0_ + 32) * LDK + kd_off), (lds_u32*)(uintptr_t)(lds_base + OFF_K + (b) * SHM_K + 8192 + widu * 1024), 16, 0, 0); \
      if constexpr (DQK == 192) __builtin_amdgcn_global_load_lds((const unsigned*)(Krp + (long)k0_ * 64 + kr_off), (lds_u32*)(uintptr_t)(lds_base + OFF_KR + (b) * SHM_KR + widu * 1024), 16, 0, 0); \
    } else { \
    sr_[i].ks0 = *reinterpret_cast<const bf16x8*>(&Kh[(long)(k0_ + sr) * LDK + sc]); sr_[i].ks1 = *reinterpret_cast<const bf16x8*>(&Kh[(long)(k0_ + 32 + sr) * LDK + sc]); \
    if constexpr (DQK == 192) sr_[i].kr = *reinterpret_cast<const bf16x8*>(&Krp[(long)(k0_ + krr) * 64 + krc]); } } while (0)
#define SWRITE(b, i) do { *(bf16x8*)(V_lds + (b) * SHM_V + vst0) = sr_[i].vs0; *(bf16x8*)(V_lds + (b) * SHM_V + vst1) = sr_[i].vs1; \
    if constexpr (!ATT_KDMA) { const int kc = sc * 2; \
    *(bf16x8*)(K_lds + (b) * SHM_K + KSWZ(sr, kc)) = sr_[i].ks0; *(bf16x8*)(K_lds + (b) * SHM_K + KSWZ(32 + sr, kc)) = sr_[i].ks1; \
    if constexpr (DQK == 192) *(bf16x8*)(KR_lds + (b) * SHM_KR + KRSWZ(krr, krc * 2)) = sr_[i].kr; } } while (0)
#define SWAIT() do { if constexpr (SDEPTH == 1) asm volatile("s_waitcnt vmcnt(0)" ::: "memory"); else if constexpr (DQK == 192) asm volatile("s_waitcnt vmcnt(5)" ::: "memory"); else asm volatile("s_waitcnt vmcnt(4)" ::: "memory"); } while (0)
#define RESC(a) do { if (__any((a) < 1.f)) { if (hi == 0) al_l[r32] = (a); asm volatile("s_waitcnt lgkmcnt(0)" ::: "memory"); \
    _Pragma("unroll") for (int d = 0; d < 4; ++d) _Pragma("unroll") for (int r = 0; r < 16; ++r) o[d][r] *= al_l[crow(r, hi)]; } } while (0)
#define MASK(P0, P1, j) do { if (wmode && (j) >= 4) wmask(P0, P1, KROW(j) + dq, hi); } while (0)
  if (ATT_PRIO & 4) { if (__builtin_amdgcn_readfirstlane(wid) >= 4) __builtin_amdgcn_s_setprio(1); }
  f32x16 pA0, pA1, pB0, pB1; float mnA, mnB, alA, alB; bf16x8 pa0, pa1, pa2, pa3;
  f32x16 negm; { const float nm0 = (m_init > -1e29f) ? -m_init * (Cfg<DQK>::SCALE * 1.4426950408889634f) : 0.f;
#pragma unroll
    for (int r = 0; r < 16; ++r) negm[r] = nm0; }
  bool force_first = !(m_init > -1e29f);
#define PSM(P0, P1, MN, AL) do { if constexpr (NEGMU) { partialSM_negm<DQK>(negm, force_first, P0, P1, AL); force_first = false; } else partialSM<DQK>(P0, P1, m_reg, MN, AL); } while (0)
  if constexpr (ATT_VDMA == 2) {
  static_assert(ATT_KDMA && SDEPTH == 1 && (4 + 8 - NQ) * 1024 <= QR_WAVE + 4096 * (DQK == 128), "ATT_VDMA 2: all nope fragments of Q in VGPRs");
  const int vk0 = (widu >> 1) * 8 + ((lane & 31) >> 2), vkey = (vk0 & ~0xC) | ((vk0 & 4) << 1) | ((vk0 & 8) >> 1);
  const int vd_off = vkey * LDV + ((widu & 1) * 2 + (lane >> 5)) * 32 + (lane & 3) * 8;
  constexpr int NDMA = (DQK == 192) ? 5 : 4;
#define DMA_K(k0, ks) do { const int k0_ = (k0); const int ks_ = (ks); \
      __builtin_amdgcn_global_load_lds((const unsigned*)(Kh + (long)k0_ * LDK + kd_off), (lds_u32*)(uintptr_t)(lds_base + OFF_K + ks_ * SHM_K + widu * 1024), 16, 0, 0); \
      __builtin_amdgcn_global_load_lds((const unsigned*)(Kh + (long)(k0_ + 32) * LDK + kd_off), (lds_u32*)(uintptr_t)(lds_base + OFF_K + ks_ * SHM_K + 8192 + widu * 1024), 16, 0, 0); \
      if constexpr (DQK == 192) __builtin_amdgcn_global_load_lds((const unsigned*)(Krp + (long)k0_ * 64 + kr_off), (lds_u32*)(uintptr_t)(lds_base + OFF_KR + ks_ * SHM_KR + widu * 1024), 16, 0, 0); } while (0)
#define DMA_V(k0, vs) do { const int k0_ = (k0); const int vs_ = (vs); \
      __builtin_amdgcn_global_load_lds((const unsigned*)(Vh + (long)k0_ * LDV + vd_off), (lds_u32*)(uintptr_t)(lds_base + OFF_V + vs_ * SHM_V + widu * 1024), 16, 0, 0); \
      __builtin_amdgcn_global_load_lds((const unsigned*)(Vh + (long)(k0_ + 32) * LDV + vd_off), (lds_u32*)(uintptr_t)(lds_base + OFF_V + vs_ * SHM_V + 8192 + widu * 1024), 16, 0, 0); } while (0)
#define VM0_SYNC() do { asm volatile("s_waitcnt vmcnt(0)" ::: "memory"); __syncthreads(); } while (0)
#define VMN_SYNC() do { if constexpr (DQK == 192) asm volatile("s_waitcnt vmcnt(5)" ::: "memory"); else asm volatile("s_waitcnt vmcnt(4)" ::: "memory"); __syncthreads(); } while (0)
#define R3_PREV(s_) ((s_) >= 1 ? (s_) - 1 : 2)
#define R3_NEXT(s_) ((s_) == 2 ? 0 : (s_) + 1)
#define KT(t) KROW((t) < NT ? (t) : NT - 1)
  DMA_K(0, 0); DMA_V(0, 0); DMA_K(KROW(1), 1); DMA_V(KROW(1), 1); DMA_K(KROW(2), 2); VM0_SYNC();
  qkt<DQK>(negm, pA0, pA1, K_lds, KR_lds, qr, qrl, r32, hi); PSM(pA0, pA1, mnA, alA);
  __syncthreads();
  const bool stag = ((DQK == 128) ? (ATT_STAG & 1) : (ATT_STAG & 2)) && (__builtin_amdgcn_readfirstlane(wid) >= 4);
  int sp = 0;
  if (!stag) {
  for (int j = 1; j + 1 < NT; j += 2) {
    { const int kq = R3_NEXT(sp);
    SBAR(); qkt<DQK>(negm, pB0, pB1, K_lds + kq * SHM_K, KR_lds + kq * SHM_KR, qr, qrl, r32, hi); MASK(pB0, pB1, j);
    finishSM(pA0, pA1, alA, l_reg, pa0, pa1, pa2, pa3); SBAR();
    DMA_K(KT(j + 2), sp); DMA_V(KROW(j + 1), R3_PREV(sp)); SBAR();
    pv_d0(o, vb0 + sp * SHM_V, pa0, pa1, pa2, pa3); PSM(pB0, pB1, mnB, alB);
    VMN_SYNC(); RESC(alB); sp = kq; }
    { const int kq = R3_NEXT(sp);
    SBAR(); qkt<DQK>(negm, pA0, pA1, K_lds + kq * SHM_K, KR_lds + kq * SHM_KR, qr, qrl, r32, hi); MASK(pA0, pA1, j + 1);
    finishSM(pB0, pB1, alB, l_reg, pa0, pa1, pa2, pa3); SBAR();
    DMA_K(KT(j + 3), sp); DMA_V(KROW(j + 2), R3_PREV(sp)); SBAR();
    pv_d0(o, vb0 + sp * SHM_V, pa0, pa1, pa2, pa3); PSM(pA0, pA1, mnA, alA);
    VMN_SYNC(); RESC(alA); sp = kq; }
  }
  } else {
  for (int j = 1; j + 1 < NT; j += 2) {
    { const int kq = R3_NEXT(sp);
    SBAR(); finishSM(pA0, pA1, alA, l_reg, pa0, pa1, pa2, pa3); SBAR();
    qkt<DQK>(negm, pB0, pB1, K_lds + kq * SHM_K, KR_lds + kq * SHM_KR, qr, qrl, r32, hi); MASK(pB0, pB1, j); SBAR();
    DMA_K(KT(j + 2), sp); DMA_V(KROW(j + 1), R3_PREV(sp)); SBAR();
    PSM(pB0, pB1, mnB, alB); SBAR(); pv_d0(o, vb0 + sp * SHM_V, pa0, pa1, pa2, pa3);
    VMN_SYNC(); RESC(alB); sp = kq; }
    { const int kq = R3_NEXT(sp);
    SBAR(); finishSM(pB0, pB1, alB, l_reg, pa0, pa1, pa2, pa3); SBAR();
    qkt<DQK>(negm, pA0, pA1, K_lds + kq * SHM_K, KR_lds + kq * SHM_KR, qr, qrl, r32, hi); MASK(pA0, pA1, j + 1); SBAR();
    DMA_K(KT(j + 3), sp); DMA_V(KROW(j + 2), R3_PREV(sp)); SBAR();
    PSM(pA0, pA1, mnA, alA); SBAR(); pv_d0(o, vb0 + sp * SHM_V, pa0, pa1, pa2, pa3);
    VMN_SYNC(); RESC(alA); sp = kq; }
  }
  }
  { const int kq = R3_NEXT(sp);
  SBAR(); qkt<DQK>(negm, pB0, pB1, K_lds + kq * SHM_K, KR_lds + kq * SHM_KR, qr, qrl, r32, hi); MASK(pB0, pB1, NT - 1);
  finishSM(pA0, pA1, alA, l_reg, pa0, pa1, pa2, pa3); SBAR();
  pv_d0(o, vb0 + sp * SHM_V, pa0, pa1, pa2, pa3); PSM(pB0, pB1, mnB, alB);
  VM0_SYNC(); RESC(alB); sp = kq; }
  finishSM(pB0, pB1, alB, l_reg, pa0, pa1, pa2, pa3); SBAR();
  pv_d0(o, vb0 + sp * SHM_V, pa0, pa1, pa2, pa3);
#undef DMA_K
#undef DMA_V
#undef VM0_SYNC
#undef VMN_SYNC
#undef R3_PREV
#undef R3_NEXT
#undef KT
  } else if constexpr (ATT_VDMA == 1) {
  static_assert(ATT_KDMA && SDEPTH == 1, "ATT_VDMA builds on ATT_KDMA");
  const int vk0 = (widu >> 1) * 8 + ((lane & 31) >> 2), vkey = (vk0 & ~0xC) | ((vk0 & 4) << 1) | ((vk0 & 8) >> 1);
  const int vd_off = vkey * LDV + ((widu & 1) * 2 + (lane >> 5)) * 32 + (lane & 3) * 8;
#define DMA_KV(k0, kb, vsl) do { const int k0_ = (k0); \
      __builtin_amdgcn_global_load_lds((const unsigned*)(Kh + (long)k0_ * LDK + kd_off), (lds_u32*)(uintptr_t)(lds_base + OFF_K + (kb) * SHM_K + widu * 1024), 16, 0, 0); \
      __builtin_amdgcn_global_load_lds((const unsigned*)(Kh + (long)(k0_ + 32) * LDK + kd_off), (lds_u32*)(uintptr_t)(lds_base + OFF_K + (kb) * SHM_K + 8192 + widu * 1024), 16, 0, 0); \
      if constexpr (DQK == 192) __builtin_amdgcn_global_load_lds((const unsigned*)(Krp + (long)k0_ * 64 + kr_off), (lds_u32*)(uintptr_t)(lds_base + OFF_KR + (kb) * SHM_KR + widu * 1024), 16, 0, 0); \
      __builtin_amdgcn_global_load_lds((const unsigned*)(Vh + (long)k0_ * LDV + vd_off), (lds_u32*)(uintptr_t)(lds_base + OFF_V + (vsl) + widu * 1024), 16, 0, 0); \
      __builtin_amdgcn_global_load_lds((const unsigned*)(Vh + (long)(k0_ + 32) * LDV + vd_off), (lds_u32*)(uintptr_t)(lds_base + OFF_V + (vsl) + 8192 + widu * 1024), 16, 0, 0); } while (0)
#define VM0_SYNC() do { asm volatile("s_waitcnt vmcnt(0)" ::: "memory"); __syncthreads(); } while (0)
#define VS_DMA(sp_) (((sp_) >= 1 ? (sp_) - 1 : 2) * SHM_V)
#define VS_NEXT(sp_) ((sp_) == 2 ? 0 : (sp_) + 1)
  DMA_KV(0, 0, 0); VM0_SYNC();
  qkt<DQK>(negm, pA0, pA1, K_lds, KR_lds, qr, qrl, r32, hi); PSM(pA0, pA1, mnA, alA);
  DMA_KV(KROW(1), 1, SHM_V); VM0_SYNC();
  const bool stag = ((DQK == 128) ? (ATT_STAG & 1) : (ATT_STAG & 2)) && (__builtin_amdgcn_readfirstlane(wid) >= 4);
  int sp = 0;
  if (!stag) {
  for (int j = 1; j + 1 < NT; j += 2) {
    SBAR(); qkt<DQK>(negm, pB0, pB1, K_lds + SHM_K, KR_lds + SHM_KR, qr, qrl, r32, hi); MASK(pB0, pB1, j);
    finishSM(pA0, pA1, alA, l_reg, pa0, pa1, pa2, pa3); SBAR();
    DMA_KV(KROW(j + 1), 0, VS_DMA(sp)); SBAR();
    pv_d0(o, vb0 + sp * SHM_V, pa0, pa1, pa2, pa3); PSM(pB0, pB1, mnB, alB);
    VM0_SYNC(); RESC(alB); sp = VS_NEXT(sp);
    SBAR(); qkt<DQK>(negm, pA0, pA1, K_lds, KR_lds, qr, qrl, r32, hi); MASK(pA0, pA1, j + 1);
    finishSM(pB0, pB1, alB, l_reg, pa0, pa1, pa2, pa3); SBAR();
    DMA_KV(KROW(j + 2), 1, VS_DMA(sp)); SBAR();
    pv_d0(o, vb0 + sp * SHM_V, pa0, pa1, pa2, pa3); PSM(pA0, pA1, mnA, alA);
    VM0_SYNC(); RESC(alA); sp = VS_NEXT(sp);
  }
  } else {
  for (int j = 1; j + 1 < NT; j += 2) {
    SBAR(); finishSM(pA0, pA1, alA, l_reg, pa0, pa1, pa2, pa3); SBAR();
    qkt<DQK>(negm, pB0, pB1, K_lds + SHM_K, KR_lds + SHM_KR, qr, qrl, r32, hi); MASK(pB0, pB1, j); SBAR();
    DMA_KV(KROW(j + 1), 0, VS_DMA(sp)); SBAR();
    PSM(pB0, pB1, mnB, alB); SBAR(); pv_d0(o, vb0 + sp * SHM_V, pa0, pa1, pa2, pa3);
    VM0_SYNC(); RESC(alB); sp = VS_NEXT(sp);
    SBAR(); finishSM(pB0, pB1, alB, l_reg, pa0, pa1, pa2, pa3); SBAR();
    qkt<DQK>(negm, pA0, pA1, K_lds, KR_lds, qr, qrl, r32, hi); MASK(pA0, pA1, j + 1); SBAR();
    DMA_KV(KROW(j + 2), 1, VS_DMA(sp)); SBAR();
    PSM(pA0, pA1, mnA, alA); SBAR(); pv_d0(o, vb0 + sp * SHM_V, pa0, pa1, pa2, pa3);
    VM0_SYNC(); RESC(alA); sp = VS_NEXT(sp);
  }
  }
  SBAR(); qkt<DQK>(negm, pB0, pB1, K_lds + SHM_K, KR_lds + SHM_KR, qr, qrl, r32, hi); MASK(pB0, pB1, NT - 1);
  finishSM(pA0, pA1, alA, l_reg, pa0, pa1, pa2, pa3); SBAR();
  pv_d0(o, vb0 + sp * SHM_V, pa0, pa1, pa2, pa3); PSM(pB0, pB1, mnB, alB);
  RESC(alB); sp = VS_NEXT(sp);
  finishSM(pB0, pB1, alB, l_reg, pa0, pa1, pa2, pa3); SBAR();
  pv_d0(o, vb0 + sp * SHM_V, pa0, pa1, pa2, pa3);
#undef DMA_KV
#undef VM0_SYNC
#undef VS_DMA
#undef VS_NEXT
  } else {
  constexpr int SE = 0, SO = SDEPTH - 1;
  SLOAD(SE, 0, 0); asm volatile("s_waitcnt vmcnt(0)" ::: "memory"); SWRITE(0, SE); __syncthreads();
  qkt<DQK>(negm, pA0, pA1, K_lds, KR_lds, qr, qrl, r32, hi); PSM(pA0, pA1, mnA, alA);
  SLOAD(SO, KROW(1), 1); if constexpr (SDEPTH == 2) { if (2 < NT) SLOAD(SE, KROW(2), 0); }
  SWAIT(); SWRITE(1, SO); __syncthreads();
  const bool stag = ((DQK == 128) ? (ATT_STAG & 1) : (ATT_STAG & 2)) && (__builtin_amdgcn_readfirstlane(wid) >= 4);
  if (!stag) {
  for (int j = 1; j + 1 < NT; j += 2) {
    SBAR(); qkt<DQK>(negm, pB0, pB1, K_lds + SHM_K, KR_lds + SHM_KR, qr, qrl, r32, hi); MASK(pB0, pB1, j);
    finishSM(pA0, pA1, alA, l_reg, pa0, pa1, pa2, pa3); SBAR();
    SLOAD(SO, KROW(j + SDEPTH), 0); SBAR();
    pv_d0(o, vb0, pa0, pa1, pa2, pa3); PSM(pB0, pB1, mnB, alB);
    __syncthreads(); SWAIT(); SWRITE(0, SE);
    RESC(alB); __syncthreads();
    SBAR(); qkt<DQK>(negm, pA0, pA1, K_lds, KR_lds, qr, qrl, r32, hi); MASK(pA0, pA1, j + 1);
    finishSM(pB0, pB1, alB, l_reg, pa0, pa1, pa2, pa3); SBAR();
    if (SDEPTH == 1 || j + 3 < NT) SLOAD(SE, KROW(j + 1 + SDEPTH), 1); SBAR();
    pv_d0(o, vb0 + SHM_V, pa0, pa1, pa2, pa3); PSM(pA0, pA1, mnA, alA);
    __syncthreads(); SWAIT(); SWRITE(1, SO);
    RESC(alA); __syncthreads();
  }
  } else {
  for (int j = 1; j + 1 < NT; j += 2) {
    SBAR(); finishSM(pA0, pA1, alA, l_reg, pa0, pa1, pa2, pa3); SBAR();
    qkt<DQK>(negm, pB0, pB1, K_lds + SHM_K, KR_lds + SHM_KR, qr, qrl, r32, hi); MASK(pB0, pB1, j); SBAR();
    SLOAD(SO, KROW(j + SDEPTH), 0); SBAR();
    PSM(pB0, pB1, mnB, alB); SBAR(); pv_d0(o, vb0, pa0, pa1, pa2, pa3);
    __syncthreads(); SWAIT(); SWRITE(0, SE);
    RESC(alB); __syncthreads();
    SBAR(); finishSM(pB0, pB1, alB, l_reg, pa0, pa1, pa2, pa3); SBAR();
    qkt<DQK>(negm, pA0, pA1, K_lds, KR_lds, qr, qrl, r32, hi); MASK(pA0, pA1, j + 1); SBAR();
    if (SDEPTH == 1 || j + 3 < NT) SLOAD(SE, KROW(j + 1 + SDEPTH), 1); SBAR();
    PSM(pA0, pA1, mnA, alA); SBAR(); pv_d0(o, vb0 + SHM_V, pa0, pa1, pa2, pa3);
    __syncthreads(); SWAIT(); SWRITE(1, SO);
    RESC(alA); __syncthreads();
  }
  }
  SBAR(); qkt<DQK>(negm, pB0, pB1, K_lds + SHM_K, KR_lds + SHM_KR, qr, qrl, r32, hi); MASK(pB0, pB1, NT - 1);
  finishSM(pA0, pA1, alA, l_reg, pa0, pa1, pa2, pa3); SBAR();
  pv_d0(o, vb0, pa0, pa1, pa2, pa3); PSM(pB0, pB1, mnB, alB);
  __syncthreads(); RESC(alB);
  finishSM(pB0, pB1, alB, l_reg, pa0, pa1, pa2, pa3); SBAR();
  pv_d0(o, vb0 + SHM_V, pa0, pa1, pa2, pa3);
  }
  if (ATT_PRIO & 4) __builtin_amdgcn_s_setprio(0);
  { const int lane_e = lane_id_fresh(), r32e = lane_e & 31, hie = lane_e >> 5; const int wide = __builtin_amdgcn_readfirstlane(wid);
  float* ws_e = (float*)(lds + OFF_WS) + wide * 64;
  if (hie == 0) ws_e[r32e] = l_reg; asm volatile("s_waitcnt lgkmcnt(0)" ::: "memory");
  float rli[16];
#pragma unroll
  for (int r = 0; r < 16; ++r) rli[r] = __builtin_amdgcn_rcpf(ws_e[crow(r, hie)]);
  __syncthreads();
  { bf16_t* stg = (bf16_t*)(lds + wide * 8192);
#pragma unroll
    for (int r = 0; r < 16; r += 2) { const int orow = crow(r, hie);
#pragma unroll
      for (int d0 = 0; d0 < 4; ++d0) { const unsigned pk = cvtpk(o[d0][r] * rli[r], o[d0][r + 1] * rli[r + 1]);
        stg[orow * 128 + d0 * 32 + r32e] = (bf16_t)(pk & 0xffffu); stg[(orow + 1) * 128 + d0 * 32 + r32e] = (bf16_t)(pk >> 16); } }
    asm volatile("s_waitcnt lgkmcnt(0)" ::: "memory");
    bf16_t* Ow = Ob + (long)(wide * QBLK) * LDO;
#pragma unroll
    for (int i = 0; i < 8; ++i) { const int ch = i * 64 + lane_e, row = ch >> 4, c8 = (ch & 15) * 8;
      const u32x4 v = *(const u32x4*)(stg + row * 128 + c8); *(u32x4*)(Ow + (long)row * LDO + c8) = v; }
  } }
  __syncthreads();
#undef PSM
#undef KROW
#undef SLOAD
#undef SWRITE
#undef SWAIT
#undef RESC
#undef MASK
}
#undef KSWZ
#undef KRSWZ
#undef SBAR
}

constexpr int NWAVES = 8;
constexpr size_t MiB = 1u << 20;
constexpr size_t WS_CTL = 0, CTL_ZERO_BYTES = 2 * MiB;
constexpr size_t WS_MOD = 1 * MiB;
constexpr size_t WS_TBL = 2 * MiB;
constexpr size_t SZ_WGU = (size_t)2 * DFF * DM * 2, SZ_WDN = (size_t)DM * DFF * 2;
constexpr size_t WS_WGU = 4 * MiB;
constexpr size_t WS_WDN = WS_WGU + 8 * SZ_WGU;
constexpr size_t SZ_WINAB = (size_t)AB_IN * DM * 2, SZ_WSQ = (size_t)DM * DM * 2, SZ_WINC = (size_t)C_IN_PAD * DM * 2, SZ_WUQ = (size_t)MLA_QOUT * QRANK * 2, SZ_WUKV = (size_t)MLA_KVOUT * KVRANK * 2;
constexpr size_t WS_WINAB = WS_WDN + 8 * SZ_WDN;
constexpr size_t WS_WOUTAB = WS_WINAB + 2 * SZ_WINAB;
constexpr size_t WS_WINC = WS_WOUTAB + 2 * SZ_WSQ;
constexpr size_t WS_WUQ = WS_WINC + 2 * SZ_WINC;
constexpr size_t WS_WUKV = WS_WUQ + 2 * SZ_WUQ;
constexpr size_t WS_WOUTC = WS_WUKV + 2 * SZ_WUKV;
constexpr size_t WS_X = WS_WOUTC + 2 * SZ_WSQ;
constexpr size_t WS_XN = WS_X + (size_t)MROWS * DM * 4;
constexpr size_t WS_H = WS_XN + (size_t)MROWS * DM * 2;
constexpr size_t WS_QKV = WS_H + (size_t)MROWS * DFF * 2;
constexpr size_t WS_KV = WS_QKV + (size_t)MROWS * 3072 * 2;
constexpr size_t WS_CQ = WS_KV + (size_t)MROWS * 4096 * 2;
constexpr size_t WS_CQN = WS_CQ + (size_t)MROWS * 1024 * 2;
constexpr size_t WS_CKVN = WS_CQN + (size_t)MROWS * 512 * 2;
constexpr size_t WS_KR = WS_CKVN + (size_t)MROWS * 256 * 2;
constexpr size_t WS_O = WS_KR + (size_t)MROWS * 64 * 2;
constexpr size_t WS_PARTC = WS_O + (size_t)MROWS * DM * 2;
constexpr size_t WS_PIN = WS_PARTC + (size_t)11 * 512 * DM * 4;
constexpr size_t WS_END = WS_PIN + (size_t)8 * 512 * 3072 * 4;
static_assert(WS_WGU % 256 == 0 && WS_X % 256 == 0 && WS_O % 256 == 0, "alignment");
constexpr int T_HRC = 0, T_HRS = 4096, T_HCC = 8192, T_HCS = 10240, T_MRC = 12288, T_MRS = 14336, T_MCC = 16384, T_MCS = 17408, T_END = 18432;
constexpr int CW_BAR = 4096;
constexpr int RING_OFF = 0, RING_BYTES = 131072, LDS_BYTES = 163840, LDSCTL_OFF = LDS_BYTES - 1024, MISC_OFF = LDSCTL_OFF + 320;
static_assert(att::LDS_BYTES <= LDSCTL_OFF, "attention scratch vs control words");

#define GAS __attribute__((address_space(1)))
#define LAS __attribute__((address_space(3)))
typedef unsigned short bf16;
typedef unsigned v4u __attribute__((ext_vector_type(4)));
typedef unsigned v2u __attribute__((ext_vector_type(2)));
typedef float f32x4 __attribute__((ext_vector_type(4)));
typedef GAS unsigned gu32;
#define RLX_AGENT __ATOMIC_RELAXED, __HIP_MEMORY_SCOPE_AGENT
#define LDS_WAIT() asm volatile("s_waitcnt lgkmcnt(0)" ::: "memory")
__device__ __forceinline__ unsigned f2bf(float f) { unsigned u = __builtin_bit_cast(unsigned, f); return (u + 0x7fffu + ((u >> 16) & 1u)) >> 16; }
__device__ __forceinline__ unsigned pk2(float lo, float hi) { return f2bf(lo) | (f2bf(hi) << 16); }
__device__ __forceinline__ float bf2f(unsigned short h) { return __builtin_bit_cast(float, (unsigned)h << 16); }
__device__ __forceinline__ float bflo(unsigned w) { return __builtin_bit_cast(float, w << 16); }
__device__ __forceinline__ float bfhi(unsigned w) { return __builtin_bit_cast(float, w & 0xffff0000u); }
__device__ __forceinline__ float wave_sum(float v) {
    const int l4 = lane_id_fresh() << 2;
#pragma unroll
    for (int o = 1; o < 64; o <<= 1) v += __builtin_bit_cast(float, __builtin_amdgcn_ds_bpermute(l4 ^ (o << 2), __builtin_bit_cast(int, v)));
    return v;
}

#define XB_TMO      128
#define XB_XCNT(j)  (256  + 64 * (j))
#define XB_XSUB(j)  (1280 + 64 * (j))
#define XB_XGEN(j)  (2304 + 64 * (j))
#define XB_TOP      3328
#define XB_TOPGEN   3392
#define XCD_BAR_WORDS 3456
#define XB_SPIN_CAP (1u << 18)

__device__ __forceinline__ unsigned xb_ld(unsigned* p)              { return __hip_atomic_load(p, __ATOMIC_RELAXED, __HIP_MEMORY_SCOPE_AGENT); }
__device__ __forceinline__ unsigned xb_add(unsigned* p, unsigned v) { return __hip_atomic_fetch_add(p, v, __ATOMIC_RELAXED, __HIP_MEMORY_SCOPE_AGENT); }
__device__ __forceinline__ unsigned xb_xcc_id() { return (unsigned)__builtin_amdgcn_s_getreg((3 << 11) | 20) & 0xFu; }
#define XB_SPIN(cond, bar) do { unsigned _sp = 0; while (cond) { __builtin_amdgcn_s_sleep(1); \
    if ((++_sp & 255u) == 0u) { if (xb_ld(&(bar)[XB_TMO])) break; if (_sp > XB_SPIN_CAP) { atomicAdd(&(bar)[XB_TMO], 1u); break; } } } } while (0)

struct XcdBarrier {
    unsigned* bar; unsigned x;
    volatile LAS unsigned* st;
};

__device__ __forceinline__ XcdBarrier xcd_barrier_post(unsigned* bar, volatile LAS unsigned* st, const bool t0) {
    XcdBarrier b; b.bar = bar; b.x = xb_xcc_id(); b.st = st;
    if (t0) (void)xb_add(&bar[XB_XCNT(b.x)], 1u);
    return b;
}
__device__ __forceinline__ void xcd_barrier_complete(unsigned* bar, unsigned x, unsigned& nloc, unsigned& nx) {
    const unsigned G = gridDim.x * gridDim.y * gridDim.z;
    unsigned sum, cnt, mine, sp = 0u;
    for (;;) {
        sum = 0u; cnt = 0u; mine = 0u;
#pragma unroll
        for (unsigned j = 0; j < 16; ++j) { const unsigned c = xb_ld(&bar[XB_XCNT(j)]); sum += c; cnt += (c > 0u) ? 1u : 0u; mine = (j == x) ? c : mine; }
        if (sum == G) break;
        __builtin_amdgcn_s_sleep(1);
        if ((++sp & 255u) == 0u) { if (xb_ld(&bar[XB_TMO])) break; if (sp > XB_SPIN_CAP) { atomicAdd(&bar[XB_TMO], 1u); break; } }
    }
    nloc = mine > 0u ? mine : 1u; nx = cnt > 0u ? cnt : 1u;
}

__device__ __forceinline__ void xcd_barrier(const XcdBarrier& b, const bool t0) {
    asm volatile("s_waitcnt vmcnt(0)" ::: "memory");
    __syncthreads();
    if (t0) {
        unsigned* bar = b.bar;
        __builtin_amdgcn_s_waitcnt(0);
        unsigned nloc = b.st[0], nx = b.st[1];
        if (nloc == 0u) { xcd_barrier_complete(bar, b.x, nloc, nx); b.st[0] = nloc; b.st[1] = nx; }
        const unsigned old = xb_add(&bar[XB_XSUB(b.x)], 1u);
        const unsigned gen = old / nloc;
#if PROBE_WAIT_LOCAL
        __hip_atomic_fetch_max(&bar[12288 + gen * 16 + b.x], (unsigned)__builtin_amdgcn_s_memrealtime(), __ATOMIC_RELAXED, __HIP_MEMORY_SCOPE_AGENT);
#endif
        if (old + 1u == (gen + 1u) * nloc) {
            __builtin_amdgcn_fence(__ATOMIC_RELEASE, "agent");
            asm volatile("s_waitcnt vmcnt(0)" ::: "memory");
            const unsigned og = xb_add(&bar[XB_TOP], 1u);
            const unsigned tg = og / nx;
            if (og + 1u == (tg + 1u) * nx) xb_add(&bar[XB_TOPGEN], 1u);
            else XB_SPIN(xb_ld(&bar[XB_TOPGEN]) == tg, bar);
            __builtin_amdgcn_fence(__ATOMIC_ACQUIRE, "agent");
            xb_add(&bar[XB_XGEN(b.x)], 1u);
            asm volatile("s_waitcnt vmcnt(0)" ::: "memory");
        } else {
            XB_SPIN(xb_ld(&bar[XB_XGEN(b.x)]) == gen, bar);
            __builtin_amdgcn_fence(__ATOMIC_ACQUIRE, "agent");
            asm volatile("s_waitcnt vmcnt(0)" ::: "memory");
        }
    }
    __syncthreads();
}
__device__ __forceinline__ void p0_mod(const float* __restrict__ c, const float* __restrict__ cctx, const float* __restrict__ wmod, float* PART,
                                       LAS unsigned char* lds, int tid, int wave, int lane) {
    LAS float* sv = (LAS float*)lds;
    LAS float* red = (LAS float*)(lds + 24576);
    for (int i = tid; i < 3 * 2048; i += 512) { const int v = i >> 11, k = i & 2047; const float x = v < 2 ? c[v * 2048 + k] : cctx[k]; sv[i] = x / (1.0f + expf(-x)); }
    __syncthreads();
    for (int t = blockIdx.x; t < 2304; t += gridDim.x) {
        const int l = t / 576, rem = t - l * 576, nch = rem >> 3, kch = rem & 7;
        const int k0 = kch * 256 + wave * 32;
        const float* W = wmod + ((size_t)l * 2048 + k0) * 18432 + nch * 256 + lane * 4;
        f32x4 a0 = {0.f, 0.f, 0.f, 0.f}, a1 = a0, a2 = a0;
#pragma unroll 8
        for (int kk = 0; kk < 32; ++kk) { const f32x4 w = NT_W ? __builtin_nontemporal_load((const f32x4*)(W + (size_t)kk * 18432)) : *(const f32x4*)(W + (size_t)kk * 18432);
            a0 += sv[k0 + kk] * w; a1 += sv[2048 + k0 + kk] * w; a2 += sv[4096 + k0 + kk] * w; }
#pragma unroll
        for (int j = 0; j < 4; ++j) { red[(wave * 12 + j) * 64 + lane] = a0[j]; red[(wave * 12 + 4 + j) * 64 + lane] = a1[j]; red[(wave * 12 + 8 + j) * 64 + lane] = a2[j]; }
        __syncthreads();
        for (int idx = tid; idx < 768; idx += 512) { const int v = idx >> 8, cc = idx & 255, ln = cc >> 2, j = cc & 3; float s = 0.f;
#pragma unroll
            for (int w = 0; w < 8; ++w) s += red[(w * 12 + v * 4 + j) * 64 + ln];
            PART[(size_t)((l * 8 + kch) * 3 + v) * 18432 + nch * 256 + cc] = s; }
        __syncthreads();
    }
}
__device__ __forceinline__ void p0_mod_sum(const float* PART, const float* __restrict__ bmod, float* MOD, int gtid, int NT_) {
    for (int i = gtid; i < DEPTH * 3 * 18432; i += NT_) { const int l = i / (3 * 18432), r = i - l * 3 * 18432, v = r / 18432, n = r - v * 18432;
        float s = bmod[(size_t)l * 18432 + n];
#pragma unroll
        for (int k = 0; k < 8; ++k) s += PART[(size_t)((l * 8 + k) * 3 + v) * 18432 + n];
        MOD[i] = s; }
}
template <int MAP>
__device__ __forceinline__ void p0_transpose_item(const float* __restrict__ W, int K, int N, bf16* WT, LAS float* scr, int item, int lane) {
    const int nblk = N / 32, kb = item / nblk, nb = item - kb * nblk, k0 = 64 * kb, n0 = 32 * nb;
#pragma unroll 16
    for (int i = 0; i < 32; ++i) { const int kk = 2 * i + (lane >> 5); const float* wp = W + (size_t)(k0 + kk) * N + n0 + (lane & 31); scr[kk * 33 + (lane & 31)] = NT_W ? __builtin_nontemporal_load(wp) : *wp; }
    LDS_WAIT(); asm volatile("" ::: "memory");
    int r0 = n0;
    if (MAP == 1) { r0 = n0 < DFF ? (n0 / 128) * 256 + (n0 % 128) : ((n0 - DFF) / 128) * 256 + 128 + ((n0 - DFF) % 128); }
    const int c = lane & 7;
#pragma unroll
    for (int j = 0; j < 4; ++j) { const int n = (lane >> 3) + 8 * j; const LAS float* s = scr + (8 * c) * 33 + n;
        v4u o; o.x = pk2(s[0 * 33], s[1 * 33]); o.y = pk2(s[2 * 33], s[3 * 33]); o.z = pk2(s[4 * 33], s[5 * 33]); o.w = pk2(s[6 * 33], s[7 * 33]);
        *(GAS v4u*)(WT + (size_t)(r0 + n) * K + k0 + 8 * c) = o; }
    LDS_WAIT(); asm volatile("" ::: "memory");
}
__device__ __forceinline__ double my_exp(double y) {
    const double t = y * (1.0 / 1024.0); double e = 1.0, term = 1.0;
#pragma unroll
    for (int i = 1; i <= 10; ++i) { term *= t * (1.0 / i); e += term; }
#pragma unroll
    for (int i = 0; i < 10; ++i) e *= e;
    return e;
}
__device__ __forceinline__ void my_sincos(double x, double& s, double& c) {
    const double k = __builtin_rint(x * 0.15915494309189535);
    const double r = (x - k * 6.283185307179586) - k * 2.4492935982947064e-16;
    const double r2 = r * r; double cs = 1.0, sn = r, tc = 1.0, ts = r;
#pragma unroll
    for (int i = 1; i <= 16; ++i) { tc *= -r2 * (1.0 / ((2.0 * i - 1.0) * (2.0 * i))); cs += tc; ts *= -r2 * (1.0 / ((2.0 * i) * (2.0 * i + 1.0))); sn += ts; }
    s = sn; c = cs;
}

__device__ __forceinline__ void convert_layer(const float* __restrict__ wgu, const float* __restrict__ wdn, const float* __restrict__ winab, const float* __restrict__ woutab, const float* __restrict__ winc,
                                              const float* __restrict__ wuq, const float* __restrict__ wukv, const float* __restrict__ woutc, unsigned char* ws,
                                              int ly, int part, int nparts, int widx, int nw, LAS float* scr, int lane) {
    constexpr int I_GU = 32 * 352, I_DN = 88 * 64, I_INAB = 32 * 96, I_SQ = 32 * 64, I_INC = 32 * 26, I_UQ = 8 * 96, I_UKV = 4 * 128;
    const bool odd = (ly & 1) != 0; const int mi = ly >> 1;
    const int NI = 2 * I_GU + 2 * I_DN + (odd ? I_INC + I_UQ + I_UKV + I_SQ : I_INAB + I_SQ);
    const int lo = (int)((long)NI * part / nparts), hi = (int)((long)NI * (part + 1) / nparts);
    for (int it = lo + widx; it < hi; it += nw) {
        int r = it;
        if (r < 2 * I_GU) { const int m = 2 * ly + r / I_GU; p0_transpose_item<1>(wgu + (size_t)m * DM * 2 * DFF, DM, 2 * DFF, (bf16*)(ws + WS_WGU) + (size_t)m * 2 * DFF * DM, scr, r % I_GU, lane); continue; } r -= 2 * I_GU;
        if (r < 2 * I_DN) { const int m = 2 * ly + r / I_DN; p0_transpose_item<0>(wdn + (size_t)m * DFF * DM, DFF, DM, (bf16*)(ws + WS_WDN) + (size_t)m * DM * DFF, scr, r % I_DN, lane); continue; } r -= 2 * I_DN;
        if (!odd) {
            if (r < I_INAB) { p0_transpose_item<0>(winab + (size_t)mi * DM * AB_IN, DM, AB_IN, (bf16*)(ws + WS_WINAB) + (size_t)mi * AB_IN * DM, scr, r, lane); continue; } r -= I_INAB;
            p0_transpose_item<0>(woutab + (size_t)mi * DM * DM, DM, DM, (bf16*)(ws + WS_WOUTAB) + (size_t)mi * DM * DM, scr, r, lane);
        } else {
            if (r < I_INC) { p0_transpose_item<0>(winc + (size_t)mi * DM * C_IN, DM, C_IN, (bf16*)(ws + WS_WINC) + (size_t)mi * C_IN_PAD * DM, scr, r, lane); continue; } r -= I_INC;
            if (r < I_UQ) { p0_transpose_item<0>(wuq + (size_t)mi * QRANK * MLA_QOUT, QRANK, MLA_QOUT, (bf16*)(ws + WS_WUQ) + (size_t)mi * MLA_QOUT * QRANK, scr, r, lane); continue; } r -= I_UQ;
            if (r < I_UKV) { p0_transpose_item<0>(wukv + (size_t)mi * KVRANK * MLA_KVOUT, KVRANK, MLA_KVOUT, (bf16*)(ws + WS_WUKV) + (size_t)mi * MLA_KVOUT * KVRANK, scr, r, lane); continue; } r -= I_UKV;
            p0_transpose_item<0>(woutc + (size_t)mi * DM * DM, DM, DM, (bf16*)(ws + WS_WOUTC) + (size_t)mi * DM * DM, scr, r, lane);
        }
    }
}

__device__ __forceinline__ int blk_xr(int q, int NGW) { if (!NORM_BLOCKED || NGW != 2048) return q; const int k = q >> 11, w = q & 2047; return (w >> 8) * 2048 + k * 256 + (w & 255); }

__device__ __forceinline__ void norm_phase(const float* __restrict__ xin, const float* __restrict__ cin, bf16* X, bf16* XN, const float* __restrict__ g, const float* modl, int jmod, bool first,
                                           const float* PART, int pS, const float* pgate, float pcoef, int gw, int NGW, int lane) {
    asm volatile("" : "+v"(lane));
    int q_first = gw;
    if (NORM_BLOCKED && NORM_NRB > 1 && NGW == 2048) {
        const int b = gw >> 10;
        const float* sh = modl + (size_t)(b * 9 + 3 * jmod) * DM; const float* sc = sh + DM;
        for (int k = 0; k < 8; k += NORM_NRB) {
            f32x4 x[NORM_NRB][4][2]; float ss[NORM_NRB];
#pragma unroll
            for (int u = 0; u < NORM_NRB; ++u) { const int xr = (gw >> 8) * 2048 + (k + u) * 256 + (gw & 255); const size_t row = (size_t)b * RPB + CTXL + (xr & (SEQ - 1));
                if (first) { const float* src = xin + (size_t)xr * DM;
#pragma unroll
                    for (int i = 0; i < 4; ++i) { x[u][i][0] = *(const f32x4*)(src + 8 * (lane + 64 * i)); x[u][i][1] = *(const f32x4*)(src + 8 * (lane + 64 * i) + 4); } }
                else { const bf16* src = X + row * DM;
#pragma unroll
                    for (int i = 0; i < 4; ++i) { const v4u w = *(const v4u*)(src + 8 * (lane + 64 * i));
                        x[u][i][0] = (f32x4){bflo(w.x), bfhi(w.x), bflo(w.y), bfhi(w.y)}; x[u][i][1] = (f32x4){bflo(w.z), bfhi(w.z), bflo(w.w), bfhi(w.w)}; } } }
            if (first) {
#pragma unroll
                for (int u = 0; u < NORM_NRB; ++u) { const int xr = (gw >> 8) * 2048 + (k + u) * 256 + (gw & 255); bf16* xo = X + ((size_t)b * RPB + CTXL + (xr & (SEQ - 1))) * DM;
#pragma unroll
                    for (int i = 0; i < 4; ++i) { v4u o; o.x = pk2(x[u][i][0].x, x[u][i][0].y); o.y = pk2(x[u][i][0].z, x[u][i][0].w); o.z = pk2(x[u][i][1].x, x[u][i][1].y); o.w = pk2(x[u][i][1].z, x[u][i][1].w);
                        *(v4u*)(xo + 8 * (lane + 64 * i)) = o;
                        x[u][i][0] = (f32x4){bflo(o.x), bfhi(o.x), bflo(o.y), bfhi(o.y)}; x[u][i][1] = (f32x4){bflo(o.z), bfhi(o.z), bflo(o.w), bfhi(o.w)}; } } }
#pragma unroll
            for (int u = 0; u < NORM_NRB; ++u) { float s = 0.f;
#pragma unroll
                for (int i = 0; i < 4; ++i)
#pragma unroll
                    for (int h = 0; h < 2; ++h) s += (x[u][i][h].x * x[u][i][h].x + x[u][i][h].y * x[u][i][h].y) + (x[u][i][h].z * x[u][i][h].z + x[u][i][h].w * x[u][i][h].w);
                ss[u] = s; }
#pragma unroll
            for (int u = 0; u < NORM_NRB; ++u) ss[u] = 1.0f / sqrtf(wave_sum(ss[u]) * (1.0f / DM) + EPS);
#pragma unroll
            for (int i = 0; i < 4; ++i) { const int col = 8 * (lane + 64 * i); f32x4 ga[2], s0[2];
#pragma unroll
                for (int h = 0; h < 2; ++h) { ga[h] = *(const f32x4*)(g + col + 4 * h) * (1.0f + *(const f32x4*)(sc + col + 4 * h)); s0[h] = *(const f32x4*)(sh + col + 4 * h); }
#pragma unroll
                for (int u = 0; u < NORM_NRB; ++u) { const int xr = (gw >> 8) * 2048 + (k + u) * 256 + (gw & 255); bf16* orow = XN + ((size_t)b * RPB + CTXL + (xr & (SEQ - 1))) * DM;
                    const f32x4 y0 = x[u][i][0] * ss[u] * ga[0] + s0[0], y1 = x[u][i][1] * ss[u] * ga[1] + s0[1];
                    v4u o; o.x = pk2(y0.x, y0.y); o.y = pk2(y0.z, y0.w); o.z = pk2(y1.x, y1.y); o.w = pk2(y1.z, y1.w); *(v4u*)(orow + col) = o; } }
        }
        q_first = NB * SEQ + gw;
    }
    for (int q = q_first; q < (NORM_BLOCKED ? NB * SEQ + NGW : MROWS); q += NGW) {
        int row = q;
        if (NORM_BLOCKED) {
            if (q < NB * SEQ) { const int k = q / NGW, w = q - k * NGW, xr = (w >> 8) * 2048 + k * 256 + (w & 255); row = (xr >> 13) * RPB + CTXL + (xr & (SEQ - 1)); }
            else { const int w = q - NB * SEQ; if (w & 3) continue; const int cr = w >> 2; if (cr >= NB * CTXL) continue; row = (cr >> 8) * RPB + (cr & (CTXL - 1)); }
        }
        const int b = row >= RPB ? 1 : 0, rr = row - b * RPB; const bool isctx = rr < CTXL; const int v = isctx ? 2 : b;
        f32x4 x[4][2]; float ss = 0.f;
        if (first) { const float* src = isctx ? cin + (size_t)(b * CTXL + rr) * DM : xin + (size_t)(b * SEQ + rr - CTXL) * DM;
#pragma unroll
            for (int i = 0; i < 4; ++i) { x[i][0] = *(const f32x4*)(src + 8 * (lane + 64 * i)); x[i][1] = *(const f32x4*)(src + 8 * (lane + 64 * i) + 4); } }
        else { const bf16* src = X + (size_t)row * DM;
#pragma unroll
            for (int i = 0; i < 4; ++i) { const v4u w = *(const v4u*)(src + 8 * (lane + 64 * i));
                x[i][0] = (f32x4){bflo(w.x), bfhi(w.x), bflo(w.y), bfhi(w.y)}; x[i][1] = (f32x4){bflo(w.z), bfhi(w.z), bflo(w.w), bfhi(w.w)}; } }
        const bool pend = isctx && pS > 0;
        if (pend) { const float* pp = PART + (size_t)(b * CTXL + rr) * DM + 8 * lane;
            f32x4 sacc[4][2];
#pragma unroll
            for (int i = 0; i < 4; ++i) { sacc[i][0] = (f32x4){0.f, 0.f, 0.f, 0.f}; sacc[i][1] = sacc[i][0]; }
            for (int k0 = 0; k0 < pS; k0 += 4) { f32x4 t[4][4][2];
#pragma unroll
                for (int kk = 0; kk < 4; ++kk) { const int k = (k0 + kk < pS) ? k0 + kk : k0;
#pragma unroll
                    for (int i = 0; i < 4; ++i) { t[kk][i][0] = *(const f32x4*)(pp + (size_t)k * 512 * DM + 512 * i); t[kk][i][1] = *(const f32x4*)(pp + (size_t)k * 512 * DM + 512 * i + 4); } }
#pragma unroll
                for (int kk = 0; kk < 4; ++kk) if (k0 + kk < pS) {
#pragma unroll
                    for (int i = 0; i < 4; ++i) { sacc[i][0] += t[kk][i][0]; sacc[i][1] += t[kk][i][1]; } } }
#pragma unroll
            for (int i = 0; i < 4; ++i) { x[i][0] += (*(const f32x4*)(pgate + 8 * (lane + 64 * i)) * pcoef) * sacc[i][0]; x[i][1] += (*(const f32x4*)(pgate + 8 * (lane + 64 * i) + 4) * pcoef) * sacc[i][1]; } }
        if (first || pend) { bf16* xo = X + (size_t)row * DM;
#pragma unroll
            for (int i = 0; i < 4; ++i) { v4u o; o.x = pk2(x[i][0].x, x[i][0].y); o.y = pk2(x[i][0].z, x[i][0].w); o.z = pk2(x[i][1].x, x[i][1].y); o.w = pk2(x[i][1].z, x[i][1].w);
                *(v4u*)(xo + 8 * (lane + 64 * i)) = o;
                x[i][0] = (f32x4){bflo(o.x), bfhi(o.x), bflo(o.y), bfhi(o.y)}; x[i][1] = (f32x4){bflo(o.z), bfhi(o.z), bflo(o.w), bfhi(o.w)}; } }
#pragma unroll
        for (int i = 0; i < 4; ++i)
#pragma unroll
            for (int h = 0; h < 2; ++h) ss += (x[i][h].x * x[i][h].x + x[i][h].y * x[i][h].y) + (x[i][h].z * x[i][h].z + x[i][h].w * x[i][h].w);
        ss = wave_sum(ss);
        const float r = 1.0f / sqrtf(ss * (1.0f / DM) + EPS);
        const float* sh = modl + (size_t)(v * 9 + 3 * jmod) * DM; const float* sc = sh + DM;
        bf16* orow = XN + (size_t)row * DM;
#pragma unroll
        for (int i = 0; i < 4; ++i) { const int col = 8 * (lane + 64 * i); f32x4 y[2];
#pragma unroll
            for (int h = 0; h < 2; ++h) { const f32x4 gg = *(const f32x4*)(g + col + 4 * h), s1 = *(const f32x4*)(sc + col + 4 * h), s0 = *(const f32x4*)(sh + col + 4 * h);
                y[h] = x[i][h] * r * gg * (1.0f + s1) + s0; }
            v4u o; o.x = pk2(y[0].x, y[0].y); o.y = pk2(y[0].z, y[0].w); o.z = pk2(y[1].x, y[1].y); o.w = pk2(y[1].z, y[1].w); *(v4u*)(orow + col) = o; }
    }
}
__device__ __forceinline__ void final_phase(const bf16* X, float* out, const float* __restrict__ g, int gw, int NGW, int lane) {
    asm volatile("" : "+v"(lane));
    for (int r0 = gw; r0 < NB * SEQ; r0 += NGW) {
        const int rx = blk_xr(r0, NGW); const int b = rx >= SEQ ? 1 : 0, t = rx - b * SEQ; const size_t row = (size_t)b * RPB + CTXL + t;
        const bf16* src = X + row * DM;
        f32x4 x[4][2]; float ss = 0.f;
#pragma unroll
        for (int i = 0; i < 4; ++i) { const v4u w = *(const v4u*)(src + 8 * (lane + 64 * i));
            x[i][0] = (f32x4){bflo(w.x), bfhi(w.x), bflo(w.y), bfhi(w.y)}; x[i][1] = (f32x4){bflo(w.z), bfhi(w.z), bflo(w.w), bfhi(w.w)};
#pragma unroll
            for (int h = 0; h < 2; ++h) ss += (x[i][h].x * x[i][h].x + x[i][h].y * x[i][h].y) + (x[i][h].z * x[i][h].z + x[i][h].w * x[i][h].w); }
        ss = wave_sum(ss);
        const float r = 1.0f / sqrtf(ss * (1.0f / DM) + EPS);
        float* o = out + (size_t)rx * DM;
#pragma unroll
        for (int i = 0; i < 4; ++i)
#pragma unroll
            for (int h = 0; h < 2; ++h) { const int col = 8 * (lane + 64 * i) + 4 * h; *(f32x4*)(o + col) = x[i][h] * r * *(const f32x4*)(g + col); }
    }
}
__device__ __forceinline__ void pass_ab(const bf16* QKVs, bf16* QKV, const float* PIN, const float* __restrict__ gq, const float* __restrict__ gk, const float* tbl, int gw, int NGW, int lane) {
    asm volatile("" : "+v"(lane));
    const int a = lane >> 5, f = lane & 31;
    const float gq1 = gq[a * 64 + f], gq2 = gq[a * 64 + 32 + f], gk1 = gk[a * 64 + f], gk2 = gk[a * 64 + 32 + f];
    for (int base = gw; base < NB * SEQ; base += 4 * NGW) {
        float x1[4][4], x2[4][4], cs[4], sn[4]; bf16* rowp[4]; bool ok[4];
#pragma unroll
        for (int j = 0; j < 4; ++j) { const int xr = base + j * NGW; ok[j] = xr < NB * SEQ; const int xc = blk_xr(ok[j] ? xr : gw, NGW); const int b = xc >> 13, t = xc & (SEQ - 1);
            const size_t row = (size_t)b * RPB + CTXL + t; const int pos = a == 0 ? (t >> 6) : (t & 63);
            cs[j] = tbl[(a == 0 ? T_HRC : T_HCC) + pos * 32 + f]; sn[j] = tbl[(a == 0 ? T_HRS : T_HCS) + pos * 32 + f];
            rowp[j] = QKV + row * AB_IN + a * 64 + f; const bf16* rows = QKVs + row * AB_IN + a * 64 + f;
#pragma unroll
            for (int q = 0; q < 4; ++q) { const int hd = q < 2 ? 8 + q : 18 + q; x1[j][q] = bf2f(rows[hd * 128]); x2[j][q] = bf2f(rows[hd * 128 + 32]); } }
#pragma unroll
        for (int j = 0; j < 4; ++j)
#pragma unroll
            for (int q = 0; q < 2; ++q) { const float ss = wave_sum(x1[j][q] * x1[j][q] + x2[j][q] * x2[j][q]); const float r = 1.0f / sqrtf(ss * (1.0f / 128.0f) + EPS); x1[j][q] *= r * gk1; x2[j][q] *= r * gk2; }
#pragma unroll
        for (int j = 0; j < 4; ++j) if (ok[j]) {
#pragma unroll
            for (int q = 0; q < 4; ++q) { const int hd = q < 2 ? 8 + q : 18 + q;
                rowp[j][hd * 128] = (bf16)f2bf(x1[j][q] * cs[j] - x2[j][q] * sn[j]); rowp[j][hd * 128 + 32] = (bf16)f2bf(x2[j][q] * cs[j] + x1[j][q] * sn[j]); } }
    }
    for (int cr = gw; cr < NB * CTXL; cr += NGW) {
        const int b = cr >> 8, rr = cr & (CTXL - 1); const size_t row = (size_t)b * RPB + rr;
        bf16* rowp = QKV + row * AB_IN + a * 64 + f;
        const float* pp = PIN + (size_t)cr * AB_IN + a * 64 + f;
#pragma unroll 4
        for (int hd = 0; hd < 24; ++hd) { float x1 = 0.f, x2 = 0.f;
#pragma unroll
            for (int k = 0; k < 8; ++k) { x1 += pp[(size_t)k * 512 * AB_IN + hd * 128]; x2 += pp[(size_t)k * 512 * AB_IN + hd * 128 + 32]; }
            if (hd < 10) { const float ss = wave_sum(x1 * x1 + x2 * x2); const float r = 1.0f / sqrtf(ss * (1.0f / 128.0f) + EPS);
                x1 *= r * (hd < 8 ? gq1 : gk1); x2 *= r * (hd < 8 ? gq2 : gk2); }
            rowp[hd * 128] = (bf16)f2bf(x1); rowp[hd * 128 + 32] = (bf16)f2bf(x2); }
    }
}
__device__ __forceinline__ void pass_mla1(const bf16* CQ, const float* PIN, bf16* CQN, bf16* CKVN, bf16* KR, const float* __restrict__ gcq, const float* __restrict__ gckv, const float* tbl, int gw, int NGW, int lane) {
    asm volatile("" : "+v"(lane));
    for (int q = gw; q < ((NORM_BLOCKED && NGW == 2048) ? NB * SEQ + NGW : MROWS); q += NGW) {
        int row = q;
        if (NORM_BLOCKED && NGW == 2048) {
            if (q < NB * SEQ) { const int xr = blk_xr(q, NGW); row = (xr >> 13) * RPB + CTXL + (xr & (SEQ - 1)); }
            else { const int w = q - NB * SEQ; if (w & 3) continue; const int cr = w >> 2; row = (cr >> 8) * RPB + (cr & (CTXL - 1)); }
        }
        const int b = row >= RPB ? 1 : 0, rr = row - b * RPB; const bool isctx = rr < CTXL; const int t = rr - CTXL;
        const bf16* rp = CQ + (size_t)row * C_IN_PAD; const float* pp = PIN + (size_t)(b * CTXL + rr) * C_IN_PAD;
        { float x[8];
          if (!isctx) { const v4u w = *(const v4u*)(rp + lane * 8); x[0] = bflo(w.x); x[1] = bfhi(w.x); x[2] = bflo(w.y); x[3] = bfhi(w.y); x[4] = bflo(w.z); x[5] = bfhi(w.z); x[6] = bflo(w.w); x[7] = bfhi(w.w); }
          else { f32x4 s0 = {0.f, 0.f, 0.f, 0.f}, s1 = s0;
#pragma unroll
              for (int k = 0; k < 8; ++k) { s0 += *(const f32x4*)(pp + (size_t)k * 512 * C_IN_PAD + lane * 8); s1 += *(const f32x4*)(pp + (size_t)k * 512 * C_IN_PAD + lane * 8 + 4); }
              x[0] = s0.x; x[1] = s0.y; x[2] = s0.z; x[3] = s0.w; x[4] = s1.x; x[5] = s1.y; x[6] = s1.z; x[7] = s1.w; }
          float ss = 0.f;
#pragma unroll
          for (int i = 0; i < 8; ++i) ss += x[i] * x[i];
          ss = wave_sum(ss); const float r = 1.0f / sqrtf(ss * (1.0f / QRANK) + EPS);
          const f32x4 g0 = *(const f32x4*)(gcq + lane * 8), g1 = *(const f32x4*)(gcq + lane * 8 + 4);
          v4u o; o.x = pk2(x[0] * r * g0.x, x[1] * r * g0.y); o.y = pk2(x[2] * r * g0.z, x[3] * r * g0.w); o.z = pk2(x[4] * r * g1.x, x[5] * r * g1.y); o.w = pk2(x[6] * r * g1.z, x[7] * r * g1.w);
          *(v4u*)(CQN + (size_t)row * QRANK + lane * 8) = o; }
        { float x[4];
          if (!isctx) { const v2u w = *(const v2u*)(rp + 512 + lane * 4); x[0] = bflo(w.x); x[1] = bfhi(w.x); x[2] = bflo(w.y); x[3] = bfhi(w.y); }
          else { f32x4 s0 = {0.f, 0.f, 0.f, 0.f};
#pragma unroll
              for (int k = 0; k < 8; ++k) s0 += *(const f32x4*)(pp + (size_t)k * 512 * C_IN_PAD + 512 + lane * 4);
              x[0] = s0.x; x[1] = s0.y; x[2] = s0.z; x[3] = s0.w; }
          float ss = (x[0] * x[0] + x[1] * x[1]) + (x[2] * x[2] + x[3] * x[3]);
          ss = wave_sum(ss); const float r = 1.0f / sqrtf(ss * (1.0f / KVRANK) + EPS);
          const f32x4 g0 = *(const f32x4*)(gckv + lane * 4);
          v2u o; o.x = pk2(x[0] * r * g0.x, x[1] * r * g0.y); o.y = pk2(x[2] * r * g0.z, x[3] * r * g0.w);
          *(v2u*)(CKVN + (size_t)row * KVRANK + lane * 4) = o; }
        if (lane < 32) { const int a = lane >> 4, f = lane & 15;
          float x1, x2;
          if (!isctx) { x1 = bf2f(rp[768 + a * 32 + f]); x2 = bf2f(rp[768 + a * 32 + 16 + f]); }
          else { x1 = 0.f; x2 = 0.f;
#pragma unroll
              for (int k = 0; k < 8; ++k) { x1 += pp[(size_t)k * 512 * C_IN_PAD + 768 + a * 32 + f]; x2 += pp[(size_t)k * 512 * C_IN_PAD + 768 + a * 32 + 16 + f]; } }
          float cs = 1.f, sn = 0.f;
          if (!isctx) { const int pos = a == 0 ? (t >> 6) : (t & 63); cs = tbl[(a == 0 ? T_MRC : T_MCC) + pos * 16 + f]; sn = tbl[(a == 0 ? T_MRS : T_MCS) + pos * 16 + f]; }
          bf16* kr = KR + (size_t)row * 64 + a * 32 + f;
          kr[0] = (bf16)f2bf(x1 * cs - x2 * sn); kr[16] = (bf16)f2bf(x2 * cs + x1 * sn); }
    }
}
__device__ __forceinline__ void pass_mla2(const bf16* Qs, bf16* Q, const float* tbl, int gw, int NGW, int lane) {
    asm volatile("" : "+v"(lane));
    for (int row = gw; row < MROWS; row += NGW) {
        const int b = row >= RPB ? 1 : 0, rr = row - b * RPB; if (rr < CTXL) continue; const int t = rr - CTXL;
        bf16* rp = Q + (size_t)row * MLA_QOUT; const bf16* rs = Qs + (size_t)row * MLA_QOUT;
#pragma unroll
        for (int it = 0; it < 8; ++it) { const int P = it * 64 + lane, h = P >> 5, p = P & 31, a = p >> 4, f = p & 15;
            const int pos = a == 0 ? (t >> 6) : (t & 63);
            const float cs = tbl[(a == 0 ? T_MRC : T_MCC) + pos * 16 + f], sn = tbl[(a == 0 ? T_MRS : T_MCS) + pos * 16 + f];
            bf16* q = rp + h * 192 + 128 + a * 32 + f; const bf16* qs = rs + h * 192 + 128 + a * 32 + f;
            const float x1 = bf2f(qs[0]), x2 = bf2f(qs[16]);
            q[0] = (bf16)f2bf(x1 * cs - x2 * sn); q[16] = (bf16)f2bf(x2 * cs + x1 * sn); }
    }
}

struct Args { const float* in[21]; float* out; unsigned char* ws; };
#define INP(k) ({ int k_ = (k); asm volatile("" : "+s"(k_)); args.in[k_]; })
#define WSP(T, off) ({ size_t o_ = (off); asm volatile("" : "+s"(o_)); (T*)(args.ws + o_); })
#define MOD WSP(float, WS_MOD)
#define TBL WSP(float, WS_TBL)
#define WGU WSP(bf16, WS_WGU)
#define WDN WSP(bf16, WS_WDN)
#define WINAB WSP(bf16, WS_WINAB)
#define WOUTAB WSP(bf16, WS_WOUTAB)
#define WINC WSP(bf16, WS_WINC)
#define WUQ WSP(bf16, WS_WUQ)
#define WUKV WSP(bf16, WS_WUKV)
#define WOUTC WSP(bf16, WS_WOUTC)
#define X WSP(bf16, WS_X)
#define XN WSP(bf16, WS_XN)
#define H WSP(bf16, WS_H)
#define QKV WSP(bf16, WS_QKV)
#define KV WSP(bf16, WS_KV)
#define CQ WSP(bf16, WS_CQ)
#define CQN WSP(bf16, WS_CQN)
#define CKVN WSP(bf16, WS_CKVN)
#define KR WSP(bf16, WS_KR)
#define O WSP(bf16, WS_O)
__global__ void __launch_bounds__(NWAVES * 64, 2) fwd(Args args) {
    extern __shared__ __attribute__((aligned(16))) unsigned char lds[];
    LAS unsigned char* L = (LAS unsigned char*)lds;
#if CODE_SHIFT >= 1
    asm volatile("s_nop 0");
#endif
#if CODE_SHIFT >= 2
    asm volatile("s_nop 0");
#endif
#if CODE_SHIFT >= 3
    asm volatile("s_nop 0");
#endif
#if CODE_SHIFT >= 4
    asm volatile("s_nop 0");
#endif
#if CODE_SHIFT >= 5
    asm volatile("s_nop 0");
#endif
#if CODE_SHIFT >= 6
    asm volatile("s_nop 0");
#endif
#if CODE_SHIFT >= 7
    asm volatile("s_nop 0");
#endif
#if CODE_SHIFT >= 8
    asm volatile("s_nop 0\n\ts_nop 0\n\ts_nop 0\n\ts_nop 0\n\ts_nop 0\n\ts_nop 0\n\ts_nop 0\n\ts_nop 0");
#endif
    volatile LAS unsigned* MISC = (volatile LAS unsigned*)(L + MISC_OFF);
    const int wave = __builtin_amdgcn_readfirstlane((int)threadIdx.x >> 6);
#define lane lane_id_fresh()
#define tid (wave * 64 + lane_id_fresh())
    const int G = gridDim.x, bx = blockIdx.x, vcu = (G % 8 == 0) ? (bx % 8) * (G / 8) + bx / 8 : bx;
    const int gw = vcu * NWAVES + wave, NGW = G * NWAVES;
    unsigned* ctl = (unsigned*)(args.ws + WS_CTL);
    for (int u = tid; u < (LDS_BYTES - LDSCTL_OFF) / 4; u += NWAVES * 64) ((LAS unsigned*)(L + LDSCTL_OFF))[u] = 0u;
    __syncthreads();
    (void)xcd_barrier_post((unsigned*)(ctl + CW_BAR), MISC + 8, tid == 0);
#if PROBE_WAIT_MASK
#define GRID_BAR(c) do { XcdBarrier bar_; bar_.bar = WSP(unsigned, WS_CTL) + CW_BAR; bar_.x = xb_xcc_id(); bar_.st = (volatile LAS unsigned*)(L + MISC_OFF) + 8; \
    const unsigned long long t0_ = __builtin_amdgcn_s_memrealtime(); xcd_barrier(bar_, tid == 0); const unsigned long long t1_ = __builtin_amdgcn_s_memrealtime(); \
    if (((PROBE_WAIT_MASK >> (c)) & 1) && tid == 0) { volatile LAS unsigned* w_ = (volatile LAS unsigned*)(L + MISC_OFF) + 16; *w_ = *w_ + (unsigned)(t1_ - t0_); } } while (0)
#else
#define GRID_BAR(c) do { XcdBarrier bar_; bar_.bar = WSP(unsigned, WS_CTL) + CW_BAR; bar_.x = xb_xcc_id(); bar_.st = (volatile LAS unsigned*)(L + MISC_OFF) + 8; xcd_barrier(bar_, tid == 0); if (PROBE_BAR) xcd_barrier(bar_, tid == 0); } while (0)
#endif

    {
        for (int rep_ = 0; rep_ < 1 + PROBE_MOD; ++rep_)
        p0_mod(INP(1), INP(3), INP(4), WSP(float, WS_H), L, tid, wave, lane);
        LAS float* scr = (LAS float*)(L + RING_OFF + wave * 16384);
        for (int rep_ = 0; rep_ < 1 + PROBE_TR; ++rep_)
        for (int ly = 0; ly < (DEFER_CONV ? 1 : DEPTH); ++ly)
            convert_layer(INP(7), INP(8), INP(9), INP(13), INP(14), INP(17), INP(18), INP(19), args.ws, ly, 0, 1, gw, NGW, scr, lane);
        { constexpr int PER = (C_IN_PAD - C_IN) * DM * 2 / 16;
          for (int i = gw * 64 + lane; i < 2 * PER; i += NGW * 64) { const int m = i / PER, j = i - m * PER;
              *(v4u*)((unsigned char*)WINC + (size_t)m * SZ_WINC + (size_t)C_IN * DM * 2 + (size_t)j * 16) = (v4u){0u, 0u, 0u, 0u}; } }
        for (int e = gw * 64 + lane; e < 9216; e += NGW * 64) {
            int p, f, nf, oc, os;
            if (e < 6144) { p = e >> 5; f = e & 31; nf = 32; if (p < 128) { oc = T_HRC + p * 32 + f; os = T_HRS + p * 32 + f; } else { oc = T_HCC + (p - 128) * 32 + f; os = T_HCS + (p - 128) * 32 + f; } }
            else { const int e2 = e - 6144; p = e2 >> 4; f = e2 & 15; nf = 16; if (p < 128) { oc = T_MRC + p * 16 + f; os = T_MRS + p * 16 + f; } else { oc = T_MCC + (p - 128) * 16 + f; os = T_MCS + (p - 128) * 16 + f; } }
            const int pos = p < 128 ? p : p - 128;
            const double inv = my_exp(-((double)f / (double)nf) * 9.210340371976184);
            double s, c; my_sincos((double)pos * inv, s, c);
            TBL[oc] = (float)c; TBL[os] = (float)s;
        }
    }
    GRID_BAR(5);
    p0_mod_sum(WSP(float, WS_H), INP(5), MOD, gw * 64 + lane, NGW * 64);
    GRID_BAR(5);

    int pS = 0; const float* pgate = nullptr; float pcoef = 0.f;
    for (int l = 0; l < DEPTH; ++l) {
        const float* modl = MOD + (size_t)l * 3 * 9 * DM;
        const int li = l >> 1; const bool even = (l & 1) == 0;
        for (int half = 0; half < 2; ++half) {
            if (half == 1) {
                norm_phase(nullptr, nullptr, X, XN, INP(6) + (size_t)(l * 3 + 1) * DM, modl, 1, false, WSP(float, WS_PARTC), pS, pgate, pcoef, gw, NGW, lane);
                pS = 0;
                GRID_BAR(0);
                {
                    const int N = even ? AB_IN : C_IN_PAD;
                    const bf16* Wi = even ? WINAB + (size_t)li * AB_IN * DM : WINC + (size_t)li * C_IN_PAD * DM;
                    {   pg8::Gemm gs{XN, Wi, MROWS, N, 256, DM, DM, (size_t)128};
                        pg8::CtxSplitOrder Sc{8, N / 256, 256, bx};
                        pg8::EpiPartial Ep{WSP(float, WS_PIN), N};
                        pg8::gemm_phase<pg8::EpiPartial, pg8::CtxSplitOrder, false, PG8_SP2>(L + RING_OFF, gs, Sc, Ep, tid); }
                    pg8::Gemm g{XN, Wi, MROWS, N, DM, DM, DM, (size_t)128};
                    pg8::PanelOrder S; S.init(N, G, bx, true); S.wgm = WGM_PROJ;
                    pg8::EpiPlain E{even ? QKV : CQ, N};
                    for (int rep_ = 0; rep_ < 1 + PROBE_INPROJ; ++rep_)
                    pg8::gemm_phase<pg8::EpiPlain, pg8::PanelOrder, PG8_ALIGN, PG8_SP2>(L + RING_OFF, g, S, E, tid);
                }
                GRID_BAR(4);
                if (even) {
                    if (PROBE_PASS) pass_ab(QKV, KV, WSP(float, WS_PIN), INP(10) + li * 128, INP(11) + li * 128, TBL, gw, NGW, lane);
                    pass_ab(QKV, QKV, WSP(float, WS_PIN), INP(10) + li * 128, INP(11) + li * 128, TBL, gw, NGW, lane);
                    GRID_BAR(0);
                    for (int rep_ = 0; rep_ < 1 + PROBE_ATTAB; ++rep_) {
                    int vc = vcu; asm volatile("" : "+s"(vc));
                    for (int it = 0; it < 5; ++it) {
                        int type, b, h, qb = 0;
                        if (it < 4) { type = it >> 1; b = it & 1; h = vc >> 5; qb = vc & 31; }
                        else { if (vc >= 32) break; type = 2 + ((vc >> 3) & 1); b = vc >> 4; h = vc & 7; }
                        const bool isB = (type & 1) != 0; const int kvh = h >> 2;
                        const int qcol = (isB ? 1536 : 0) + 128 * h, kcol = (isB ? 2560 : 1024) + 128 * kvh, vcol = (isB ? 2816 : 1280) + 128 * kvh, ocol = (isB ? 1024 : 0) + 128 * h;
                        const size_t rowb = (size_t)b * RPB, qrow = rowb + (type < 2 ? CTXL + 256 * qb : 0);
                        int NT = 4, base1 = 256, wmode = 0, qpos0 = 0;
                        if (type == 0) NT = 132;
                        else if (type == 1) { const int bs = (256 * qb - 128) < 0 ? 0 : (256 * qb - 128), be = (256 * qb + 384) > SEQ ? SEQ : (256 * qb + 384); NT = 4 + (be - bs) / 64; base1 = 256 + bs; wmode = 1; qpos0 = 256 * qb; }
                        float m_init = -1e30f, l_init = 0.f;
                        if (isB) { m_init = INP(12)[li * 8 + h] * 11.313708498984761f; l_init = 1.f; }
                        att::attn_unit<128, 3072, 3072, 3072, 2048, ATT_SD128>(QKV + qrow * AB_IN + qcol, QKV + rowb * AB_IN + kcol, nullptr, QKV + rowb * AB_IN + vcol, O + qrow * DM + ocol,
                                                                   NT, base1, wmode, type < 2 ? 256 * qb : 0, m_init, l_init, type < 2 ? (const float*)TBL : nullptr, (type == 0) ? INP(10) + li * 128 : nullptr, (char*)lds + RING_OFF, tid);
                    }
                    }
                } else {
                    if (PROBE_PASS) pass_mla1(CQ, WSP(float, WS_PIN), CQN, CKVN, KR, INP(15) + li * QRANK, INP(16) + li * KVRANK, TBL, gw, NGW, lane);
                    pass_mla1(CQ, WSP(float, WS_PIN), CQN, CKVN, KR, INP(15) + li * QRANK, INP(16) + li * KVRANK, TBL, gw, NGW, lane);
                    GRID_BAR(0);
                    {   pg8::Gemm g{CQN, WUQ + (size_t)li * MLA_QOUT * QRANK, MROWS, MLA_QOUT, QRANK, QRANK, QRANK, (size_t)128};
                        pg8::PanelOrder S; S.init(MLA_QOUT, G, bx, UP_HALFCTX ? true : false); S.wgm = WGM_PROJ;
                        pg8::EpiPlain E{QKV, MLA_QOUT};
                        for (int rep_ = 0; rep_ < 1 + PROBE_UQKV; ++rep_)
                        pg8::gemm_phase<pg8::EpiPlain, pg8::PanelOrder, PG8_ALIGN, PG8_SP2>(L + RING_OFF, g, S, E, tid);
                        if (UP_HALFCTX) { pg8::CtxHalfOrder Sh{MLA_QOUT / 256, bx - 64}; pg8::EpiPlain_T<true> Eh{QKV, MLA_QOUT};
                            pg8::gemm_phase<pg8::EpiPlain_T<true>, pg8::CtxHalfOrder, false, true, true>(L + RING_OFF, g, Sh, Eh, tid); } }
                    {   pg8::Gemm g{CKVN, WUKV + (size_t)li * MLA_KVOUT * KVRANK, MROWS, MLA_KVOUT, KVRANK, KVRANK, KVRANK, (size_t)128};
                        pg8::PanelOrder S; S.init(MLA_KVOUT, G, bx, UP_HALFCTX ? true : false); S.wgm = WGM_PROJ;
                        pg8::EpiPlain E{KV, MLA_KVOUT};
                        for (int rep_ = 0; rep_ < 1 + PROBE_UQKV; ++rep_)
                        pg8::gemm_phase<pg8::EpiPlain, pg8::PanelOrder, PG8_ALIGN, PG8_SP2>(L + RING_OFF, g, S, E, tid);
                        if (UP_HALFCTX) { pg8::CtxHalfOrder Sh{MLA_KVOUT / 256, bx}; pg8::EpiPlain_T<true> Eh{KV, MLA_KVOUT};
                            pg8::gemm_phase<pg8::EpiPlain_T<true>, pg8::CtxHalfOrder, false, true, true>(L + RING_OFF, g, Sh, Eh, tid); } }
                    GRID_BAR(4);
                    const bool need_ctx = l < DEPTH - 1;
                    for (int rep_ = 0; rep_ < 1 + PROBE_ATTMLA; ++rep_) {
                    int vc = vcu; asm volatile("" : "+s"(vc));
                    for (int it = 0; it < 5; ++it) {
                        int b, h, qb = 0; bool cx = false;
                        if (it < 4) { b = it >> 1; h = (it & 1) * 8 + (vc >> 5); qb = vc & 31; }
                        else { if (!need_ctx || vc >= 32) break; b = vc >> 4; h = vc & 15; cx = true; }
                        const size_t rowb = (size_t)b * RPB, qrow = rowb + (cx ? 0 : CTXL + 256 * qb);
                        att::attn_unit<192, 3072, 4096, 4096, 2048, ATT_SD192>(QKV + qrow * MLA_QOUT + 192 * h, KV + rowb * MLA_KVOUT + 256 * h, KR + rowb * 64, KV + rowb * MLA_KVOUT + 256 * h + 128, O + qrow * DM + 128 * h,
                                                                   cx ? 4 : 132, 256, 0, 256 * qb, -1e30f, 0.f, cx ? nullptr : (const float*)TBL, nullptr, (char*)lds + RING_OFF, tid);
                    }
                    }
                }
                GRID_BAR(3);
                {
                    const bf16* Wo = even ? WOUTAB + (size_t)li * DM * DM : WOUTC + (size_t)li * DM * DM;
                    if (l < DEPTH - 1) {
                        pg8::Gemm gs{O, Wo, MROWS, DM, 256, DM, DM, (size_t)128};
                        pg8::CtxSplitOrder Sc{8, DM / 256, 256, bx};
                        pg8::EpiPartial Ep{WSP(float, WS_PARTC), DM};
                        pg8::gemm_phase<pg8::EpiPartial, pg8::CtxSplitOrder, false, PG8_SP2>(L + RING_OFF, gs, Sc, Ep, tid);
                        pS = 8; pgate = modl + (size_t)(2 * 9 + 5) * DM; pcoef = 1.0f;
                    }
                    pg8::Gemm g{O, Wo, MROWS, DM, DM, DM, DM, (size_t)128};
                    pg8::PanelOrder S; S.init(DM, G, bx, true); S.wgm = WGM_G2;
                    pg8::EpiResid E{X, modl, 5, 1.0f / (1 + PROBE_OUTPROJ)};
                    for (int rep_ = 0; rep_ < 1 + PROBE_OUTPROJ; ++rep_)
                    pg8::gemm_phase<pg8::EpiResid, pg8::PanelOrder, PG8_ALIGN, PG8_SP2>(L + RING_OFF, g, S, E, tid);
                    if (PROBE_OUTPLAIN) { pg8::EpiPlain E2{WSP(bf16, WS_END), DM};
                        pg8::gemm_phase<pg8::EpiPlain, pg8::PanelOrder, PG8_ALIGN, PG8_SP2>(L + RING_OFF, g, S, E2, tid); }
                }
                GRID_BAR(4);
            }
            const int j = 2 * half, wi = l * 2 + half;
            const bool ctx_live = !(l == DEPTH - 1 && half == 1);
            for (int rep_ = 0; rep_ < 1 + PROBE_NORM; ++rep_)
            norm_phase(INP(0), INP(2), X, XN, INP(6) + (size_t)(l * 3 + j) * DM, modl, j, l == 0 && half == 0, WSP(float, WS_PARTC), rep_ == 0 ? pS : 0, pgate, pcoef, gw, NGW, lane);
            pS = 0;
            GRID_BAR(0);
            {   pg8::Gemm g{XN, WGU + (size_t)wi * 2 * DFF * DM, MROWS, 2 * DFF, DM, DM, DM, (size_t)128};
                pg8::PanelOrder S; S.init(2 * DFF, G, bx, G1_HALFCTX ? true : !ctx_live); S.wgm = WGM_G1;
                pg8::EpiSwiGLU E{H, H_TILED ? MROWS : DFF};
                for (int rep_ = 0; rep_ < 1 + PROBE_G1; ++rep_)
                for (int cut_ = 0; cut_ < G1_CUTS; ++cut_) {
                    S.r0 = cut_ * (12 / G1_CUTS); S.r1 = (cut_ + 1) * (12 / G1_CUTS);
                    if (cut_ > 0) GRID_BAR(1);
                    pg8::gemm_phase<pg8::EpiSwiGLU, pg8::PanelOrder, PG8_ALIGN, PG8_SP2>(L + RING_OFF, g, S, E, tid); }
                if (G1_HALFCTX && ctx_live) {
                    pg8::CtxHalfOrder Sh{2 * DFF / 256, bx};
                    pg8::EpiSwiGLU_T<true> Eh{H, H_TILED ? MROWS : DFF};
                    pg8::gemm_phase<pg8::EpiSwiGLU_T<true>, pg8::CtxHalfOrder, false, true, true>(L + RING_OFF, g, Sh, Eh, tid); }
                if (PROBE_G1PLAIN) { pg8::EpiPlain E2{WSP(bf16, WS_END), 2 * DFF};
                    pg8::gemm_phase<pg8::EpiPlain, pg8::PanelOrder, PG8_ALIGN, PG8_SP2>(L + RING_OFF, g, S, E2, tid); }
                if (DEFER_CONV && l + 1 < DEPTH && bx >= 88) {
                    int lane_ = lane; asm volatile("" : "+v"(lane_));
                    convert_layer(INP(7), INP(8), INP(9), INP(13), INP(14), INP(17), INP(18), INP(19), args.ws, l + 1, half, 2, (bx - 88) * NWAVES + wave, 168 * NWAVES, (LAS float*)(L + RING_OFF + wave * 16384), lane_); } }
            GRID_BAR(1);
            {
                const bf16* Wd = WDN + (size_t)wi * DM * DFF;
                if (ctx_live) {
                    pg8::Gemm gs{H, Wd, MROWS, DM, 512, DFF, H_TILED ? 64 : DFF, H_TILED ? (size_t)MROWS * 128 : (size_t)128};
                    pg8::CtxSplitOrder Sc{11, DM / 256, 512, bx};
                    pg8::EpiPartial Ep{WSP(float, WS_PARTC), DM};
                    pg8::gemm_phase<pg8::EpiPartial, pg8::CtxSplitOrder, false, PG8_SP2>(L + RING_OFF, gs, Sc, Ep, tid);
                    pS = 11; pgate = modl + (size_t)(2 * 9 + 3 * j + 2) * DM; pcoef = 0.5f;
                }
                pg8::Gemm g{H, Wd, MROWS, DM, DFF, DFF, H_TILED ? 64 : DFF, H_TILED ? (size_t)MROWS * 128 : (size_t)128};
                pg8::PanelOrder S; S.init(DM, G, bx, true); S.rev = REV_G2; S.wgm = WGM_G2;
                pg8::EpiResid E{X, modl, 3 * j + 2, 0.5f / (1 + PROBE_G2)};
                for (int rep_ = 0; rep_ < 1 + PROBE_G2; ++rep_)
                pg8::gemm_phase<pg8::EpiResid, pg8::PanelOrder, PG8_ALIGN, PG8_SP2>(L + RING_OFF, g, S, E, tid); }
            GRID_BAR(2);
        }
    }
    final_phase(X, args.out, INP(20), gw, NGW, lane);
#if PROBE_WAIT_MASK
    if (tid == 0) __hip_atomic_fetch_add(WSP(unsigned, WS_CTL) + 2048, *((volatile LAS unsigned*)(L + MISC_OFF) + 16), __ATOMIC_RELAXED, __HIP_MEMORY_SCOPE_AGENT);
    GRID_BAR(7);
    if (bx == 0 && tid == 0) { const unsigned tot = __hip_atomic_load(WSP(unsigned, WS_CTL) + 2048, __ATOMIC_RELAXED, __HIP_MEMORY_SCOPE_AGENT); const float us_ = (float)tot / (float)G * 0.01f; args.out[0] += floorf((us_ + PROBE_WAIT_OFF) / PROBE_WAIT_Q) * PROBE_WAIT_Q; }
#endif
#undef GRID_BAR
#undef lane
#undef tid
}
#undef MOD
#undef TBL
#undef WGU
#undef WDN
#undef WINAB
#undef WOUTAB
#undef WINC
#undef WUQ
#undef WUKV
#undef WOUTC
#undef X
#undef XN
#undef H
#undef QKV
#undef KV
#undef CQ
#undef CQN
#undef CKVN
#undef KR
#undef O

extern "C" void kernel_launch(void* const* d_in, const int* in_sizes, int n_in, void* d_out, int out_size, void* d_ws, size_t ws_size, hipStream_t stream) {
    static int grid = 0;
    if (grid == 0) {
        if (n_in != 21 || in_sizes[0] != NB * SEQ * DM || out_size != NB * SEQ * DM || ws_size < WS_END) {
            fprintf(stderr, "kernel_launch: shape mismatch: n_in %d in0 %d out %d ws %zu (need %zu)\n", n_in, n_in > 0 ? in_sizes[0] : -1, out_size, ws_size, (size_t)WS_END); grid = -1; return; }
        int dev = 0, cus = 0, per_cu = 0;
        if (hipGetDevice(&dev) != hipSuccess || hipDeviceGetAttribute(&cus, hipDeviceAttributeMultiprocessorCount, dev) != hipSuccess) { fprintf(stderr, "kernel_launch: device query failed\n"); grid = -1; return; }
        if (hipFuncSetAttribute((const void*)fwd, hipFuncAttributeMaxDynamicSharedMemorySize, LDS_BYTES) != hipSuccess) { fprintf(stderr, "kernel_launch: hipFuncSetAttribute failed\n"); grid = -1; return; }
        if (hipOccupancyMaxActiveBlocksPerMultiprocessor(&per_cu, (const void*)fwd, NWAVES * 64, LDS_BYTES) != hipSuccess || per_cu < 1)
            fprintf(stderr, "kernel_launch: note: occupancy query reports %d workgroups per CU\n", per_cu);
        (void)hipGetLastError();
        grid = cus;
    }
    if (grid < 0) return;
    if (hipMemsetAsync((char*)d_ws + WS_CTL, 0, CTL_ZERO_BYTES, stream) != hipSuccess) { fprintf(stderr, "kernel_launch: memset failed\n"); return; }
    Args a{};
    for (int i = 0; i < 21; ++i) a.in[i] = (const float*)d_in[i];
    a.out = (float*)d_out; a.ws = (unsigned char*)d_ws;
    hipLaunchKernelGGL(fwd, dim3(grid), dim3(NWAVES * 64), LDS_BYTES, stream, a);
    const hipError_t le = hipPeekAtLastError();
    if (le != hipSuccess) fprintf(stderr, "kernel_launch: launch failed: %s\n", hipGetErrorName(le));
}
```

```cpp
#define ATT_NEGM 1
#define ATT_NOMAX 1
#define ATT_NQ128 1
#define ATT_NQ192 8
#include <hip/hip_runtime.h>
#include <cstdio>
#include <cstdint>

constexpr int DM = 2048, NB = 2, SEQ = 8192, CTXL = 256, DEPTH = 4, DFF = 5632, NMOD = 9, GRID_W = 64;
constexpr int RPB = CTXL + SEQ;
constexpr int MROWS = NB * RPB;
constexpr int PPB = RPB / 256;
constexpr int AB_IN = 3072, C_IN = 832, C_IN_PAD = 1024, QRANK = 512, KVRANK = 256, MLA_QOUT = 3072, MLA_KVOUT = 4096;
constexpr float EPS = 1e-6f;

__device__ __forceinline__ int lane_id_fresh() { unsigned z = 0u; asm volatile("" : "+v"(z)); return (int)__builtin_amdgcn_mbcnt_hi(~0u, __builtin_amdgcn_mbcnt_lo(~0u, z)); }

#ifndef DIS_A128
#define DIS_A128 0
#endif
#ifndef DIS_A192
#define DIS_A192 0
#endif
#ifndef DIS_G1
#define DIS_G1 0
#endif
#ifndef DIS_G2
#define DIS_G2 0
#endif
#ifndef DIS_G3
#define DIS_G3 0
#endif
#ifndef DIS_G4
#define DIS_G4 0
#endif
#ifndef DIS_G5
#define DIS_G5 0
#endif
#ifndef DIS_G6
#define DIS_G6 0
#endif
#ifndef ATT_SD128
#define ATT_SD128 1
#endif
#ifndef ATT_SD192
#define ATT_SD192 1
#endif
#ifndef PROBE_ATTAB
#define PROBE_ATTAB 0
#endif
#ifndef PROBE_ATTMLA
#define PROBE_ATTMLA 0
#endif
#ifndef PROBE_G1
#define PROBE_G1 0
#endif
#ifndef PROBE_NORM
#define PROBE_NORM 0
#endif
#ifndef PROBE_TR
#define PROBE_TR 0
#endif
#ifndef PROBE_G2
#define PROBE_G2 0
#endif
#ifndef PROBE_PASS
#define PROBE_PASS 0
#endif
#ifndef PROBE_MOD
#define PROBE_MOD 0
#endif
#ifndef PROBE_INPROJ
#define PROBE_INPROJ 0
#endif
#ifndef PROBE_UQKV
#define PROBE_UQKV 0
#endif
#ifndef PROBE_OUTPROJ
#define PROBE_OUTPROJ 0
#endif
#ifndef PROBE_BAR
#define PROBE_BAR 0
#endif
#ifndef PROBE_WAIT_MASK
#define PROBE_WAIT_MASK 0
#endif
#ifndef PROBE_WAIT_Q
#define PROBE_WAIT_Q 200.0f
#endif
#ifndef PROBE_WAIT_OFF
#define PROBE_WAIT_OFF 0.0f
#endif
#ifndef REV_G2
#define REV_G2 (LOCAL_SEAMS ? false : true)
#endif
#ifndef WGM_G2
#define WGM_G2 4
#endif
#ifndef NT_H
#define NT_H 0
#endif
#ifndef DEFER_CONV
#define DEFER_CONV 0
#endif
#ifndef PROBE_OUTPLAIN
#define PROBE_OUTPLAIN 0
#endif
#ifndef PROBE_G1PLAIN
#define PROBE_G1PLAIN 0
#endif
#ifndef H_TILED
#define H_TILED 1
#endif
#ifndef G1_CUTS
#define G1_CUTS 1
#endif
#ifndef NT_W
#define NT_W 0
#endif
#ifndef WGM_G1
#define WGM_G1 4
#endif
#ifndef CODE_SHIFT
#define CODE_SHIFT 0
#endif
#ifndef ATT_PRIO
#define ATT_PRIO 0
#endif
#ifndef NORM_BLOCKED
#define NORM_BLOCKED 1
#endif
#ifndef WGM_PROJ
#define WGM_PROJ 8
#endif
#ifndef ATT_EARLY
#define ATT_EARLY 0
#endif
#ifndef ATT_STAG
#define ATT_STAG 1
#endif
#ifndef ATT_NQ128
#define ATT_NQ128 8
#endif
#ifndef ATT_NQ192
#define ATT_NQ192 8
#endif
#ifndef ATT_SLEEP
#define ATT_SLEEP 0
#endif
#ifndef KSWZ_MASK
#define KSWZ_MASK 15
#endif
#ifndef ATT_KDMA
#define ATT_KDMA 1
#endif
#ifndef ATT_VDMA
#define ATT_VDMA 1
#endif
#ifndef ATT_PKMATH
#define ATT_PKMATH 0
#endif
#ifndef G1_HALFCTX
#define G1_HALFCTX 1
#endif
#ifndef NORM_NRB
#define NORM_NRB 1
#endif
#ifndef UP_HALFCTX
#define UP_HALFCTX 1
#endif
#ifndef PROBE_ABL
#define PROBE_ABL 0
#endif
#ifndef ATT_ILV
#define ATT_ILV 0
#endif
#ifndef PROBE_WAIT_LOCAL
#define PROBE_WAIT_LOCAL 0
#endif
#ifndef LOCAL_SEAMS
#define LOCAL_SEAMS 0
#endif
#ifndef PROBE_LOCALFLAG
#define PROBE_LOCALFLAG 0
#endif
#ifndef ATT_QPF
#define ATT_QPF 0
#endif
#ifndef ATT_NEGM
#define ATT_NEGM 0
#endif
#ifndef ATT_NOMAX
#define ATT_NOMAX 0
#endif
namespace pg8 {
#define PG8_LAS __attribute__((address_space(3)))
typedef unsigned short bf16_t;
typedef short bf16x8 __attribute__((ext_vector_type(8)));
typedef float f32x4 __attribute__((ext_vector_type(4)));
typedef unsigned u32x4 __attribute__((ext_vector_type(4)));
constexpr int BM = 256, BK = 64, HALF = 128, HTB = HALF * BK * 2  , STAGE_BYTES = 8 * HTB, NXCD = 8, WGM = 8;

__host__ __device__ __forceinline__ int lds_byte(int r, int c) { const int st = (r >> 4) * 2 + (c >> 5), rr = r & 15, cc = c & 31, ob = rr * 64 + cc * 2; return st * 1024 + (ob ^ (((ob >> 9) & 1) << 5)); }
__host__ __device__ __forceinline__ void stage_rc(int b, int& R, int& C) { const int st = b / 1024, sb = b % 1024, swz = sb ^ (((sb >> 9) & 1) << 5); R = (st >> 1) * 16 + swz / 64; C = (st & 1) * 32 + (swz % 64) / 2; }
__host__ __device__ __forceinline__ int perm32(int rho) { const int n = rho >> 4, i = rho & 15; return 8 * (i >> 2) + 4 * n + (i & 3); }

struct Unit { int pm, pn, koff, ks; };
struct Gemm { const bf16_t* A; const bf16_t* Bt; int M, N, K, ld; int lda; size_t kstepA; };

struct StaticOrder {
    int nM, nN, nwg, G, c, wgm = WGM;
    __host__ __device__ void init(int M, int N, int G_, int c_) { nM = M / BM; nN = N / BM; nwg = nM * nN; G = G_; c = c_; }
    __host__ __device__ bool next(int i, Unit& u) const {
        const long L = (long)i * G + c; if (L >= nwg) return false;
        int wgid = (int)L; { const int q = nwg / NXCD, r = nwg % NXCD, xcd = wgid % NXCD, off = wgid / NXCD; wgid = (xcd < r ? xcd * (q + 1) : r * (q + 1) + (xcd - r) * q) + off; }
        const int nig = wgm * nN, gid = wgid / nig, fm = gid * wgm, gsz = (nM - fm) < wgm ? (nM - fm) : wgm;
        u.pm = fm + ((wgid % nig) % gsz); u.pn = (wgid % nig) / gsz; u.koff = 0; u.ks = 0; return true;
    }
    __device__ __forceinline__ void a_ready(const Unit&) const {}
    __device__ __forceinline__ void done(const Unit&) const {}
};

typedef float f32x2_t __attribute__((ext_vector_type(2))); typedef __bf16 bf16x2_t __attribute__((ext_vector_type(2)));
__device__ __forceinline__ unsigned cvt_pk_bf16(float lo, float hi) { f32x2_t v = {lo, hi}; bf16x2_t b = __builtin_convertvector(v, bf16x2_t); return __builtin_bit_cast(unsigned, b); }

template <bool HALFM> struct EpiPlain_T {
    static constexpr bool PERM = true, AFTER_DRAIN = false;
    bf16_t* O; int ldc;
    __device__ __forceinline__ void operator()(const f32x4 (&acc)[2][2][4][2], const Unit& u, int wr, int wc, int fr, int fq) const {
        const int row0 = u.pm * BM + (HALFM ? u.ks * HALF : 0) + wr * 64 + fr, col0 = u.pn * BM + wc * 32 + 8 * fq;
#pragma unroll
        for (int ai = 0; ai < (HALFM ? 1 : 2); ++ai)
#pragma unroll
            for (int m = 0; m < 4; ++m) { bf16_t* rowp = O + (size_t)(row0 + ai * HALF + m * 16) * ldc + col0;
#pragma unroll
                for (int bj = 0; bj < 2; ++bj) { const f32x4 v0 = acc[ai][bj][m][0], v1 = acc[ai][bj][m][1];
                    u32x4 w; w.x = cvt_pk_bf16(v0[0], v0[1]); w.y = cvt_pk_bf16(v0[2], v0[3]); w.z = cvt_pk_bf16(v1[0], v1[1]); w.w = cvt_pk_bf16(v1[2], v1[3]);
                    *(u32x4*)(rowp + bj * HALF) = w; } }
    }
};
typedef EpiPlain_T<false> EpiPlain;
__device__ __forceinline__ u32x4 swiglu8(const f32x4 g0, const f32x4 g1, const f32x4 u0, const f32x4 u1) {
    float g[8] = {g0[0], g0[1], g0[2], g0[3], g1[0], g1[1], g1[2], g1[3]}, u[8] = {u0[0], u0[1], u0[2], u0[3], u1[0], u1[1], u1[2], u1[3]}, t[8];
#pragma unroll
    for (int k = 0; k < 8; ++k) t[k] = g[k] * -1.4426950408889634f;
#pragma unroll
    for (int k = 0; k < 8; ++k) t[k] = __builtin_amdgcn_exp2f(t[k]);
#pragma unroll
    for (int k = 0; k < 8; ++k) t[k] = 1.0f + t[k];
#pragma unroll
    for (int k = 0; k < 8; ++k) t[k] = __builtin_amdgcn_rcpf(t[k]);
#pragma unroll
    for (int k = 0; k < 8; ++k) t[k] = (g[k] * t[k]) * u[k];
    u32x4 w; w.x = cvt_pk_bf16(t[0], t[1]); w.y = cvt_pk_bf16(t[2], t[3]); w.z = cvt_pk_bf16(t[4], t[5]); w.w = cvt_pk_bf16(t[6], t[7]); return w;
}
template <bool HALFM> struct EpiSwiGLU_T {
    static constexpr bool PERM = true, AFTER_DRAIN = false;
    bf16_t* H; int ldh;
    __device__ __forceinline__ void operator()(const f32x4 (&acc)[2][2][4][2], const Unit& u, int wr, int wc, int fr, int fq) const {
        const int row0 = u.pm * BM + (HALFM ? u.ks * HALF : 0) + wr * 64 + fr, col0 = u.pn * HALF + wc * 32 + 8 * fq;
#pragma unroll
        for (int ai = 0; ai < (HALFM ? 1 : 2); ++ai)
#pragma unroll
            for (int m = 0; m < 4; ++m) {
                bf16_t* rowp = H_TILED ? H + ((size_t)(col0 >> 6) * ldh + (row0 + ai * HALF + m * 16)) * 64 + (col0 & 63) : H + (size_t)(row0 + ai * HALF + m * 16) * ldh + col0;
                const u32x4 w = swiglu8(acc[ai][0][m][0], acc[ai][0][m][1], acc[ai][1][m][0], acc[ai][1][m][1]);
                if (NT_H) __builtin_nontemporal_store(w, (u32x4*)rowp); else *(u32x4*)rowp = w; }
    }
};
typedef EpiSwiGLU_T<false> EpiSwiGLU;
struct EpiResid {
    static constexpr bool PERM = true, AFTER_DRAIN = false;
    bf16_t* X; const float* modl; int gidx; float coef;
    __device__ __forceinline__ void operator()(const f32x4 (&acc)[2][2][4][2], const Unit& u, int wr, int wc, int fr, int fq) const {
        const int b = u.pm / 33, v = (u.pm - b * 33 == 0) ? 2 : b;
        const float* gate = modl + (size_t)(v * 9 + gidx) * 2048;
        const int row0 = u.pm * BM + wr * 64 + fr, col0 = u.pn * BM + wc * 32 + 8 * fq;
        f32x4 gv[2][2];
#pragma unroll
        for (int bj = 0; bj < 2; ++bj)
#pragma unroll
            for (int n = 0; n < 2; ++n) gv[bj][n] = *(const f32x4*)(gate + col0 + bj * HALF + n * 4) * coef;
#pragma unroll
        for (int ai = 0; ai < 2; ++ai) {
            u32x4 xo[4][2];
#pragma unroll
            for (int m = 0; m < 4; ++m)
#pragma unroll
                for (int bj = 0; bj < 2; ++bj) xo[m][bj] = *(const u32x4*)(X + (size_t)(row0 + ai * HALF + m * 16) * 2048 + col0 + bj * HALF);
#pragma unroll
            for (int m = 0; m < 4; ++m)
#pragma unroll
                for (int bj = 0; bj < 2; ++bj) { const u32x4 x4 = xo[m][bj];
                    const f32x4 d0 = gv[bj][0] * acc[ai][bj][m][0], d1 = gv[bj][1] * acc[ai][bj][m][1];
                    u32x4 w;
                    w.x = cvt_pk_bf16(__builtin_bit_cast(float, x4.x << 16) + d0[0], __builtin_bit_cast(float, x4.x & 0xffff0000u) + d0[1]);
                    w.y = cvt_pk_bf16(__builtin_bit_cast(float, x4.y << 16) + d0[2], __builtin_bit_cast(float, x4.y & 0xffff0000u) + d0[3]);
                    w.z = cvt_pk_bf16(__builtin_bit_cast(float, x4.z << 16) + d1[0], __builtin_bit_cast(float, x4.z & 0xffff0000u) + d1[1]);
                    w.w = cvt_pk_bf16(__builtin_bit_cast(float, x4.w << 16) + d1[2], __builtin_bit_cast(float, x4.w & 0xffff0000u) + d1[3]);
                    *(u32x4*)(X + (size_t)(row0 + ai * HALF + m * 16) * 2048 + col0 + bj * HALF) = w; }
            asm volatile("" ::: "memory"); }
    }
};

struct PanelOrder : StaticOrder {
    int r0 = 0, r1 = 1 << 30;
    bool skip; bool rev = false;
    __host__ __device__ void init(int N, int G_, int c_, bool skip_) {
#if defined(__HIP_DEVICE_COMPILE__)
        asm volatile("" : "+s"(G_), "+s"(c_));
#endif
        skip = skip_; StaticOrder::init((skip_ ? 64 : 66) * BM, N, G_, c_); }
    __host__ __device__ bool next(int i, Unit& u) const { if (i + r0 >= r1 || !StaticOrder::next(i + r0, u)) return false; if (rev) u.pm = nM - 1 - u.pm; if (skip) u.pm += 1 + (u.pm >= 32 ? 1 : 0); return true; }
};
struct CtxSplitOrder {
    int S, nN, klen, c;
    __host__ __device__ bool next(int i, Unit& u) const { if (i > 0 || c >= 2 * nN * S) return false; const int ks = c % S, rest = c / S; u.pn = rest % nN; u.pm = (rest / nN) * 33; u.koff = ks * klen; u.ks = ks; return true; }
    __device__ __forceinline__ void a_ready(const Unit&) const {}
    __device__ __forceinline__ void done(const Unit&) const {}
};
struct CtxHalfOrder {
    int nN, c;
    __host__ __device__ bool next(int i, Unit& u) const { if (i > 0 || c < 0 || c >= 4 * nN) return false; u.pn = c % nN; const int hp = c / nN; u.pm = (hp >> 1) * 33; u.ks = hp & 1; u.koff = 0; return true; }
    __device__ __forceinline__ void a_ready(const Unit&) const {}
    __device__ __forceinline__ void done(const Unit&) const {}
};
struct EpiPartial {
    static constexpr bool PERM = false, AFTER_DRAIN = false;
    float* P; int ldp;
    __device__ __forceinline__ void operator()(const f32x4 (&acc)[2][2][4][2], const Unit& u, int wr, int wc, int fr, int fq) const {
        const int crow0 = (u.pm == 0 ? 0 : 256) + wr * 64 + fr, col0 = u.pn * BM + wc * 32 + 4 * fq;
        float* base = P + ((size_t)u.ks * 512 + crow0) * ldp + col0;
#pragma unroll
        for (int ai = 0; ai < 2; ++ai)
#pragma unroll
            for (int m = 0; m < 4; ++m) { float* rowp = base + (size_t)(ai * HALF + m * 16) * ldp;
#pragma unroll
                for (int bj = 0; bj < 2; ++bj)
#pragma unroll
                    for (int n = 0; n < 2; ++n) *(f32x4*)(rowp + bj * HALF + n * 16) = acc[ai][bj][m][n]; }
    }
};

template <class Epi, class Sched, bool ALIGN_EPI = false, bool SP2 = false, bool HALFM = false>
__device__ __forceinline__ void gemm_phase(PG8_LAS unsigned char* lds, const Gemm g, const Sched& S, const Epi& E, const int tid_in) {
    int tid_ = tid_in; asm volatile("" : "+v"(tid_));
    const int tid = tid_, wid = __builtin_amdgcn_readfirstlane(tid >> 6), lane = tid & 63, wr = wid >> 2, wc = wid & 3, fr = lane & 15, fq = lane >> 4;
    const int K = g.K, nt = K / BK;
    unsigned voffA[2], voffB[2];
#pragma unroll
    for (int i = 0; i < 2; ++i) { int R, C; stage_rc(tid * 16 + i * 8192, R, C); const int Rb = Epi::PERM ? ((R & ~31) + perm32(R & 31)) : R;
        voffA[i] = (unsigned)(R * g.lda + C) * 2u; voffB[i] = (unsigned)(Rb * g.ld + C) * 2u; }
    const size_t kstep = (size_t)(BK * 2);
    const size_t kstepA = g.kstepA, hstepA = (size_t)HALF * g.lda * 2, tstepA = 2 * hstepA;
    const size_t hstep = (size_t)HALF * g.ld * 2;
    const size_t tstep = 2 * hstep;
    const unsigned ldsw = (unsigned)wid * 1024u;
    const int aoff = lds_byte(wr * 64 + fr, fq * 8), boff = lds_byte(wc * 32 + fr, fq * 8);
#define PG8_SA(b, h) (((b) * 2 + (h)) * HTB)
#define PG8_SB(b, h) ((4 + (b) * 2 + (h)) * HTB)
#define PG8_STAGE(bufoff, gbase, voff) do { _Pragma("unroll") for (int _i = 0; _i < 2; ++_i) \
        __builtin_amdgcn_global_load_lds((const unsigned*)((const char*)(gbase) + (voff)[_i]), (PG8_LAS unsigned*)(lds + (bufoff) + ldsw + _i * 8192), 16, 0, 0); } while (0)
#define PG8_LDA(dst, b, h) do { _Pragma("unroll") for (int m = 0; m < 4; ++m) _Pragma("unroll") for (int k = 0; k < 2; ++k) dst[m][k] = *(const PG8_LAS bf16x8*)(lds + PG8_SA(b, h) + aoff + m * 2048 + k * 1024); } while (0)
#define PG8_LDB(dst, b, h) do { _Pragma("unroll") for (int n = 0; n < 2; ++n) _Pragma("unroll") for (int k = 0; k < 2; ++k) dst[n][k] = *(const PG8_LAS bf16x8*)(lds + PG8_SB(b, h) + boff + n * 2048 + k * 1024); } while (0)
#define PG8_MMA(ai, bj, At, Bt) do { __builtin_amdgcn_s_setprio(1); _Pragma("unroll") for (int m = 0; m < 4; ++m) _Pragma("unroll") for (int n = 0; n < 2; ++n) _Pragma("unroll") for (int k = 0; k < 2; ++k) \
        acc[ai][bj][m][n] = __builtin_amdgcn_mfma_f32_16x16x32_bf16(Bt[n][k], At[m][k], acc[ai][bj][m][n], 0, 0, 0); __builtin_amdgcn_s_setprio(0); } while (0)
#define PG8_WAIT_V(n) asm volatile("s_waitcnt vmcnt(" #n ")" ::: "memory")
#define PG8_WV do { if constexpr (HALFM) PG8_WAIT_V(6); else PG8_WAIT_V(8); } while (0)
#define PG8_WAIT_L(n) asm volatile("s_waitcnt lgkmcnt(" #n ")" ::: "memory")
#define PG8_BAR __builtin_amdgcn_s_barrier()
#define PG8_SCHED __builtin_amdgcn_sched_barrier(0)
    Unit cur, nxt; int ui = 0;
    if (!S.next(0, cur)) return;
    f32x4 acc[2][2][4][2];
#pragma unroll
    for (int a = 0; a < 2; ++a)
#pragma unroll
        for (int b = 0; b < 2; ++b)
#pragma unroll
            for (int m = 0; m < 4; ++m)
#pragma unroll
                for (int n = 0; n < 2; ++n) acc[a][b][m][n] = (f32x4){0.f, 0.f, 0.f, 0.f};
    bf16x8 At[4][2], B0[2][2], B1[2][2];
    static_assert(!HALFM || SP2, "HALFM is written for the two-super-phase loop");
    const char* cA = (const char*)g.A + (size_t)cur.pm * tstepA + (size_t)(cur.koff >> 6) * kstepA + (HALFM ? (size_t)cur.ks * hstepA : (size_t)0); const char* cB = (const char*)g.Bt + (size_t)cur.pn * tstep + (size_t)cur.koff * 2;
    S.a_ready(cur);
    if constexpr (SP2) {
        PG8_STAGE(PG8_SB(0, 0), cB, voffB); PG8_STAGE(PG8_SB(0, 1), cB + hstep, voffB); PG8_STAGE(PG8_SA(0, 0), cA, voffA); if constexpr (!HALFM) PG8_STAGE(PG8_SA(0, 1), cA + hstepA, voffA);
        if (wr == 1) PG8_BAR;
        if constexpr (HALFM) PG8_WAIT_V(0); else PG8_WAIT_V(2);
        PG8_BAR;
        PG8_STAGE(PG8_SB(1, 0), cB + kstep, voffB); PG8_STAGE(PG8_SA(1, 0), cA + kstepA, voffA); PG8_STAGE(PG8_SB(1, 1), cB + hstep + kstep, voffB);
        PG8_WAIT_V(6); PG8_BAR;
    } else {
        PG8_STAGE(PG8_SB(0, 0), cB, voffB); PG8_STAGE(PG8_SA(0, 0), cA, voffA); PG8_STAGE(PG8_SB(0, 1), cB + hstep, voffB); PG8_STAGE(PG8_SA(0, 1), cA + hstepA, voffA);
        if (wr == 1) PG8_BAR;
        PG8_WAIT_V(4); PG8_BAR;
        PG8_STAGE(PG8_SB(1, 0), cB + kstep, voffB); PG8_STAGE(PG8_SA(1, 0), cA + kstepA, voffA); PG8_STAGE(PG8_SB(1, 1), cB + hstep + kstep, voffB);
        PG8_WAIT_V(6); PG8_BAR;
    }
    for (;;) {
        const bool has_next = S.next(ui + 1, nxt);
        const char* nA = has_next ? (const char*)g.A + (size_t)nxt.pm * tstepA + (size_t)(nxt.koff >> 6) * kstepA + (HALFM ? (size_t)nxt.ks * hstepA : (size_t)0) : cA; const char* nB = has_next ? (const char*)g.Bt + (size_t)nxt.pn * tstep + (size_t)nxt.koff * 2 : cB;
        for (int t = 0; t < nt; t += 2) {
            const bool last = (t == nt - 2);
            const char* a1 = cA + (size_t)(t + 1) * kstepA;
            const char* a2 = last ? nA : cA + (size_t)(t + 2) * kstepA; const char* b2 = last ? nB : cB + (size_t)(t + 2) * kstep;
            const char* a3 = a2 + kstepA; const char* b3 = b2 + kstep;
            if (last && has_next) S.a_ready(nxt);
            if constexpr (SP2) {
            PG8_LDB(B0, 0, 0); PG8_LDB(B1, 0, 1); PG8_SCHED; PG8_LDA(At, 0, 0); if constexpr (!HALFM) PG8_STAGE(PG8_SA(1, 1), a1 + hstepA, voffA);
            PG8_WV; PG8_WAIT_L(0); PG8_BAR; PG8_MMA(0, 0, At, B0); PG8_MMA(0, 1, At, B1); PG8_BAR; PG8_SCHED;
            if constexpr (!HALFM) PG8_LDA(At, 0, 1); PG8_STAGE(PG8_SB(0, 0), b2, voffB); PG8_STAGE(PG8_SB(0, 1), b2 + hstep, voffB); PG8_STAGE(PG8_SA(0, 0), a2, voffA);
            PG8_WV; PG8_WAIT_L(0); PG8_BAR; if constexpr (!HALFM) { PG8_MMA(1, 0, At, B0); PG8_MMA(1, 1, At, B1); } PG8_BAR; PG8_SCHED;
            PG8_LDB(B0, 1, 0); PG8_LDB(B1, 1, 1); PG8_SCHED; PG8_LDA(At, 1, 0); if constexpr (!HALFM) PG8_STAGE(PG8_SA(0, 1), a2 + hstepA, voffA);
            PG8_WV; PG8_WAIT_L(0); PG8_BAR; PG8_MMA(0, 0, At, B0); PG8_MMA(0, 1, At, B1); PG8_BAR; PG8_SCHED;
            if constexpr (!HALFM) PG8_LDA(At, 1, 1); PG8_STAGE(PG8_SB(1, 0), b3, voffB); PG8_STAGE(PG8_SB(1, 1), b3 + hstep, voffB); PG8_STAGE(PG8_SA(1, 0), a3, voffA);
            PG8_WV; PG8_WAIT_L(0); PG8_BAR; if constexpr (!HALFM) { PG8_MMA(1, 0, At, B0); PG8_MMA(1, 1, At, B1); } PG8_BAR; PG8_SCHED;
            } else {
            PG8_LDB(B0, 0, 0); PG8_SCHED; PG8_LDA(At, 0, 0); PG8_STAGE(PG8_SA(1, 1), a1 + hstepA, voffA);
            PG8_WAIT_L(8); PG8_BAR; PG8_WAIT_L(0); PG8_MMA(0, 0, At, B0); PG8_BAR; PG8_SCHED;
            PG8_LDB(B1, 0, 1); PG8_STAGE(PG8_SB(0, 0), b2, voffB);
            PG8_BAR; PG8_WAIT_L(0); PG8_MMA(0, 1, At, B1); PG8_BAR;
            PG8_LDA(At, 0, 1); PG8_STAGE(PG8_SA(0, 0), a2, voffA);
            PG8_BAR; PG8_WAIT_L(0); PG8_MMA(1, 0, At, B0); PG8_BAR; PG8_SCHED;
            PG8_STAGE(PG8_SB(0, 1), b2 + hstep, voffB);
            PG8_WAIT_V(6); PG8_BAR; PG8_MMA(1, 1, At, B1); PG8_BAR;
            PG8_LDB(B0, 1, 0); PG8_SCHED; PG8_LDA(At, 1, 0); PG8_STAGE(PG8_SA(0, 1), a2 + hstepA, voffA);
            PG8_WAIT_L(8); PG8_BAR; PG8_WAIT_L(0); PG8_MMA(0, 0, At, B0); PG8_BAR; PG8_SCHED;
            PG8_LDB(B1, 1, 1); PG8_STAGE(PG8_SB(1, 0), b3, voffB);
            PG8_BAR; PG8_WAIT_L(0); PG8_MMA(0, 1, At, B1); PG8_BAR;
            PG8_LDA(At, 1, 1); PG8_STAGE(PG8_SA(1, 0), a3, voffA);
            PG8_BAR; PG8_WAIT_L(0); PG8_MMA(1, 0, At, B0); PG8_BAR; PG8_SCHED;
            PG8_STAGE(PG8_SB(1, 1), b3 + hstep, voffB);
            PG8_WAIT_V(6); PG8_BAR; PG8_MMA(1, 1, At, B1); PG8_BAR;
            }
        }
        if constexpr (ALIGN_EPI) { if (wr == 0) PG8_BAR; }
        if constexpr (!Epi::AFTER_DRAIN) { E(acc, cur, wr, wc, fr, fq); S.done(cur); }
        if (!has_next) break;
#pragma unroll
        for (int a = 0; a < 2; ++a)
#pragma unroll
            for (int b = 0; b < 2; ++b)
#pragma unroll
                for (int m = 0; m < 4; ++m)
#pragma unroll
                    for (int n = 0; n < 2; ++n) acc[a][b][m][n] = (f32x4){0.f, 0.f, 0.f, 0.f};
        cur = nxt; cA = nA; cB = nB; ++ui;
        if constexpr (ALIGN_EPI) { if (wr == 1) PG8_BAR; }
    }
    PG8_WAIT_V(0);
    if constexpr (!ALIGN_EPI) { if (wr == 0) PG8_BAR; }
    PG8_BAR;
    if constexpr (Epi::AFTER_DRAIN) { E.fused(acc, cur, wr, wc, fr, fq, lds, wid, lane); S.done(cur); }
#undef PG8_SA
#undef PG8_WV
#undef PG8_SB
#undef PG8_STAGE
#undef PG8_LDA
#undef PG8_LDB
#undef PG8_MMA
#undef PG8_WAIT_V
#undef PG8_WAIT_L
#undef PG8_BAR
#undef PG8_SCHED
}
}
#ifndef PG8_SP2
#define PG8_SP2 true
#endif
#ifndef PG8_ALIGN
#define PG8_ALIGN true
#endif

namespace att {
typedef unsigned short bf16_t;
using bf16x8 = __attribute__((ext_vector_type(8))) short;
using s16x4  = __attribute__((ext_vector_type(4))) short;
using f32x16 = __attribute__((ext_vector_type(16))) float;
using u32x4  = __attribute__((ext_vector_type(4))) unsigned;
constexpr int NW = 8, QBLK = 32, KVBLK = 64;
constexpr int SHM_V = 16384, SHM_K = 16384, SHM_KR = 8192;
constexpr int NVB = ATT_VDMA ? 3 : 2;
constexpr int NKB = (ATT_VDMA == 2) ? 3 : 2;
constexpr int OFF_V = 0, OFF_K = NVB * SHM_V, OFF_KR = OFF_K + NKB * SHM_K, OFF_WS = OFF_KR + NKB * SHM_KR, OFF_QR = OFF_WS + NW * 64 * 4, QR_WAVE = (ATT_VDMA == 2) ? 4096 : 7168, LDS_BYTES = OFF_QR + NW * QR_WAVE;
#ifndef ATTN_THR
#define ATTN_THR 8.f
#endif
constexpr float THR = ATTN_THR;
#define KSWZ(row, colB) ((row) * 256 + ((colB) ^ (((row) & KSWZ_MASK) << 4)))
#define KRSWZ(row, colB) ((row) * 128 + ((colB) ^ ((((row) >> 1) & 7) << 4)))
#define SBAR() __builtin_amdgcn_sched_barrier(0)
__device__ __forceinline__ int crow(int r, int hi) { return (r & 3) + 8 * (r >> 2) + 4 * hi; }
__device__ __forceinline__ unsigned cvtpk(float lo, float hi) { unsigned r; asm volatile("v_cvt_pk_bf16_f32 %0, %1, %2" : "=v"(r) : "v"(lo), "v"(hi)); return r; }
template <int DQK> struct Cfg { static constexpr float SCALE = (DQK == 128) ? 0.08838834764831845f : 0.07216878364870323f; };

__device__ __forceinline__ bf16x8 scale_frag(bf16x8 v, float c) { const u32x4 w = __builtin_bit_cast(u32x4, v); u32x4 o;
#pragma unroll
  for (int i = 0; i < 4; ++i) o[i] = cvtpk(__builtin_bit_cast(float, w[i] << 16) * c, __builtin_bit_cast(float, w[i] & 0xffff0000u) * c);
  return __builtin_bit_cast(bf16x8, o); }
template <int DQK>
__device__ __forceinline__ void partialSM_negm(float& negs, const bool force, f32x16& p0, f32x16& p1, float& alpha) {
  constexpr float THRL = THR * 1.4426950408889634f;
  float pmax = p0[0];
#pragma unroll
  for (int r = 1; r < 16; ++r) pmax = fmaxf(pmax, p0[r]);
#pragma unroll
  for (int r = 0; r < 16; ++r) pmax = fmaxf(pmax, p1[r]);
  { auto rr = __builtin_amdgcn_permlane32_swap(__float_as_uint(pmax), __float_as_uint(pmax), false, false);
    pmax = fmaxf(__uint_as_float(rr[0]), __uint_as_float(rr[1])); }
  if (__builtin_expect(!force && __all(pmax <= THRL), 1)) { alpha = 1.f; }
  else { const float d = force ? pmax : fmaxf(pmax, 0.f);
    alpha = force ? 1.f : __builtin_amdgcn_exp2f(-d);
#pragma unroll
    for (int r = 0; r < 16; ++r) { p0[r] -= d; p1[r] -= d; }
    negs -= d; }
#pragma unroll
  for (int r = 0; r < 16; ++r) p0[r] = __builtin_amdgcn_exp2f(p0[r]);
}
template <int DQK>
__device__ __forceinline__ void partialSM(f32x16& p0, f32x16& p1, float& m_reg, float& mn, float& alpha) {
  constexpr float SCALE = Cfg<DQK>::SCALE, C = SCALE * 1.4426950408889634f;
  float pmax = p0[0];
#pragma unroll
  for (int r = 1; r < 16; ++r) pmax = fmaxf(pmax, p0[r]);
#pragma unroll
  for (int r = 0; r < 16; ++r) pmax = fmaxf(pmax, p1[r]);
  { auto rr = __builtin_amdgcn_permlane32_swap(__float_as_uint(pmax), __float_as_uint(pmax), false, false);
    pmax = fmaxf(__uint_as_float(rr[0]), __uint_as_float(rr[1])); }
  if (__builtin_expect(__all(pmax - m_reg <= THR / SCALE), 1)) { mn = m_reg; alpha = 1.f; }
  else { mn = fmaxf(m_reg, pmax); alpha = __builtin_amdgcn_exp2f((m_reg - mn) * C); m_reg = mn; }
  const float mnC = -mn * C;
  if constexpr (ATT_PKMATH) {
    typedef float f32x2_ __attribute__((ext_vector_type(2)));
    const f32x2_ c2 = {C, C}, m2 = {mnC, mnC};
#pragma unroll
    for (int r = 0; r < 16; r += 2) { f32x2_ v = {p0[r], p0[r + 1]}; v = __builtin_elementwise_fma(v, c2, m2); p0[r] = v.x; p0[r + 1] = v.y; }
#pragma unroll
    for (int r = 0; r < 16; r += 2) { f32x2_ v = {p1[r], p1[r + 1]}; v = __builtin_elementwise_fma(v, c2, m2); p1[r] = v.x; p1[r + 1] = v.y; }
  } else {
#pragma unroll
  for (int r = 0; r < 16; ++r) p0[r] = fmaf(p0[r], C, mnC);
#pragma unroll
  for (int r = 0; r < 16; ++r) p1[r] = fmaf(p1[r], C, mnC);
  }
#pragma unroll
  for (int r = 0; r < 16; ++r) p0[r] = __builtin_amdgcn_exp2f(p0[r]);
}
__device__ __forceinline__ void finishSM(f32x16& p0, f32x16& p1, float alpha, float& l_reg, bf16x8& pa0, bf16x8& pa1, bf16x8& pa2, bf16x8& pa3) {
#pragma unroll
  for (int r = 0; r < 16; ++r) p1[r] = __builtin_amdgcn_exp2f(p1[r]);
  float ps = 0;
#pragma unroll
  for (int r = 0; r < (ATT_PKMATH ? 0 : 16); ++r) ps += p0[r];
#pragma unroll
  for (int r = 0; r < (ATT_PKMATH ? 0 : 16); ++r) ps += p1[r];
  if constexpr (ATT_PKMATH) {
    typedef float f32x2_ __attribute__((ext_vector_type(2)));
    f32x2_ s2 = {p0[0], p0[1]};
#pragma unroll
    for (int r = 2; r < 16; r += 2) s2 += (f32x2_){p0[r], p0[r + 1]};
#pragma unroll
    for (int r = 0; r < 16; r += 2) s2 += (f32x2_){p1[r], p1[r + 1]};
    ps = s2.x + s2.y;
  }
  { auto rr = __builtin_amdgcn_permlane32_swap(__float_as_uint(ps), __float_as_uint(ps), false, false);
    ps = __uint_as_float(rr[0]) + __uint_as_float(rr[1]); }
  l_reg = l_reg * alpha + ps;
#define PK4(P, BASE, OUT) do { unsigned a0 = cvtpk(P[BASE + 0], P[BASE + 1]), a1 = cvtpk(P[BASE + 2], P[BASE + 3]);   \
    unsigned b0 = cvtpk(P[BASE + 4], P[BASE + 5]), b1 = cvtpk(P[BASE + 6], P[BASE + 7]);                              \
    auto r0 = __builtin_amdgcn_permlane32_swap(a0, b0, false, false); auto r1 = __builtin_amdgcn_permlane32_swap(a1, b1, false, false); \
    u32x4 w = {r0[0], r1[0], r0[1], r1[1]}; OUT = *reinterpret_cast<bf16x8*>(&w); } while (0)
  PK4(p0, 0, pa0); PK4(p0, 8, pa1); PK4(p1, 0, pa2); PK4(p1, 8, pa3);
#undef PK4
}
template <int DQK, bool NEGM_>
__device__ __forceinline__ void qkt(const float negs, f32x16& p0, f32x16& p1, const char* Ks, const char* Krs, const bf16x8* qr, const char* qrl, int r32, int hi) {
  f32x16 negm;
  if constexpr (!NEGM_) { p0 = f32x16{}; p1 = f32x16{}; }
  else { float s_ = negs; asm volatile("" : "+v"(s_));
#pragma unroll
    for (int r = 0; r < 16; ++r) negm[r] = s_; }
  if (ATT_PRIO & 1) __builtin_amdgcn_s_setprio(1);
#pragma unroll
  for (int d0 = 0; d0 < 8; ++d0) { const int cb = (d0 * 16 + hi * 8) * 2;
    const bf16x8 b0 = *reinterpret_cast<const bf16x8*>(Ks + KSWZ(r32, cb));
    const bf16x8 b1 = *reinterpret_cast<const bf16x8*>(Ks + KSWZ(32 + r32, cb));
    bf16x8 qv;
    constexpr int NQR = (DQK == 192) ? ATT_NQ192 : ATT_NQ128;
    if (d0 >= NQR) qv = *reinterpret_cast<const bf16x8*>(qrl + ((DQK == 192 ? 4 : 0) + d0 - NQR) * 1024); else qv = qr[d0 < NQR ? d0 : 0];
    if (NEGM_ && d0 == 0) {
      p0 = __builtin_amdgcn_mfma_f32_32x32x16_bf16(b0, qv, negm, 0, 0, 0);
      p1 = __builtin_amdgcn_mfma_f32_32x32x16_bf16(b1, qv, negm, 0, 0, 0);
    } else {
    p0 = __builtin_amdgcn_mfma_f32_32x32x16_bf16(b0, qv, p0, 0, 0, 0);
    p1 = __builtin_amdgcn_mfma_f32_32x32x16_bf16(b1, qv, p1, 0, 0, 0); } }
  if constexpr (DQK == 192) {
#pragma unroll
    for (int d0 = 0; d0 < 4; ++d0) { const int cb = (d0 * 16 + hi * 8) * 2;
      const bf16x8 b0 = *reinterpret_cast<const bf16x8*>(Krs + KRSWZ(r32, cb));
      const bf16x8 b1 = *reinterpret_cast<const bf16x8*>(Krs + KRSWZ(32 + r32, cb));
      const bf16x8 qv = *reinterpret_cast<const bf16x8*>(qrl + d0 * 1024);
      p0 = __builtin_amdgcn_mfma_f32_32x32x16_bf16(b0, qv, p0, 0, 0, 0);
      p1 = __builtin_amdgcn_mfma_f32_32x32x16_bf16(b1, qv, p1, 0, 0, 0); }
  }
  if (ATT_PRIO & 1) __builtin_amdgcn_s_setprio(0);
}
__device__ __forceinline__ void wmask(f32x16& p0, f32x16& p1, int dbase, int hi) {
#pragma unroll
  for (int r = 0; r < 16; ++r) { const int d0 = dbase + (r & 3) + 8 * (r >> 2) + 4 * hi, d1 = d0 + 32;
    if (d0 > 128 || d0 < -128) p0[r] = -1e30f;
    if (d1 > 128 || d1 < -128) p1[r] = -1e30f; }
}
__device__ __forceinline__ int v_st(int k, int c) { const int kk = (k & ~0xC) | ((k & 4) << 1) | ((k & 8) >> 1); return ((kk >> 3) * 4 + (c >> 5)) * 512 + ((kk & 7) * 32 + (c & 31)) * 2; }
__device__ __forceinline__ int v_rd_base(int lane) { return ((lane & 3) << 3) | (((lane >> 2) & 3) << 6) | (((lane >> 4) & 1) << 5) | (((lane >> 5) & 1) << 8); }
constexpr int v_rd_off(int d0, int ks, int half) { return d0 * 512 + ks * 4096 + half * 2048; }
template <int OFF> __device__ __forceinline__ s16x4 tr_read(int vb) {
  s16x4 r; asm volatile("ds_read_b64_tr_b16 %0, %1 offset:%2" : "=&v"(r) : "v"(vb), "i"(OFF) : "memory"); return r;
}
template <int D0> __device__ __forceinline__ void pv_one(f32x16& od, int vb, bf16x8 pa0, bf16x8 pa1, bf16x8 pa2, bf16x8 pa3) {
  const s16x4 l0 = tr_read<v_rd_off(D0, 0, 0)>(vb), h0 = tr_read<v_rd_off(D0, 0, 1)>(vb), l1 = tr_read<v_rd_off(D0, 1, 0)>(vb), h1 = tr_read<v_rd_off(D0, 1, 1)>(vb);
  const s16x4 l2 = tr_read<v_rd_off(D0, 2, 0)>(vb), h2 = tr_read<v_rd_off(D0, 2, 1)>(vb), l3 = tr_read<v_rd_off(D0, 3, 0)>(vb), h3 = tr_read<v_rd_off(D0, 3, 1)>(vb);
  asm volatile("s_waitcnt lgkmcnt(0)" ::: "memory"); SBAR();
  if (ATT_PRIO & 2) __builtin_amdgcn_s_setprio(1);
#define PK(L, H) (bf16x8){L[0], L[1], L[2], L[3], H[0], H[1], H[2], H[3]}
  od = __builtin_amdgcn_mfma_f32_32x32x16_bf16(pa0, PK(l0, h0), od, 0, 0, 0);
  od = __builtin_amdgcn_mfma_f32_32x32x16_bf16(pa1, PK(l1, h1), od, 0, 0, 0);
  od = __builtin_amdgcn_mfma_f32_32x32x16_bf16(pa2, PK(l2, h2), od, 0, 0, 0);
  od = __builtin_amdgcn_mfma_f32_32x32x16_bf16(pa3, PK(l3, h3), od, 0, 0, 0);
  if (ATT_PRIO & 2) __builtin_amdgcn_s_setprio(0);
#undef PK
}
__device__ __forceinline__ void pv_d0(f32x16* o, int vb, bf16x8 pa0, bf16x8 pa1, bf16x8 pa2, bf16x8 pa3) {
  pv_one<0>(o[0], vb, pa0, pa1, pa2, pa3); pv_one<1>(o[1], vb, pa0, pa1, pa2, pa3); pv_one<2>(o[2], vb, pa0, pa1, pa2, pa3); pv_one<3>(o[3], vb, pa0, pa1, pa2, pa3);
}

template <int DQK, int LDQ, int LDK, int LDV, int LDO, int SDEPTH, int ABL = 0, int NOMAX = 0>
__device__ __forceinline__ void attn_unit(const bf16_t* __restrict__ Qb, const bf16_t* __restrict__ Kh, const bf16_t* __restrict__ Krp, const bf16_t* __restrict__ Vh,
                                          bf16_t* __restrict__ Ob, const int NT, const int base1, const int wmode, const int qpos0, const float m_init, const float l_init, const float* rope_tbl, const float* gq, char* lds, const int tid_in, const bool nomax_rt = false) {
  constexpr int NQ = (DQK == 192) ? ATT_NQ192 : ATT_NQ128;
  int tid_ = tid_in; asm volatile("" : "+v"(tid_));
  const int tid = tid_, wid = tid >> 6, lane = tid & 63, r32 = lane & 31, hi = lane >> 5;
  char* V_lds = lds + OFF_V; char* K_lds = lds + OFF_K; char* KR_lds = lds + OFF_KR;
  float* ws = (float*)(lds + OFF_WS) + wid * 64; float* li_l = ws; float* al_l = ws + 32;
  float m_reg = m_init, l_reg = l_init; f32x16 o[4] = {}; bf16x8 qall[8];
  const bf16_t* Qw = Qb + (long)(wid * QBLK + r32) * LDQ + hi * 8;
#pragma unroll
  for (int d0 = 0; d0 < 8; ++d0) qall[d0] = *reinterpret_cast<const bf16x8*>(Qw + d0 * 16);
  if constexpr (DQK == 128) {
    if (rope_tbl) {
      float x[8][8];
#pragma unroll
      for (int d0 = 0; d0 < 8; ++d0) { const u32x4 w = __builtin_bit_cast(u32x4, qall[d0]);
#pragma unroll
        for (int i = 0; i < 4; ++i) { x[d0][2 * i] = __builtin_bit_cast(float, w[i] << 16); x[d0][2 * i + 1] = __builtin_bit_cast(float, w[i] & 0xffff0000u); } }
      if (gq) { float ss = 0.f;
#pragma unroll
        for (int d0 = 0; d0 < 8; ++d0)
#pragma unroll
          for (int i = 0; i < 8; ++i) ss += x[d0][i] * x[d0][i];
        { auto rr = __builtin_amdgcn_permlane32_swap(__float_as_uint(ss), __float_as_uint(ss), false, false); ss = __uint_as_float(rr[0]) + __uint_as_float(rr[1]); }
        const float r = 1.0f / sqrtf(ss * (1.0f / 128.0f) + 1e-6f);
#pragma unroll
        for (int d0 = 0; d0 < 8; ++d0)
#pragma unroll
          for (int i = 0; i < 8; ++i) x[d0][i] *= r * gq[16 * d0 + 8 * hi + i]; }
      const int t = qpos0 + wid * QBLK + r32;
#pragma unroll
      for (int a = 0; a < 2; ++a) { const int pos = a == 0 ? (t >> 6) : (t & 63);
#pragma unroll
        for (int e = 0; e < 2; ++e) { const float* ct = rope_tbl + (a == 0 ? 0 : 8192) + pos * 32 + 16 * e + 8 * hi; const float* st = ct + (a == 0 ? 4096 : 2048);
#pragma unroll
          for (int i = 0; i < 8; ++i) { const float c = ct[i], s_ = st[i], x1 = x[4 * a + e][i], x2 = x[4 * a + 2 + e][i]; x[4 * a + e][i] = x1 * c - x2 * s_; x[4 * a + 2 + e][i] = x2 * c + x1 * s_; } } }
#pragma unroll
      for (int d0 = 0; d0 < 8; ++d0) { u32x4 w;
#pragma unroll
        for (int i = 0; i < 4; ++i) w[i] = cvtpk(x[d0][2 * i], x[d0][2 * i + 1]);
        qall[d0] = __builtin_bit_cast(bf16x8, w); }
    }
  }
  constexpr bool NEGMU = (ATT_NEGM == 1 && DQK == 128) || ATT_NEGM == 2 || NOMAX != 0;
  if constexpr (NEGMU) {
#pragma unroll
    for (int d0 = 0; d0 < 8; ++d0) qall[d0] = scale_frag(qall[d0], Cfg<DQK>::SCALE * 1.4426950408889634f);
  }
  char* qrl = lds + OFF_QR + wid * QR_WAVE + lane * 16;
  bf16x8 qr[NQ];
#pragma unroll
  for (int d0 = 0; d0 < NQ; ++d0) qr[d0] = qall[d0];
#pragma unroll
  for (int d0 = NQ; d0 < 8; ++d0) *reinterpret_cast<bf16x8*>(qrl + ((DQK == 192 ? 4 : 0) + d0 - NQ) * 1024) = qall[d0];
  if constexpr (DQK == 192) {
    bf16x8 qf[4];
#pragma unroll
    for (int d0 = 0; d0 < 4; ++d0) qf[d0] = *reinterpret_cast<const bf16x8*>(Qw + 128 + d0 * 16);
    if (rope_tbl) {
      const int t = qpos0 + wid * QBLK + r32;
#pragma unroll
      for (int a = 0; a < 2; ++a) { const int pos = a == 0 ? (t >> 6) : (t & 63);
        const float* ct = rope_tbl + (a == 0 ? 12288 : 16384) + pos * 16 + hi * 8; const float* st = ct + (a == 0 ? 2048 : 1024);
        u32x4 w1 = __builtin_bit_cast(u32x4, qf[2 * a]), w2 = __builtin_bit_cast(u32x4, qf[2 * a + 1]), o1, o2;
#pragma unroll
        for (int i = 0; i < 4; ++i) { const float c0 = ct[2 * i], c1 = ct[2 * i + 1], s0 = st[2 * i], s1 = st[2 * i + 1];
          const float x1l = __builtin_bit_cast(float, w1[i] << 16), x1h = __builtin_bit_cast(float, w1[i] & 0xffff0000u), x2l = __builtin_bit_cast(float, w2[i] << 16), x2h = __builtin_bit_cast(float, w2[i] & 0xffff0000u);
          o1[i] = cvtpk(x1l * c0 - x2l * s0, x1h * c1 - x2h * s1); o2[i] = cvtpk(x2l * c0 + x1l * s0, x2h * c1 + x1h * s1); }
        qf[2 * a] = __builtin_bit_cast(bf16x8, o1); qf[2 * a + 1] = __builtin_bit_cast(bf16x8, o2); }
    }
    if constexpr (NEGMU) {
#pragma unroll
      for (int d0 = 0; d0 < 4; ++d0) qf[d0] = scale_frag(qf[d0], Cfg<DQK>::SCALE * 1.4426950408889634f); }
#pragma unroll
    for (int d0 = 0; d0 < 4; ++d0) *reinterpret_cast<bf16x8*>(qrl + d0 * 1024) = qf[d0];
  }
  const int sr = tid >> 4, sc = (tid & 15) * 8, vst0 = v_st(sr, sc), vst1 = v_st(32 + sr, sc);
  const int krr = tid >> 3, krc = (tid & 7) * 8;
  const int vb0 = (int)(uintptr_t)V_lds + v_rd_base(lane);
  const int dq = -(qpos0 + wid * QBLK + r32) - 256;
  struct { bf16x8 vs0, vs1, ks0, ks1, kr; } sr_[SDEPTH];
  static_assert(!(ATT_KDMA && SDEPTH != 1), "LDS-DMA staging of K needs SDEPTH 1");
  typedef __attribute__((address_space(3))) unsigned lds_u32;
  const int widu = __builtin_amdgcn_readfirstlane(wid);
  const int kd_row = widu * 4 + (lane >> 4), kd_col = ((lane & 15) ^ (kd_row & KSWZ_MASK)) * 8;
  const int kd_off = kd_row * LDK + kd_col;
  const int kr_row = widu * 8 + (lane >> 3), kr_off = kr_row * 64 + (((lane & 7) ^ ((kr_row >> 1) & 7)) * 8);
  const unsigned lds_base = (unsigned)(uintptr_t)lds;
#define KROW(j) ((j) < 4 ? (j) * 64 : base1 + ((j) - 4) * 64)
#define SLOAD(i, k0, b) do { const int k0_ = (k0); sr_[i].vs0 = *reinterpret_cast<const bf16x8*>(&Vh[(long)(k0_ + sr) * LDV + sc]); sr_[i].vs1 = *reinterpret_cast<const bf16x8*>(&Vh[(long)(k0_ + 32 + sr) * LDV + sc]); \
    if constexpr (ATT_KDMA) { \
      __builtin_amdgcn_global_load_lds((const unsigned*)(Kh + (long)k0_ * LDK + kd_off), (lds_u32*)(uintptr_t)(lds_base + OFF_K + (b) * SHM_K + widu * 1024), 16, 0, 0); \
      __builtin_amdgcn_global_load_lds((const unsigned*)(Kh + (long)(k0_ + 32) * LDK + kd_off), (lds_u32*)(uintptr_t)(lds_base + OFF_K + (b) * SHM_K + 8192 + widu * 1024), 16, 0, 0); \
      if constexpr (DQK == 192) __builtin_amdgcn_global_load_lds((const unsigned*)(Krp + (long)k0_ * 64 + kr_off), (lds_u32*)(uintptr_t)(lds_base + OFF_KR + (b) * SHM_KR + widu * 1024), 16, 0, 0); \
    } else { \
    sr_[i].ks0 = *reinterpret_cast<const bf16x8*>(&Kh[(long)(k0_ + sr) * LDK + sc]); sr_[i].ks1 = *reinterpret_cast<const bf16x8*>(&Kh[(long)(k0_ + 32 + sr) * LDK + sc]); \
    if constexpr (DQK == 192) sr_[i].kr = *reinterpret_cast<const bf16x8*>(&Krp[(long)(k0_ + krr) * 64 + krc]); } } while (0)
#define SWRITE(b, i) do { *(bf16x8*)(V_lds + (b) * SHM_V + vst0) = sr_[i].vs0; *(bf16x8*)(V_lds + (b) * SHM_V + vst1) = sr_[i].vs1; \
    if constexpr (!ATT_KDMA) { const int kc = sc * 2; \
    *(bf16x8*)(K_lds + (b) * SHM_K + KSWZ(sr, kc)) = sr_[i].ks0; *(bf16x8*)(K_lds + (b) * SHM_K + KSWZ(32 + sr, kc)) = sr_[i].ks1; \
    if constexpr (DQK == 192) *(bf16x8*)(KR_lds + (b) * SHM_KR + KRSWZ(krr, krc * 2)) = sr_[i].kr; } } while (0)
#define SWAIT() do { if constexpr (SDEPTH == 1) asm volatile("s_waitcnt vmcnt(0)" ::: "memory"); else if constexpr (DQK == 192) asm volatile("s_waitcnt vmcnt(5)" ::: "memory"); else asm volatile("s_waitcnt vmcnt(4)" ::: "memory"); } while (0)
#define RESC(a) do { if constexpr (NOMAX == 0) if (!(NEGMU && nomax_rt) && __any((a) < 1.f)) { if (hi == 0) al_l[r32] = (a); asm volatile("s_waitcnt lgkmcnt(0)" ::: "memory"); \
    _Pragma("unroll") for (int d = 0; d < 4; ++d) _Pragma("unroll") for (int r = 0; r < 16; ++r) o[d][r] *= al_l[crow(r, hi)]; } } while (0)
#define MASK(P0, P1, j) do { if (wmode && (j) >= 4) wmask(P0, P1, KROW(j) + dq, hi); } while (0)
  if (ATT_PRIO & 4) { if (__builtin_amdgcn_readfirstlane(wid) >= 4) __builtin_amdgcn_s_setprio(1); }
  f32x16 pA0, pA1, pB0, pB1; float mnA, mnB, alA, alB; bf16x8 pa0, pa1, pa2, pa3;
  float negm = (NOMAX || nomax_rt) ? -m_init : (m_init > -1e29f) ? -m_init * (Cfg<DQK>::SCALE * 1.4426950408889634f) : 0.f;
  bool force_first = !(m_init > -1e29f);
#define PSM(P0, P1, MN, AL) do { if constexpr (NOMAX != 0) { AL = 1.f; _Pragma("unroll") for (int r_ = 0; r_ < 16; ++r_) P0[r_] = __builtin_amdgcn_exp2f(P0[r_]); } else if constexpr (NEGMU) { if (nomax_rt) { AL = 1.f; _Pragma("unroll") for (int r_ = 0; r_ < 16; ++r_) P0[r_] = __builtin_amdgcn_exp2f(P0[r_]); } else { partialSM_negm<DQK>(negm, force_first, P0, P1, AL); force_first = false; } } else partialSM<DQK>(P0, P1, m_reg, MN, AL); } while (0)
  if constexpr (ATT_VDMA == 2) {
  static_assert(ATT_KDMA && SDEPTH == 1 && (4 + 8 - NQ) * 1024 <= QR_WAVE + 4096 * (DQK == 128), "ATT_VDMA 2: all nope fragments of Q in VGPRs");
  const int vk0 = (widu >> 1) * 8 + ((lane & 31) >> 2), vkey = (vk0 & ~0xC) | ((vk0 & 4) << 1) | ((vk0 & 8) >> 1);
  const int vd_off = vkey * LDV + ((widu & 1) * 2 + (lane >> 5)) * 32 + (lane & 3) * 8;
  constexpr int NDMA = (DQK == 192) ? 5 : 4;
#define DMA_K(k0, ks) do { const int k0_ = (k0); const int ks_ = (ks); \
      __builtin_amdgcn_global_load_lds((const unsigned*)(Kh + (long)k0_ * LDK + kd_off), (lds_u32*)(uintptr_t)(lds_base + OFF_K + ks_ * SHM_K + widu * 1024), 16, 0, 0); \
      __builtin_amdgcn_global_load_lds((const unsigned*)(Kh + (long)(k0_ + 32) * LDK + kd_off), (lds_u32*)(uintptr_t)(lds_base + OFF_K + ks_ * SHM_K + 8192 + widu * 1024), 16, 0, 0); \
      if constexpr (DQK == 192) __builtin_amdgcn_global_load_lds((const unsigned*)(Krp + (long)k0_ * 64 + kr_off), (lds_u32*)(uintptr_t)(lds_base + OFF_KR + ks_ * SHM_KR + widu * 1024), 16, 0, 0); } while (0)
#define DMA_V(k0, vs) do { const int k0_ = (k0); const int vs_ = (vs); \
      __builtin_amdgcn_global_load_lds((const unsigned*)(Vh + (long)k0_ * LDV + vd_off), (lds_u32*)(uintptr_t)(lds_base + OFF_V + vs_ * SHM_V + widu * 1024), 16, 0, 0); \
      __builtin_amdgcn_global_load_lds((const unsigned*)(Vh + (long)(k0_ + 32) * LDV + vd_off), (lds_u32*)(uintptr_t)(lds_base + OFF_V + vs_ * SHM_V + 8192 + widu * 1024), 16, 0, 0); } while (0)
#define VM0_SYNC() do { asm volatile("s_waitcnt vmcnt(0)" ::: "memory"); __syncthreads(); } while (0)
#define VMN_SYNC() do { if constexpr (DQK == 192) asm volatile("s_waitcnt vmcnt(5)" ::: "memory"); else asm volatile("s_waitcnt vmcnt(4)" ::: "memory"); __syncthreads(); } while (0)
#define R3_PREV(s_) ((s_) >= 1 ? (s_) - 1 : 2)
#define R3_NEXT(s_) ((s_) == 2 ? 0 : (s_) + 1)
#define KT(t) KROW((t) < NT ? (t) : NT - 1)
  DMA_K(0, 0); DMA_V(0, 0); DMA_K(KROW(1), 1); DMA_V(KROW(1), 1); DMA_K(KROW(2), 2); VM0_SYNC();
  qkt<DQK, NEGMU>(negm, pA0, pA1, K_lds, KR_lds, qr, qrl, r32, hi); PSM(pA0, pA1, mnA, alA);
  __syncthreads();
  const bool stag = ((DQK == 128) ? (ATT_STAG & 1) : (ATT_STAG & 2)) && (__builtin_amdgcn_readfirstlane(wid) >= 4);
  int sp = 0;
  if (!stag) {
  for (int j = 1; j + 1 < NT; j += 2) {
    { const int kq = R3_NEXT(sp);
    SBAR(); qkt<DQK, NEGMU>(negm, pB0, pB1, K_lds + kq * SHM_K, KR_lds + kq * SHM_KR, qr, qrl, r32, hi); MASK(pB0, pB1, j);
    finishSM(pA0, pA1, alA, l_reg, pa0, pa1, pa2, pa3); SBAR();
    DMA_K(KT(j + 2), sp); DMA_V(KROW(j + 1), R3_PREV(sp)); SBAR();
    pv_d0(o, vb0 + sp * SHM_V, pa0, pa1, pa2, pa3); PSM(pB0, pB1, mnB, alB);
    VMN_SYNC(); RESC(alB); sp = kq; }
    { const int kq = R3_NEXT(sp);
    SBAR(); qkt<DQK, NEGMU>(negm, pA0, pA1, K_lds + kq * SHM_K, KR_lds + kq * SHM_KR, qr, qrl, r32, hi); MASK(pA0, pA1, j + 1);
    finishSM(pB0, pB1, alB, l_reg, pa0, pa1, pa2, pa3); SBAR();
    DMA_K(KT(j + 3), sp); DMA_V(KROW(j + 2), R3_PREV(sp)); SBAR();
    pv_d0(o, vb0 + sp * SHM_V, pa0, pa1, pa2, pa3); PSM(pA0, pA1, mnA, alA);
    VMN_SYNC(); RESC(alA); sp = kq; }
  }
  } else {
  for (int j = 1; j + 1 < NT; j += 2) {
    { const int kq = R3_NEXT(sp);
    SBAR(); finishSM(pA0, pA1, alA, l_reg, pa0, pa1, pa2, pa3); SBAR();
    qkt<DQK, NEGMU>(negm, pB0, pB1, K_lds + kq * SHM_K, KR_lds + kq * SHM_KR, qr, qrl, r32, hi); MASK(pB0, pB1, j); SBAR();
    DMA_K(KT(j + 2), sp); DMA_V(KROW(j + 1), R3_PREV(sp)); SBAR();
    PSM(pB0, pB1, mnB, alB); SBAR(); pv_d0(o, vb0 + sp * SHM_V, pa0, pa1, pa2, pa3);
    VMN_SYNC(); RESC(alB); sp = kq; }
    { const int kq = R3_NEXT(sp);
    SBAR(); finishSM(pB0, pB1, alB, l_reg, pa0, pa1, pa2, pa3); SBAR();
    qkt<DQK, NEGMU>(negm, pA0, pA1, K_lds + kq * SHM_K, KR_lds + kq * SHM_KR, qr, qrl, r32, hi); MASK(pA0, pA1, j + 1); SBAR();
    DMA_K(KT(j + 3), sp); DMA_V(KROW(j + 2), R3_PREV(sp)); SBAR();
    PSM(pA0, pA1, mnA, alA); SBAR(); pv_d0(o, vb0 + sp * SHM_V, pa0, pa1, pa2, pa3);
    VMN_SYNC(); RESC(alA); sp = kq; }
  }
  }
  { const int kq = R3_NEXT(sp);
  SBAR(); qkt<DQK, NEGMU>(negm, pB0, pB1, K_lds + kq * SHM_K, KR_lds + kq * SHM_KR, qr, qrl, r32, hi); MASK(pB0, pB1, NT - 1);
  finishSM(pA0, pA1, alA, l_reg, pa0, pa1, pa2, pa3); SBAR();
  pv_d0(o, vb0 + sp * SHM_V, pa0, pa1, pa2, pa3); PSM(pB0, pB1, mnB, alB);
  VM0_SYNC(); RESC(alB); sp = kq; }
  finishSM(pB0, pB1, alB, l_reg, pa0, pa1, pa2, pa3); SBAR();
  pv_d0(o, vb0 + sp * SHM_V, pa0, pa1, pa2, pa3);
#undef DMA_K
#undef DMA_V
#undef VM0_SYNC
#undef VMN_SYNC
#undef R3_PREV
#undef R3_NEXT
#undef KT
  } else if constexpr (ATT_VDMA == 1) {
  static_assert(ATT_KDMA && SDEPTH == 1, "ATT_VDMA builds on ATT_KDMA");
  const int vk0 = (widu >> 1) * 8 + ((lane & 31) >> 2), vkey = (vk0 & ~0xC) | ((vk0 & 4) << 1) | ((vk0 & 8) >> 1);
  const int vd_off = vkey * LDV + ((widu & 1) * 2 + (lane >> 5)) * 32 + (lane & 3) * 8;
#define DMA_KV(k0, kb, vsl) do { const int k0_ = (k0); \
      __builtin_amdgcn_global_load_lds((const unsigned*)(Kh + (long)k0_ * LDK + kd_off), (lds_u32*)(uintptr_t)(lds_base + OFF_K + (kb) * SHM_K + widu * 1024), 16, 0, 0); \
      __builtin_amdgcn_global_load_lds((const unsigned*)(Kh + (long)(k0_ + 32) * LDK + kd_off), (lds_u32*)(uintptr_t)(lds_base + OFF_K + (kb) * SHM_K + 8192 + widu * 1024), 16, 0, 0); \
      if constexpr (DQK == 192) __builtin_amdgcn_global_load_lds((const unsigned*)(Krp + (long)k0_ * 64 + kr_off), (lds_u32*)(uintptr_t)(lds_base + OFF_KR + (kb) * SHM_KR + widu * 1024), 16, 0, 0); \
      __builtin_amdgcn_global_load_lds((const unsigned*)(Vh + (long)k0_ * LDV + vd_off), (lds_u32*)(uintptr_t)(lds_base + OFF_V + (vsl) + widu * 1024), 16, 0, 0); \
      __builtin_amdgcn_global_load_lds((const unsigned*)(Vh + (long)(k0_ + 32) * LDV + vd_off), (lds_u32*)(uintptr_t)(lds_base + OFF_V + (vsl) + 8192 + widu * 1024), 16, 0, 0); } while (0)
#define VM0_SYNC() do { asm volatile("s_waitcnt vmcnt(0)" ::: "memory"); __syncthreads(); } while (0)
#define VS_DMA(sp_) (((sp_) >= 1 ? (sp_) - 1 : 2) * SHM_V)
#define VS_NEXT(sp_) ((sp_) == 2 ? 0 : (sp_) + 1)
  DMA_KV(0, 0, 0); VM0_SYNC();
  qkt<DQK, NEGMU>(negm, pA0, pA1, K_lds, KR_lds, qr, qrl, r32, hi); PSM(pA0, pA1, mnA, alA);
  DMA_KV(KROW(1), 1, SHM_V); VM0_SYNC();
  const bool stag = ((DQK == 128) ? (ATT_STAG & 1) : (ATT_STAG & 2)) && (__builtin_amdgcn_readfirstlane(wid) >= 4);
  int sp = 0;
  if (!stag) {
  for (int j = 1; j + 1 < NT; j += 2) {
    SBAR(); qkt<DQK, NEGMU>(negm, pB0, pB1, K_lds + SHM_K, KR_lds + SHM_KR, qr, qrl, r32, hi); MASK(pB0, pB1, j);
    finishSM(pA0, pA1, alA, l_reg, pa0, pa1, pa2, pa3); SBAR();
    DMA_KV(KROW(j + 1), 0, VS_DMA(sp)); SBAR();
    pv_d0(o, vb0 + sp * SHM_V, pa0, pa1, pa2, pa3); PSM(pB0, pB1, mnB, alB);
    VM0_SYNC(); RESC(alB); sp = VS_NEXT(sp);
    SBAR(); qkt<DQK, NEGMU>(negm, pA0, pA1, K_lds, KR_lds, qr, qrl, r32, hi); MASK(pA0, pA1, j + 1);
    finishSM(pB0, pB1, alB, l_reg, pa0, pa1, pa2, pa3); SBAR();
    DMA_KV(KROW(j + 2), 1, VS_DMA(sp)); SBAR();
    pv_d0(o, vb0 + sp * SHM_V, pa0, pa1, pa2, pa3); PSM(pA0, pA1, mnA, alA);
    VM0_SYNC(); RESC(alA); sp = VS_NEXT(sp);
  }
  } else {
  for (int j = 1; j + 1 < NT; j += 2) {
    SBAR(); finishSM(pA0, pA1, alA, l_reg, pa0, pa1, pa2, pa3); SBAR();
    qkt<DQK, NEGMU>(negm, pB0, pB1, K_lds + SHM_K, KR_lds + SHM_KR, qr, qrl, r32, hi); MASK(pB0, pB1, j); SBAR();
    DMA_KV(KROW(j + 1), 0, VS_DMA(sp)); SBAR();
    PSM(pB0, pB1, mnB, alB); SBAR(); pv_d0(o, vb0 + sp * SHM_V, pa0, pa1, pa2, pa3);
    VM0_SYNC(); RESC(alB); sp = VS_NEXT(sp);
    SBAR(); finishSM(pB0, pB1, alB, l_reg, pa0, pa1, pa2, pa3); SBAR();
    qkt<DQK, NEGMU>(negm, pA0, pA1, K_lds, KR_lds, qr, qrl, r32, hi); MASK(pA0, pA1, j + 1); SBAR();
    DMA_KV(KROW(j + 2), 1, VS_DMA(sp)); SBAR();
    PSM(pA0, pA1, mnA, alA); SBAR(); pv_d0(o, vb0 + sp * SHM_V, pa0, pa1, pa2, pa3);
    VM0_SYNC(); RESC(alA); sp = VS_NEXT(sp);
  }
  }
  SBAR(); qkt<DQK, NEGMU>(negm, pB0, pB1, K_lds + SHM_K, KR_lds + SHM_KR, qr, qrl, r32, hi); MASK(pB0, pB1, NT - 1);
  finishSM(pA0, pA1, alA, l_reg, pa0, pa1, pa2, pa3); SBAR();
  pv_d0(o, vb0 + sp * SHM_V, pa0, pa1, pa2, pa3); PSM(pB0, pB1, mnB, alB);
  RESC(alB); sp = VS_NEXT(sp);
  finishSM(pB0, pB1, alB, l_reg, pa0, pa1, pa2, pa3); SBAR();
  pv_d0(o, vb0 + sp * SHM_V, pa0, pa1, pa2, pa3);
#undef DMA_KV
#undef VM0_SYNC
#undef VS_DMA
#undef VS_NEXT
  } else {
  constexpr int SE = 0, SO = SDEPTH - 1;
  SLOAD(SE, 0, 0); asm volatile("s_waitcnt vmcnt(0)" ::: "memory"); SWRITE(0, SE); __syncthreads();
  qkt<DQK, NEGMU>(negm, pA0, pA1, K_lds, KR_lds, qr, qrl, r32, hi); PSM(pA0, pA1, mnA, alA);
  SLOAD(SO, KROW(1), 1); if constexpr (SDEPTH == 2) { if (2 < NT) SLOAD(SE, KROW(2), 0); }
  SWAIT(); SWRITE(1, SO); __syncthreads();
  const bool stag = ((DQK == 128) ? (ATT_STAG & 1) : (ATT_STAG & 2)) && (__builtin_amdgcn_readfirstlane(wid) >= 4);
  if (!stag) {
  for (int j = 1; j + 1 < NT; j += 2) {
    SBAR(); qkt<DQK, NEGMU>(negm, pB0, pB1, K_lds + SHM_K, KR_lds + SHM_KR, qr, qrl, r32, hi); MASK(pB0, pB1, j);
    finishSM(pA0, pA1, alA, l_reg, pa0, pa1, pa2, pa3); SBAR();
    SLOAD(SO, KROW(j + SDEPTH), 0); SBAR();
    pv_d0(o, vb0, pa0, pa1, pa2, pa3); PSM(pB0, pB1, mnB, alB);
    __syncthreads(); SWAIT(); SWRITE(0, SE);
    RESC(alB); __syncthreads();
    SBAR(); qkt<DQK, NEGMU>(negm, pA0, pA1, K_lds, KR_lds, qr, qrl, r32, hi); MASK(pA0, pA1, j + 1);
    finishSM(pB0, pB1, alB, l_reg, pa0, pa1, pa2, pa3); SBAR();
    if (SDEPTH == 1 || j + 3 < NT) SLOAD(SE, KROW(j + 1 + SDEPTH), 1); SBAR();
    pv_d0(o, vb0 + SHM_V, pa0, pa1, pa2, pa3); PSM(pA0, pA1, mnA, alA);
    __syncthreads(); SWAIT(); SWRITE(1, SO);
    RESC(alA); __syncthreads();
  }
  } else {
  for (int j = 1; j + 1 < NT; j += 2) {
    SBAR(); finishSM(pA0, pA1, alA, l_reg, pa0, pa1, pa2, pa3); SBAR();
    qkt<DQK, NEGMU>(negm, pB0, pB1, K_lds + SHM_K, KR_lds + SHM_KR, qr, qrl, r32, hi); MASK(pB0, pB1, j); SBAR();
    SLOAD(SO, KROW(j + SDEPTH), 0); SBAR();
    PSM(pB0, pB1, mnB, alB); SBAR(); pv_d0(o, vb0, pa0, pa1, pa2, pa3);
    __syncthreads(); SWAIT(); SWRITE(0, SE);
    RESC(alB); __syncthreads();
    SBAR(); finishSM(pB0, pB1, alB, l_reg, pa0, pa1, pa2, pa3); SBAR();
    qkt<DQK, NEGMU>(negm, pA0, pA1, K_lds, KR_lds, qr, qrl, r32, hi); MASK(pA0, pA1, j + 1); SBAR();
    if (SDEPTH == 1 || j + 3 < NT) SLOAD(SE, KROW(j + 1 + SDEPTH), 1); SBAR();
    PSM(pA0, pA1, mnA, alA); SBAR(); pv_d0(o, vb0 + SHM_V, pa0, pa1, pa2, pa3);
    __syncthreads(); SWAIT(); SWRITE(1, SO);
    RESC(alA); __syncthreads();
  }
  }
  SBAR(); qkt<DQK, NEGMU>(negm, pB0, pB1, K_lds + SHM_K, KR_lds + SHM_KR, qr, qrl, r32, hi); MASK(pB0, pB1, NT - 1);
  finishSM(pA0, pA1, alA, l_reg, pa0, pa1, pa2, pa3); SBAR();
  pv_d0(o, vb0, pa0, pa1, pa2, pa3); PSM(pB0, pB1, mnB, alB);
  __syncthreads(); RESC(alB);
  finishSM(pB0, pB1, alB, l_reg, pa0, pa1, pa2, pa3); SBAR();
  pv_d0(o, vb0 + SHM_V, pa0, pa1, pa2, pa3);
  }
  if (ATT_PRIO & 4) __builtin_amdgcn_s_setprio(0);
  { const int lane_e = lane_id_fresh(), r32e = lane_e & 31, hie = lane_e >> 5; const int wide = __builtin_amdgcn_readfirstlane(wid);
  float* ws_e = (float*)(lds + OFF_WS) + wide * 64;
  if (hie == 0) ws_e[r32e] = l_reg; asm volatile("s_waitcnt lgkmcnt(0)" ::: "memory");
  float rli[16];
#pragma unroll
  for (int r = 0; r < 16; ++r) rli[r] = __builtin_amdgcn_rcpf(ws_e[crow(r, hie)]);
  __syncthreads();
  { bf16_t* stg = (bf16_t*)(lds + wide * 8192);
#pragma unroll
    for (int r = 0; r < 16; r += 2) { const int orow = crow(r, hie);
#pragma unroll
      for (int d0 = 0; d0 < 4; ++d0) { const unsigned pk = cvtpk(o[d0][r] * rli[r], o[d0][r + 1] * rli[r + 1]);
        stg[orow * 128 + d0 * 32 + r32e] = (bf16_t)(pk & 0xffffu); stg[(orow + 1) * 128 + d0 * 32 + r32e] = (bf16_t)(pk >> 16); } }
    asm volatile("s_waitcnt lgkmcnt(0)" ::: "memory");
    bf16_t* Ow = Ob + (long)(wide * QBLK) * LDO;
#pragma unroll
    for (int i = 0; i < 8; ++i) { const int ch = i * 64 + lane_e, row = ch >> 4, c8 = (ch & 15) * 8;
      const u32x4 v = *(const u32x4*)(stg + row * 128 + c8); *(u32x4*)(Ow + (long)row * LDO + c8) = v; }
  } }
  __syncthreads();
#undef PSM
#undef KROW
#undef SLOAD
#undef SWRITE
#undef SWAIT
#undef RESC
#undef MASK
}
#undef KSWZ
#undef KRSWZ
#undef SBAR
}

constexpr int NWAVES = 8;
constexpr size_t MiB = 1u << 20;
constexpr size_t WS_CTL = 0, CTL_ZERO_BYTES = 2 * MiB;
constexpr size_t WS_MOD = 1 * MiB;
constexpr size_t WS_TBL = 2 * MiB;
constexpr size_t SZ_WGU = (size_t)2 * DFF * DM * 2, SZ_WDN = (size_t)DM * DFF * 2;
constexpr size_t WS_WGU = 4 * MiB;
constexpr size_t WS_WDN = WS_WGU + 8 * SZ_WGU;
constexpr size_t SZ_WINAB = (size_t)AB_IN * DM * 2, SZ_WSQ = (size_t)DM * DM * 2, SZ_WINC = (size_t)C_IN_PAD * DM * 2, SZ_WUQ = (size_t)MLA_QOUT * QRANK * 2, SZ_WUKV = (size_t)MLA_KVOUT * KVRANK * 2;
constexpr size_t WS_WINAB = WS_WDN + 8 * SZ_WDN;
constexpr size_t WS_WOUTAB = WS_WINAB + 2 * SZ_WINAB;
constexpr size_t WS_WINC = WS_WOUTAB + 2 * SZ_WSQ;
constexpr size_t WS_WUQ = WS_WINC + 2 * SZ_WINC;
constexpr size_t WS_WUKV = WS_WUQ + 2 * SZ_WUQ;
constexpr size_t WS_WOUTC = WS_WUKV + 2 * SZ_WUKV;
constexpr size_t WS_X = WS_WOUTC + 2 * SZ_WSQ;
constexpr size_t WS_XN = WS_X + (size_t)MROWS * DM * 4;
constexpr size_t WS_H = WS_XN + (size_t)MROWS * DM * 2;
constexpr size_t WS_QKV = WS_H + (size_t)MROWS * DFF * 2;
constexpr size_t WS_KV = WS_QKV + (size_t)MROWS * 3072 * 2;
constexpr size_t WS_CQ = WS_KV + (size_t)MROWS * 4096 * 2;
constexpr size_t WS_CQN = WS_CQ + (size_t)MROWS * 1024 * 2;
constexpr size_t WS_CKVN = WS_CQN + (size_t)MROWS * 512 * 2;
constexpr size_t WS_KR = WS_CKVN + (size_t)MROWS * 256 * 2;
constexpr size_t WS_O = WS_KR + (size_t)MROWS * 64 * 2;
constexpr size_t WS_PARTC = WS_O + (size_t)MROWS * DM * 2;
constexpr size_t WS_PIN = WS_PARTC + (size_t)11 * 512 * DM * 4;
constexpr size_t WS_END = WS_PIN + (size_t)8 * 512 * 3072 * 4;
static_assert(WS_WGU % 256 == 0 && WS_X % 256 == 0 && WS_O % 256 == 0, "alignment");
constexpr int T_HRC = 0, T_HRS = 4096, T_HCC = 8192, T_HCS = 10240, T_MRC = 12288, T_MRS = 14336, T_MCC = 16384, T_MCS = 17408, T_END = 18432;
constexpr int CW_BAR = 4096;
constexpr int RING_OFF = 0, RING_BYTES = 131072, LDS_BYTES = 163840, LDSCTL_OFF = LDS_BYTES - 1024, MISC_OFF = LDSCTL_OFF + 320;
static_assert(att::LDS_BYTES <= LDSCTL_OFF, "attention scratch vs control words");

#define GAS __attribute__((address_space(1)))
#define LAS __attribute__((address_space(3)))
typedef unsigned short bf16;
typedef unsigned v4u __attribute__((ext_vector_type(4)));
typedef unsigned v2u __attribute__((ext_vector_type(2)));
typedef float f32x4 __attribute__((ext_vector_type(4)));
typedef GAS unsigned gu32;
#define RLX_AGENT __ATOMIC_RELAXED, __HIP_MEMORY_SCOPE_AGENT
#define LDS_WAIT() asm volatile("s_waitcnt lgkmcnt(0)" ::: "memory")
__device__ __forceinline__ unsigned f2bf(float f) { unsigned u = __builtin_bit_cast(unsigned, f); return (u + 0x7fffu + ((u >> 16) & 1u)) >> 16; }
__device__ __forceinline__ unsigned pk2(float lo, float hi) { return f2bf(lo) | (f2bf(hi) << 16); }
__device__ __forceinline__ float bf2f(unsigned short h) { return __builtin_bit_cast(float, (unsigned)h << 16); }
__device__ __forceinline__ float bflo(unsigned w) { return __builtin_bit_cast(float, w << 16); }
__device__ __forceinline__ float bfhi(unsigned w) { return __builtin_bit_cast(float, w & 0xffff0000u); }
__device__ __forceinline__ float wave_max(float v) {
    const int l4 = lane_id_fresh() << 2;
#pragma unroll
    for (int o = 1; o < 64; o <<= 1) v = fmaxf(v, __builtin_bit_cast(float, __builtin_amdgcn_ds_bpermute(l4 ^ (o << 2), __builtin_bit_cast(int, v))));
    return v;
}
__device__ __forceinline__ float wave_sum(float v) {
    const int l4 = lane_id_fresh() << 2;
#pragma unroll
    for (int o = 1; o < 64; o <<= 1) v += __builtin_bit_cast(float, __builtin_amdgcn_ds_bpermute(l4 ^ (o << 2), __builtin_bit_cast(int, v)));
    return v;
}

#define XB_TMO      128
#define XB_XCNT(j)  (256  + 64 * (j))
#define XB_XSUB(j)  (1280 + 64 * (j))
#define XB_XGEN(j)  (2304 + 64 * (j))
#define XB_TOP      3328
#define XB_TOPGEN   3392
#define XCD_BAR_WORDS 3456
#define XB_SPIN_CAP (1u << 18)

__device__ __forceinline__ unsigned xb_ld(unsigned* p)              { return __hip_atomic_load(p, __ATOMIC_RELAXED, __HIP_MEMORY_SCOPE_AGENT); }
__device__ __forceinline__ unsigned xb_add(unsigned* p, unsigned v) { return __hip_atomic_fetch_add(p, v, __ATOMIC_RELAXED, __HIP_MEMORY_SCOPE_AGENT); }
__device__ __forceinline__ unsigned xb_xcc_id() { return (unsigned)__builtin_amdgcn_s_getreg((3 << 11) | 20) & 0xFu; }
#define XB_SPIN(cond, bar) do { unsigned _sp = 0; while (cond) { __builtin_amdgcn_s_sleep(1); \
    if ((++_sp & 255u) == 0u) { if (xb_ld(&(bar)[XB_TMO])) break; if (_sp > XB_SPIN_CAP) { atomicAdd(&(bar)[XB_TMO], 1u); break; } } } } while (0)

struct XcdBarrier {
    unsigned* bar; unsigned x;
    volatile LAS unsigned* st;
};

__device__ __forceinline__ XcdBarrier xcd_barrier_post(unsigned* bar, volatile LAS unsigned* st, const bool t0) {
    XcdBarrier b; b.bar = bar; b.x = xb_xcc_id(); b.st = st;
    if (t0) (void)xb_add(&bar[XB_XCNT(b.x)], 1u);
    return b;
}
__device__ __forceinline__ void xcd_barrier_complete(unsigned* bar, unsigned x, unsigned& nloc, unsigned& nx) {
    const unsigned G = gridDim.x * gridDim.y * gridDim.z;
    unsigned sum, cnt, mine, sp = 0u;
    for (;;) {
        sum = 0u; cnt = 0u; mine = 0u;
#pragma unroll
        for (unsigned j = 0; j < 16; ++j) { const unsigned c = xb_ld(&bar[XB_XCNT(j)]); sum += c; cnt += (c > 0u) ? 1u : 0u; mine = (j == x) ? c : mine; }
        if (sum == G) break;
        __builtin_amdgcn_s_sleep(1);
        if ((++sp & 255u) == 0u) { if (xb_ld(&bar[XB_TMO])) break; if (sp > XB_SPIN_CAP) { atomicAdd(&bar[XB_TMO], 1u); break; } }
    }
    nloc = mine > 0u ? mine : 1u; nx = cnt > 0u ? cnt : 1u;
}

__device__ __forceinline__ void xcd_barrier(const XcdBarrier& b, const bool t0) {
    asm volatile("s_waitcnt vmcnt(0)" ::: "memory");
    __syncthreads();
    if (t0) {
        unsigned* bar = b.bar;
        __builtin_amdgcn_s_waitcnt(0);
        unsigned nloc = b.st[0], nx = b.st[1];
        if (nloc == 0u) { xcd_barrier_complete(bar, b.x, nloc, nx); b.st[0] = nloc; b.st[1] = nx; }
        const unsigned old = xb_add(&bar[XB_XSUB(b.x)], 1u);
        const unsigned gen = old / nloc;
#if PROBE_WAIT_LOCAL
        __hip_atomic_fetch_max(&bar[12288 + gen * 16 + b.x], (unsigned)__builtin_amdgcn_s_memrealtime(), __ATOMIC_RELAXED, __HIP_MEMORY_SCOPE_AGENT);
#endif
        if (old + 1u == (gen + 1u) * nloc) {
            __builtin_amdgcn_fence(__ATOMIC_RELEASE, "agent");
            asm volatile("s_waitcnt vmcnt(0)" ::: "memory");
            const unsigned og = xb_add(&bar[XB_TOP], 1u);
            const unsigned tg = og / nx;
            if (og + 1u == (tg + 1u) * nx) xb_add(&bar[XB_TOPGEN], 1u);
            else XB_SPIN(xb_ld(&bar[XB_TOPGEN]) == tg, bar);
            __builtin_amdgcn_fence(__ATOMIC_ACQUIRE, "agent");
            xb_add(&bar[XB_XGEN(b.x)], 1u);
            asm volatile("s_waitcnt vmcnt(0)" ::: "memory");
        } else {
            XB_SPIN(xb_ld(&bar[XB_XGEN(b.x)]) == gen, bar);
            __builtin_amdgcn_fence(__ATOMIC_ACQUIRE, "agent");
            asm volatile("s_waitcnt vmcnt(0)" ::: "memory");
        }
    }
    __syncthreads();
}
__device__ __forceinline__ void p0_mod(const float* __restrict__ c, const float* __restrict__ cctx, const float* __restrict__ wmod, float* PART,
                                       LAS unsigned char* lds, int tid, int wave, int lane) {
    LAS float* sv = (LAS float*)lds;
    LAS float* red = (LAS float*)(lds + 24576);
    for (int i = tid; i < 3 * 2048; i += 512) { const int v = i >> 11, k = i & 2047; const float x = v < 2 ? c[v * 2048 + k] : cctx[k]; sv[i] = x / (1.0f + expf(-x)); }
    __syncthreads();
    for (int t = blockIdx.x; t < 2304; t += gridDim.x) {
        const int l = t / 576, rem = t - l * 576, nch = rem >> 3, kch = rem & 7;
        const int k0 = kch * 256 + wave * 32;
        const float* W = wmod + ((size_t)l * 2048 + k0) * 18432 + nch * 256 + lane * 4;
        f32x4 a0 = {0.f, 0.f, 0.f, 0.f}, a1 = a0, a2 = a0;
#pragma unroll 8
        for (int kk = 0; kk < 32; ++kk) { const f32x4 w = NT_W ? __builtin_nontemporal_load((const f32x4*)(W + (size_t)kk * 18432)) : *(const f32x4*)(W + (size_t)kk * 18432);
            a0 += sv[k0 + kk] * w; a1 += sv[2048 + k0 + kk] * w; a2 += sv[4096 + k0 + kk] * w; }
#pragma unroll
        for (int j = 0; j < 4; ++j) { red[(wave * 12 + j) * 64 + lane] = a0[j]; red[(wave * 12 + 4 + j) * 64 + lane] = a1[j]; red[(wave * 12 + 8 + j) * 64 + lane] = a2[j]; }
        __syncthreads();
        for (int idx = tid; idx < 768; idx += 512) { const int v = idx >> 8, cc = idx & 255, ln = cc >> 2, j = cc & 3; float s = 0.f;
#pragma unroll
            for (int w = 0; w < 8; ++w) s += red[(w * 12 + v * 4 + j) * 64 + ln];
            PART[(size_t)((l * 8 + kch) * 3 + v) * 18432 + nch * 256 + cc] = s; }
        __syncthreads();
    }
}
__device__ __forceinline__ void p0_mod_sum(const float* PART, const float* __restrict__ bmod, float* MOD, int gtid, int NT_) {
    for (int i = gtid; i < DEPTH * 3 * 18432; i += NT_) { const int l = i / (3 * 18432), r = i - l * 3 * 18432, v = r / 18432, n = r - v * 18432;
        float s = bmod[(size_t)l * 18432 + n];
#pragma unroll
        for (int k = 0; k < 8; ++k) s += PART[(size_t)((l * 8 + k) * 3 + v) * 18432 + n];
        MOD[i] = s; }
}
template <int MAP>
__device__ __forceinline__ void p0_transpose_item(const float* __restrict__ W, int K, int N, bf16* WT, LAS float* scr, int item, int lane) {
    const int nblk = N / 32, kb = item / nblk, nb = item - kb * nblk, k0 = 64 * kb, n0 = 32 * nb;
#pragma unroll 16
    for (int i = 0; i < 32; ++i) { const int kk = 2 * i + (lane >> 5); const float* wp = W + (size_t)(k0 + kk) * N + n0 + (lane & 31); scr[kk * 33 + (lane & 31)] = NT_W ? __builtin_nontemporal_load(wp) : *wp; }
    LDS_WAIT(); asm volatile("" ::: "memory");
    int r0 = n0;
    if (MAP == 1) { r0 = n0 < DFF ? (n0 / 128) * 256 + (n0 % 128) : ((n0 - DFF) / 128) * 256 + 128 + ((n0 - DFF) % 128); }
    const int c = lane & 7;
#pragma unroll
    for (int j = 0; j < 4; ++j) { const int n = (lane >> 3) + 8 * j; const LAS float* s = scr + (8 * c) * 33 + n;
        v4u o; o.x = pk2(s[0 * 33], s[1 * 33]); o.y = pk2(s[2 * 33], s[3 * 33]); o.z = pk2(s[4 * 33], s[5 * 33]); o.w = pk2(s[6 * 33], s[7 * 33]);
        *(GAS v4u*)(WT + (size_t)(r0 + n) * K + k0 + 8 * c) = o; }
    LDS_WAIT(); asm volatile("" ::: "memory");
}
__device__ __forceinline__ double my_exp(double y) {
    const double t = y * (1.0 / 1024.0); double e = 1.0, term = 1.0;
#pragma unroll
    for (int i = 1; i <= 10; ++i) { term *= t * (1.0 / i); e += term; }
#pragma unroll
    for (int i = 0; i < 10; ++i) e *= e;
    return e;
}
__device__ __forceinline__ void my_sincos(double x, double& s, double& c) {
    const double k = __builtin_rint(x * 0.15915494309189535);
    const double r = (x - k * 6.283185307179586) - k * 2.4492935982947064e-16;
    const double r2 = r * r; double cs = 1.0, sn = r, tc = 1.0, ts = r;
#pragma unroll
    for (int i = 1; i <= 16; ++i) { tc *= -r2 * (1.0 / ((2.0 * i - 1.0) * (2.0 * i))); cs += tc; ts *= -r2 * (1.0 / ((2.0 * i) * (2.0 * i + 1.0))); sn += ts; }
    s = sn; c = cs;
}

__device__ __forceinline__ void convert_layer(const float* __restrict__ wgu, const float* __restrict__ wdn, const float* __restrict__ winab, const float* __restrict__ woutab, const float* __restrict__ winc,
                                              const float* __restrict__ wuq, const float* __restrict__ wukv, const float* __restrict__ woutc, unsigned char* ws,
                                              int ly, int part, int nparts, int widx, int nw, LAS float* scr, int lane) {
    constexpr int I_GU = 32 * 352, I_DN = 88 * 64, I_INAB = 32 * 96, I_SQ = 32 * 64, I_INC = 32 * 26, I_UQ = 8 * 96, I_UKV = 4 * 128;
    const bool odd = (ly & 1) != 0; const int mi = ly >> 1;
    const int NI = 2 * I_GU + 2 * I_DN + (odd ? I_INC + I_UQ + I_UKV + I_SQ : I_INAB + I_SQ);
    const int lo = (int)((long)NI * part / nparts), hi = (int)((long)NI * (part + 1) / nparts);
    for (int it = lo + widx; it < hi; it += nw) {
        int r = it;
        if (r < 2 * I_GU) { const int m = 2 * ly + r / I_GU; p0_transpose_item<1>(wgu + (size_t)m * DM * 2 * DFF, DM, 2 * DFF, (bf16*)(ws + WS_WGU) + (size_t)m * 2 * DFF * DM, scr, r % I_GU, lane); continue; } r -= 2 * I_GU;
        if (r < 2 * I_DN) { const int m = 2 * ly + r / I_DN; p0_transpose_item<0>(wdn + (size_t)m * DFF * DM, DFF, DM, (bf16*)(ws + WS_WDN) + (size_t)m * DM * DFF, scr, r % I_DN, lane); continue; } r -= 2 * I_DN;
        if (!odd) {
            if (r < I_INAB) { p0_transpose_item<0>(winab + (size_t)mi * DM * AB_IN, DM, AB_IN, (bf16*)(ws + WS_WINAB) + (size_t)mi * AB_IN * DM, scr, r, lane); continue; } r -= I_INAB;
            p0_transpose_item<0>(woutab + (size_t)mi * DM * DM, DM, DM, (bf16*)(ws + WS_WOUTAB) + (size_t)mi * DM * DM, scr, r, lane);
        } else {
            if (r < I_INC) { p0_transpose_item<0>(winc + (size_t)mi * DM * C_IN, DM, C_IN, (bf16*)(ws + WS_WINC) + (size_t)mi * C_IN_PAD * DM, scr, r, lane); continue; } r -= I_INC;
            if (r < I_UQ) { p0_transpose_item<0>(wuq + (size_t)mi * QRANK * MLA_QOUT, QRANK, MLA_QOUT, (bf16*)(ws + WS_WUQ) + (size_t)mi * MLA_QOUT * QRANK, scr, r, lane); continue; } r -= I_UQ;
            if (r < I_UKV) { p0_transpose_item<0>(wukv + (size_t)mi * KVRANK * MLA_KVOUT, KVRANK, MLA_KVOUT, (bf16*)(ws + WS_WUKV) + (size_t)mi * MLA_KVOUT * KVRANK, scr, r, lane); continue; } r -= I_UKV;
            p0_transpose_item<0>(woutc + (size_t)mi * DM * DM, DM, DM, (bf16*)(ws + WS_WOUTC) + (size_t)mi * DM * DM, scr, r, lane);
        }
    }
}

__device__ __forceinline__ int blk_xr(int q, int NGW) { if (!NORM_BLOCKED || NGW != 2048) return q; const int k = q >> 11, w = q & 2047; return (w >> 8) * 2048 + k * 256 + (w & 255); }

__device__ __forceinline__ void norm_phase(const float* __restrict__ xin, const float* __restrict__ cin, bf16* X, bf16* XN, const float* __restrict__ g, const float* modl, int jmod, bool first,
                                           const float* PART, int pS, const float* pgate, float pcoef, int gw, int NGW, int lane) {
    asm volatile("" : "+v"(lane));
    int q_first = gw;
    if (NORM_BLOCKED && NORM_NRB > 1 && NGW == 2048) {
        const int b = gw >> 10;
        const float* sh = modl + (size_t)(b * 9 + 3 * jmod) * DM; const float* sc = sh + DM;
        for (int k = 0; k < 8; k += NORM_NRB) {
            f32x4 x[NORM_NRB][4][2]; float ss[NORM_NRB];
#pragma unroll
            for (int u = 0; u < NORM_NRB; ++u) { const int xr = (gw >> 8) * 2048 + (k + u) * 256 + (gw & 255); const size_t row = (size_t)b * RPB + CTXL + (xr & (SEQ - 1));
                if (first) { const float* src = xin + (size_t)xr * DM;
#pragma unroll
                    for (int i = 0; i < 4; ++i) { x[u][i][0] = *(const f32x4*)(src + 8 * (lane + 64 * i)); x[u][i][1] = *(const f32x4*)(src + 8 * (lane + 64 * i) + 4); } }
                else { const bf16* src = X + row * DM;
#pragma unroll
                    for (int i = 0; i < 4; ++i) { const v4u w = *(const v4u*)(src + 8 * (lane + 64 * i));
                        x[u][i][0] = (f32x4){bflo(w.x), bfhi(w.x), bflo(w.y), bfhi(w.y)}; x[u][i][1] = (f32x4){bflo(w.z), bfhi(w.z), bflo(w.w), bfhi(w.w)}; } } }
            if (first) {
#pragma unroll
                for (int u = 0; u < NORM_NRB; ++u) { const int xr = (gw >> 8) * 2048 + (k + u) * 256 + (gw & 255); bf16* xo = X + ((size_t)b * RPB + CTXL + (xr & (SEQ - 1))) * DM;
#pragma unroll
                    for (int i = 0; i < 4; ++i) { v4u o; o.x = pk2(x[u][i][0].x, x[u][i][0].y); o.y = pk2(x[u][i][0].z, x[u][i][0].w); o.z = pk2(x[u][i][1].x, x[u][i][1].y); o.w = pk2(x[u][i][1].z, x[u][i][1].w);
                        *(v4u*)(xo + 8 * (lane + 64 * i)) = o;
                        x[u][i][0] = (f32x4){bflo(o.x), bfhi(o.x), bflo(o.y), bfhi(o.y)}; x[u][i][1] = (f32x4){bflo(o.z), bfhi(o.z), bflo(o.w), bfhi(o.w)}; } } }
#pragma unroll
            for (int u = 0; u < NORM_NRB; ++u) { float s = 0.f;
#pragma unroll
                for (int i = 0; i < 4; ++i)
#pragma unroll
                    for (int h = 0; h < 2; ++h) s += (x[u][i][h].x * x[u][i][h].x + x[u][i][h].y * x[u][i][h].y) + (x[u][i][h].z * x[u][i][h].z + x[u][i][h].w * x[u][i][h].w);
                ss[u] = s; }
#pragma unroll
            for (int u = 0; u < NORM_NRB; ++u) ss[u] = 1.0f / sqrtf(wave_sum(ss[u]) * (1.0f / DM) + EPS);
#pragma unroll
            for (int i = 0; i < 4; ++i) { const int col = 8 * (lane + 64 * i); f32x4 ga[2], s0[2];
#pragma unroll
                for (int h = 0; h < 2; ++h) { ga[h] = *(const f32x4*)(g + col + 4 * h) * (1.0f + *(const f32x4*)(sc + col + 4 * h)); s0[h] = *(const f32x4*)(sh + col + 4 * h); }
#pragma unroll
                for (int u = 0; u < NORM_NRB; ++u) { const int xr = (gw >> 8) * 2048 + (k + u) * 256 + (gw & 255); bf16* orow = XN + ((size_t)b * RPB + CTXL + (xr & (SEQ - 1))) * DM;
                    const f32x4 y0 = x[u][i][0] * ss[u] * ga[0] + s0[0], y1 = x[u][i][1] * ss[u] * ga[1] + s0[1];
                    v4u o; o.x = pk2(y0.x, y0.y); o.y = pk2(y0.z, y0.w); o.z = pk2(y1.x, y1.y); o.w = pk2(y1.z, y1.w); *(v4u*)(orow + col) = o; } }
        }
        q_first = NB * SEQ + gw;
    }
    for (int q = q_first; q < (NORM_BLOCKED ? NB * SEQ + NGW : MROWS); q += NGW) {
        int row = q;
        if (NORM_BLOCKED) {
            if (q < NB * SEQ) { const int k = q / NGW, w = q - k * NGW, xr = (w >> 8) * 2048 + k * 256 + (w & 255); row = (xr >> 13) * RPB + CTXL + (xr & (SEQ - 1)); }
            else { const int w = q - NB * SEQ; if (w & 3) continue; const int cr = w >> 2; if (cr >= NB * CTXL) continue; row = (cr >> 8) * RPB + (cr & (CTXL - 1)); }
        }
        const int b = row >= RPB ? 1 : 0, rr = row - b * RPB; const bool isctx = rr < CTXL; const int v = isctx ? 2 : b;
        f32x4 x[4][2]; float ss = 0.f;
        if (first) { const float* src = isctx ? cin + (size_t)(b * CTXL + rr) * DM : xin + (size_t)(b * SEQ + rr - CTXL) * DM;
#pragma unroll
            for (int i = 0; i < 4; ++i) { x[i][0] = *(const f32x4*)(src + 8 * (lane + 64 * i)); x[i][1] = *(const f32x4*)(src + 8 * (lane + 64 * i) + 4); } }
        else { const bf16* src = X + (size_t)row * DM;
#pragma unroll
            for (int i = 0; i < 4; ++i) { const v4u w = *(const v4u*)(src + 8 * (lane + 64 * i));
                x[i][0] = (f32x4){bflo(w.x), bfhi(w.x), bflo(w.y), bfhi(w.y)}; x[i][1] = (f32x4){bflo(w.z), bfhi(w.z), bflo(w.w), bfhi(w.w)}; } }
        const bool pend = isctx && pS > 0;
        if (pend) { const float* pp = PART + (size_t)(b * CTXL + rr) * DM + 8 * lane;
            f32x4 sacc[4][2];
#pragma unroll
            for (int i = 0; i < 4; ++i) { sacc[i][0] = (f32x4){0.f, 0.f, 0.f, 0.f}; sacc[i][1] = sacc[i][0]; }
            for (int k0 = 0; k0 < pS; k0 += 4) { f32x4 t[4][4][2];
#pragma unroll
                for (int kk = 0; kk < 4; ++kk) { const int k = (k0 + kk < pS) ? k0 + kk : k0;
#pragma unroll
                    for (int i = 0; i < 4; ++i) { t[kk][i][0] = *(const f32x4*)(pp + (size_t)k * 512 * DM + 512 * i); t[kk][i][1] = *(const f32x4*)(pp + (size_t)k * 512 * DM + 512 * i + 4); } }
#pragma unroll
                for (int kk = 0; kk < 4; ++kk) if (k0 + kk < pS) {
#pragma unroll
                    for (int i = 0; i < 4; ++i) { sacc[i][0] += t[kk][i][0]; sacc[i][1] += t[kk][i][1]; } } }
#pragma unroll
            for (int i = 0; i < 4; ++i) { x[i][0] += (*(const f32x4*)(pgate + 8 * (lane + 64 * i)) * pcoef) * sacc[i][0]; x[i][1] += (*(const f32x4*)(pgate + 8 * (lane + 64 * i) + 4) * pcoef) * sacc[i][1]; } }
        if (first || pend) { bf16* xo = X + (size_t)row * DM;
#pragma unroll
            for (int i = 0; i < 4; ++i) { v4u o; o.x = pk2(x[i][0].x, x[i][0].y); o.y = pk2(x[i][0].z, x[i][0].w); o.z = pk2(x[i][1].x, x[i][1].y); o.w = pk2(x[i][1].z, x[i][1].w);
                *(v4u*)(xo + 8 * (lane + 64 * i)) = o;
                x[i][0] = (f32x4){bflo(o.x), bfhi(o.x), bflo(o.y), bfhi(o.y)}; x[i][1] = (f32x4){bflo(o.z), bfhi(o.z), bflo(o.w), bfhi(o.w)}; } }
#pragma unroll
        for (int i = 0; i < 4; ++i)
#pragma unroll
            for (int h = 0; h < 2; ++h) ss += (x[i][h].x * x[i][h].x + x[i][h].y * x[i][h].y) + (x[i][h].z * x[i][h].z + x[i][h].w * x[i][h].w);
        ss = wave_sum(ss);
        const float r = 1.0f / sqrtf(ss * (1.0f / DM) + EPS);
        const float* sh = modl + (size_t)(v * 9 + 3 * jmod) * DM; const float* sc = sh + DM;
        bf16* orow = XN + (size_t)row * DM;
#pragma unroll
        for (int i = 0; i < 4; ++i) { const int col = 8 * (lane + 64 * i); f32x4 y[2];
#pragma unroll
            for (int h = 0; h < 2; ++h) { const f32x4 gg = *(const f32x4*)(g + col + 4 * h), s1 = *(const f32x4*)(sc + col + 4 * h), s0 = *(const f32x4*)(sh + col + 4 * h);
                y[h] = x[i][h] * r * gg * (1.0f + s1) + s0; }
            v4u o; o.x = pk2(y[0].x, y[0].y); o.y = pk2(y[0].z, y[0].w); o.z = pk2(y[1].x, y[1].y); o.w = pk2(y[1].z, y[1].w); *(v4u*)(orow + col) = o; }
    }
}
__device__ __forceinline__ void final_phase(const bf16* X, float* out, const float* __restrict__ g, int gw, int NGW, int lane) {
    asm volatile("" : "+v"(lane));
    for (int r0 = gw; r0 < NB * SEQ; r0 += NGW) {
        const int rx = blk_xr(r0, NGW); const int b = rx >= SEQ ? 1 : 0, t = rx - b * SEQ; const size_t row = (size_t)b * RPB + CTXL + t;
        const bf16* src = X + row * DM;
        f32x4 x[4][2]; float ss = 0.f;
#pragma unroll
        for (int i = 0; i < 4; ++i) { const v4u w = *(const v4u*)(src + 8 * (lane + 64 * i));
            x[i][0] = (f32x4){bflo(w.x), bfhi(w.x), bflo(w.y), bfhi(w.y)}; x[i][1] = (f32x4){bflo(w.z), bfhi(w.z), bflo(w.w), bfhi(w.w)};
#pragma unroll
            for (int h = 0; h < 2; ++h) ss += (x[i][h].x * x[i][h].x + x[i][h].y * x[i][h].y) + (x[i][h].z * x[i][h].z + x[i][h].w * x[i][h].w); }
        ss = wave_sum(ss);
        const float r = 1.0f / sqrtf(ss * (1.0f / DM) + EPS);
        float* o = out + (size_t)rx * DM;
#pragma unroll
        for (int i = 0; i < 4; ++i)
#pragma unroll
            for (int h = 0; h < 2; ++h) { const int col = 8 * (lane + 64 * i) + 4 * h; *(f32x4*)(o + col) = x[i][h] * r * *(const f32x4*)(g + col); }
    }
}
__device__ __forceinline__ void pass_ab(const bf16* QKVs, bf16* QKV, const float* PIN, const float* __restrict__ gq, const float* __restrict__ gk, const float* tbl, int gw, int NGW, int lane) {
    asm volatile("" : "+v"(lane));
    const int a = lane >> 5, f = lane & 31;
    const float gq1 = gq[a * 64 + f], gq2 = gq[a * 64 + 32 + f], gk1 = gk[a * 64 + f], gk2 = gk[a * 64 + 32 + f];
    for (int base = gw; base < NB * SEQ; base += 4 * NGW) {
        float x1[4][4], x2[4][4], cs[4], sn[4]; bf16* rowp[4]; bool ok[4];
#pragma unroll
        for (int j = 0; j < 4; ++j) { const int xr = base + j * NGW; ok[j] = xr < NB * SEQ; const int xc = blk_xr(ok[j] ? xr : gw, NGW); const int b = xc >> 13, t = xc & (SEQ - 1);
            const size_t row = (size_t)b * RPB + CTXL + t; const int pos = a == 0 ? (t >> 6) : (t & 63);
            cs[j] = tbl[(a == 0 ? T_HRC : T_HCC) + pos * 32 + f]; sn[j] = tbl[(a == 0 ? T_HRS : T_HCS) + pos * 32 + f];
            rowp[j] = QKV + row * AB_IN + a * 64 + f; const bf16* rows = QKVs + row * AB_IN + a * 64 + f;
#pragma unroll
            for (int q = 0; q < 4; ++q) { const int hd = q < 2 ? 8 + q : 18 + q; x1[j][q] = bf2f(rows[hd * 128]); x2[j][q] = bf2f(rows[hd * 128 + 32]); } }
#pragma unroll
        for (int j = 0; j < 4; ++j)
#pragma unroll
            for (int q = 0; q < 2; ++q) { const float ss = wave_sum(x1[j][q] * x1[j][q] + x2[j][q] * x2[j][q]); const float r = 1.0f / sqrtf(ss * (1.0f / 128.0f) + EPS); x1[j][q] *= r * gk1; x2[j][q] *= r * gk2; }
#pragma unroll
        for (int j = 0; j < 4; ++j) if (ok[j]) {
#pragma unroll
            for (int q = 0; q < 4; ++q) { const int hd = q < 2 ? 8 + q : 18 + q;
                rowp[j][hd * 128] = (bf16)f2bf(x1[j][q] * cs[j] - x2[j][q] * sn[j]); rowp[j][hd * 128 + 32] = (bf16)f2bf(x2[j][q] * cs[j] + x1[j][q] * sn[j]); } }
    }
    for (int cr = gw; cr < NB * CTXL; cr += NGW) {
        const int b = cr >> 8, rr = cr & (CTXL - 1); const size_t row = (size_t)b * RPB + rr;
        bf16* rowp = QKV + row * AB_IN + a * 64 + f;
        const float* pp = PIN + (size_t)cr * AB_IN + a * 64 + f;
#pragma unroll 4
        for (int hd = 0; hd < 24; ++hd) { float x1 = 0.f, x2 = 0.f;
#pragma unroll
            for (int k = 0; k < 8; ++k) { x1 += pp[(size_t)k * 512 * AB_IN + hd * 128]; x2 += pp[(size_t)k * 512 * AB_IN + hd * 128 + 32]; }
            if (hd < 10) { const float ss = wave_sum(x1 * x1 + x2 * x2); const float r = 1.0f / sqrtf(ss * (1.0f / 128.0f) + EPS);
                x1 *= r * (hd < 8 ? gq1 : gk1); x2 *= r * (hd < 8 ? gq2 : gk2); }
            rowp[hd * 128] = (bf16)f2bf(x1); rowp[hd * 128 + 32] = (bf16)f2bf(x2); }
    }
}
__device__ __forceinline__ void pass_mla1(const bf16* CQ, const float* PIN, bf16* CQN, bf16* CKVN, bf16* KR, const float* __restrict__ gcq, const float* __restrict__ gckv, const float* tbl, int gw, int NGW, int lane) {
    asm volatile("" : "+v"(lane));
    for (int q = gw; q < ((NORM_BLOCKED && NGW == 2048) ? NB * SEQ + NGW : MROWS); q += NGW) {
        int row = q;
        if (NORM_BLOCKED && NGW == 2048) {
            if (q < NB * SEQ) { const int xr = blk_xr(q, NGW); row = (xr >> 13) * RPB + CTXL + (xr & (SEQ - 1)); }
            else { const int w = q - NB * SEQ; if (w & 3) continue; const int cr = w >> 2; row = (cr >> 8) * RPB + (cr & (CTXL - 1)); }
        }
        const int b = row >= RPB ? 1 : 0, rr = row - b * RPB; const bool isctx = rr < CTXL; const int t = rr - CTXL;
        const bf16* rp = CQ + (size_t)row * C_IN_PAD; const float* pp = PIN + (size_t)(b * CTXL + rr) * C_IN_PAD;
        { float x[8];
          if (!isctx) { const v4u w = *(const v4u*)(rp + lane * 8); x[0] = bflo(w.x); x[1] = bfhi(w.x); x[2] = bflo(w.y); x[3] = bfhi(w.y); x[4] = bflo(w.z); x[5] = bfhi(w.z); x[6] = bflo(w.w); x[7] = bfhi(w.w); }
          else { f32x4 s0 = {0.f, 0.f, 0.f, 0.f}, s1 = s0;
#pragma unroll
              for (int k = 0; k < 8; ++k) { s0 += *(const f32x4*)(pp + (size_t)k * 512 * C_IN_PAD + lane * 8); s1 += *(const f32x4*)(pp + (size_t)k * 512 * C_IN_PAD + lane * 8 + 4); }
              x[0] = s0.x; x[1] = s0.y; x[2] = s0.z; x[3] = s0.w; x[4] = s1.x; x[5] = s1.y; x[6] = s1.z; x[7] = s1.w; }
          float ss = 0.f;
#pragma unroll
          for (int i = 0; i < 8; ++i) ss += x[i] * x[i];
          ss = wave_sum(ss); const float r = 1.0f / sqrtf(ss * (1.0f / QRANK) + EPS);
          const f32x4 g0 = *(const f32x4*)(gcq + lane * 8), g1 = *(const f32x4*)(gcq + lane * 8 + 4);
          v4u o; o.x = pk2(x[0] * r * g0.x, x[1] * r * g0.y); o.y = pk2(x[2] * r * g0.z, x[3] * r * g0.w); o.z = pk2(x[4] * r * g1.x, x[5] * r * g1.y); o.w = pk2(x[6] * r * g1.z, x[7] * r * g1.w);
          *(v4u*)(CQN + (size_t)row * QRANK + lane * 8) = o; }
        { float x[4];
          if (!isctx) { const v2u w = *(const v2u*)(rp + 512 + lane * 4); x[0] = bflo(w.x); x[1] = bfhi(w.x); x[2] = bflo(w.y); x[3] = bfhi(w.y); }
          else { f32x4 s0 = {0.f, 0.f, 0.f, 0.f};
#pragma unroll
              for (int k = 0; k < 8; ++k) s0 += *(const f32x4*)(pp + (size_t)k * 512 * C_IN_PAD + 512 + lane * 4);
              x[0] = s0.x; x[1] = s0.y; x[2] = s0.z; x[3] = s0.w; }
          float ss = (x[0] * x[0] + x[1] * x[1]) + (x[2] * x[2] + x[3] * x[3]);
          ss = wave_sum(ss); const float r = 1.0f / sqrtf(ss * (1.0f / KVRANK) + EPS);
          const f32x4 g0 = *(const f32x4*)(gckv + lane * 4);
          v2u o; o.x = pk2(x[0] * r * g0.x, x[1] * r * g0.y); o.y = pk2(x[2] * r * g0.z, x[3] * r * g0.w);
          *(v2u*)(CKVN + (size_t)row * KVRANK + lane * 4) = o; }
        if (lane < 32) { const int a = lane >> 4, f = lane & 15;
          float x1, x2;
          if (!isctx) { x1 = bf2f(rp[768 + a * 32 + f]); x2 = bf2f(rp[768 + a * 32 + 16 + f]); }
          else { x1 = 0.f; x2 = 0.f;
#pragma unroll
              for (int k = 0; k < 8; ++k) { x1 += pp[(size_t)k * 512 * C_IN_PAD + 768 + a * 32 + f]; x2 += pp[(size_t)k * 512 * C_IN_PAD + 768 + a * 32 + 16 + f]; } }
          float cs = 1.f, sn = 0.f;
          if (!isctx) { const int pos = a == 0 ? (t >> 6) : (t & 63); cs = tbl[(a == 0 ? T_MRC : T_MCC) + pos * 16 + f]; sn = tbl[(a == 0 ? T_MRS : T_MCS) + pos * 16 + f]; }
          bf16* kr = KR + (size_t)row * 64 + a * 32 + f;
          kr[0] = (bf16)f2bf(x1 * cs - x2 * sn); kr[16] = (bf16)f2bf(x2 * cs + x1 * sn); }
    }
}
__device__ __forceinline__ void pass_mla2(const bf16* Qs, bf16* Q, const float* tbl, int gw, int NGW, int lane) {
    asm volatile("" : "+v"(lane));
    for (int row = gw; row < MROWS; row += NGW) {
        const int b = row >= RPB ? 1 : 0, rr = row - b * RPB; if (rr < CTXL) continue; const int t = rr - CTXL;
        bf16* rp = Q + (size_t)row * MLA_QOUT; const bf16* rs = Qs + (size_t)row * MLA_QOUT;
#pragma unroll
        for (int it = 0; it < 8; ++it) { const int P = it * 64 + lane, h = P >> 5, p = P & 31, a = p >> 4, f = p & 15;
            const int pos = a == 0 ? (t >> 6) : (t & 63);
            const float cs = tbl[(a == 0 ? T_MRC : T_MCC) + pos * 16 + f], sn = tbl[(a == 0 ? T_MRS : T_MCS) + pos * 16 + f];
            bf16* q = rp + h * 192 + 128 + a * 32 + f; const bf16* qs = rs + h * 192 + 128 + a * 32 + f;
            const float x1 = bf2f(qs[0]), x2 = bf2f(qs[16]);
            q[0] = (bf16)f2bf(x1 * cs - x2 * sn); q[16] = (bf16)f2bf(x2 * cs + x1 * sn); }
    }
}

struct Args { const float* in[21]; float* out; unsigned char* ws; };
#define INP(k) ({ int k_ = (k); asm volatile("" : "+s"(k_)); args.in[k_]; })
#define WSP(T, off) ({ size_t o_ = (off); asm volatile("" : "+s"(o_)); (T*)(args.ws + o_); })
#define MOD WSP(float, WS_MOD)
#define TBL WSP(float, WS_TBL)
#define WGU WSP(bf16, WS_WGU)
#define WDN WSP(bf16, WS_WDN)
#define WINAB WSP(bf16, WS_WINAB)
#define WOUTAB WSP(bf16, WS_WOUTAB)
#define WINC WSP(bf16, WS_WINC)
#define WUQ WSP(bf16, WS_WUQ)
#define WUKV WSP(bf16, WS_WUKV)
#define WOUTC WSP(bf16, WS_WOUTC)
#define X WSP(bf16, WS_X)
#define XN WSP(bf16, WS_XN)
#define H WSP(bf16, WS_H)
#define QKV WSP(bf16, WS_QKV)
#define KV WSP(bf16, WS_KV)
#define CQ WSP(bf16, WS_CQ)
#define CQN WSP(bf16, WS_CQN)
#define CKVN WSP(bf16, WS_CKVN)
#define KR WSP(bf16, WS_KR)
#define O WSP(bf16, WS_O)
__global__ void __launch_bounds__(NWAVES * 64, 2) fwd(Args args) {
    extern __shared__ __attribute__((aligned(16))) unsigned char lds[];
    LAS unsigned char* L = (LAS unsigned char*)lds;
#if CODE_SHIFT >= 1
    asm volatile("s_nop 0");
#endif
#if CODE_SHIFT >= 2
    asm volatile("s_nop 0");
#endif
#if CODE_SHIFT >= 3
    asm volatile("s_nop 0");
#endif
#if CODE_SHIFT >= 4
    asm volatile("s_nop 0");
#endif
#if CODE_SHIFT >= 5
    asm volatile("s_nop 0");
#endif
#if CODE_SHIFT >= 6
    asm volatile("s_nop 0");
#endif
#if CODE_SHIFT >= 7
    asm volatile("s_nop 0");
#endif
#if CODE_SHIFT >= 8
    asm volatile("s_nop 0\n\ts_nop 0\n\ts_nop 0\n\ts_nop 0\n\ts_nop 0\n\ts_nop 0\n\ts_nop 0\n\ts_nop 0");
#endif
    volatile LAS unsigned* MISC = (volatile LAS unsigned*)(L + MISC_OFF);
    const int wave = __builtin_amdgcn_readfirstlane((int)threadIdx.x >> 6);
#define lane lane_id_fresh()
#define tid (wave * 64 + lane_id_fresh())
    const int G = gridDim.x, bx = blockIdx.x, vcu = (G % 8 == 0) ? (bx % 8) * (G / 8) + bx / 8 : bx;
    const int gw = vcu * NWAVES + wave, NGW = G * NWAVES;
    unsigned* ctl = (unsigned*)(args.ws + WS_CTL);
    for (int u = tid; u < (LDS_BYTES - LDSCTL_OFF) / 4; u += NWAVES * 64) ((LAS unsigned*)(L + LDSCTL_OFF))[u] = 0u;
    __syncthreads();
    (void)xcd_barrier_post((unsigned*)(ctl + CW_BAR), MISC + 8, tid == 0);
#if PROBE_WAIT_MASK
#define GRID_BAR(c) do { XcdBarrier bar_; bar_.bar = WSP(unsigned, WS_CTL) + CW_BAR; bar_.x = xb_xcc_id(); bar_.st = (volatile LAS unsigned*)(L + MISC_OFF) + 8; \
    const unsigned long long t0_ = __builtin_amdgcn_s_memrealtime(); xcd_barrier(bar_, tid == 0); const unsigned long long t1_ = __builtin_amdgcn_s_memrealtime(); \
    if (((PROBE_WAIT_MASK >> (c)) & 1) && tid == 0) { volatile LAS unsigned* w_ = (volatile LAS unsigned*)(L + MISC_OFF) + 16; *w_ = *w_ + (unsigned)(t1_ - t0_); } } while (0)
#else
#define GRID_BAR(c) do { XcdBarrier bar_; bar_.bar = WSP(unsigned, WS_CTL) + CW_BAR; bar_.x = xb_xcc_id(); bar_.st = (volatile LAS unsigned*)(L + MISC_OFF) + 8; xcd_barrier(bar_, tid == 0); if (PROBE_BAR) xcd_barrier(bar_, tid == 0); } while (0)
#endif

    {
        for (int rep_ = 0; rep_ < 1 + PROBE_MOD; ++rep_)
        p0_mod(INP(1), INP(3), INP(4), WSP(float, WS_H), L, tid, wave, lane);
        LAS float* scr = (LAS float*)(L + RING_OFF + wave * 16384);
        for (int rep_ = 0; rep_ < 1 + PROBE_TR; ++rep_)
        for (int ly = 0; ly < (DEFER_CONV ? 1 : DEPTH); ++ly)
            convert_layer(INP(7), INP(8), INP(9), INP(13), INP(14), INP(17), INP(18), INP(19), args.ws, ly, 0, 1, gw, NGW, scr, lane);
        { constexpr int PER = (C_IN_PAD - C_IN) * DM * 2 / 16;
          for (int i = gw * 64 + lane; i < 2 * PER; i += NGW * 64) { const int m = i / PER, j = i - m * PER;
              *(v4u*)((unsigned char*)WINC + (size_t)m * SZ_WINC + (size_t)C_IN * DM * 2 + (size_t)j * 16) = (v4u){0u, 0u, 0u, 0u}; } }
        for (int e = gw * 64 + lane; e < 9216; e += NGW * 64) {
            int p, f, nf, oc, os;
            if (e < 6144) { p = e >> 5; f = e & 31; nf = 32; if (p < 128) { oc = T_HRC + p * 32 + f; os = T_HRS + p * 32 + f; } else { oc = T_HCC + (p - 128) * 32 + f; os = T_HCS + (p - 128) * 32 + f; } }
            else { const int e2 = e - 6144; p = e2 >> 4; f = e2 & 15; nf = 16; if (p < 128) { oc = T_MRC + p * 16 + f; os = T_MRS + p * 16 + f; } else { oc = T_MCC + (p - 128) * 16 + f; os = T_MCS + (p - 128) * 16 + f; } }
            const int pos = p < 128 ? p : p - 128;
            const double inv = my_exp(-((double)f / (double)nf) * 9.210340371976184);
            double s, c; my_sincos((double)pos * inv, s, c);
            TBL[oc] = (float)c; TBL[os] = (float)s;
        }
    }
    GRID_BAR(5);
    p0_mod_sum(WSP(float, WS_H), INP(5), MOD, gw * 64 + lane, NGW * 64);
    GRID_BAR(5);

    int pS = 0; const float* pgate = nullptr; float pcoef = 0.f;
    for (int l = 0; l < DEPTH; ++l) {
        const float* modl = MOD + (size_t)l * 3 * 9 * DM;
        const int li = l >> 1; const bool even = (l & 1) == 0;
        for (int half = 0; half < 2; ++half) {
            if (half == 1) {
                norm_phase(nullptr, nullptr, X, XN, INP(6) + (size_t)(l * 3 + 1) * DM, modl, 1, false, WSP(float, WS_PARTC), pS, pgate, pcoef, gw, NGW, lane);
                pS = 0;
                GRID_BAR(0);
                {
                    const int N = even ? AB_IN : C_IN_PAD;
                    const bf16* Wi = even ? WINAB + (size_t)li * AB_IN * DM : WINC + (size_t)li * C_IN_PAD * DM;
                    {   pg8::Gemm gs{XN, Wi, MROWS, N, 256, DM, DM, (size_t)128};
                        pg8::CtxSplitOrder Sc{8, N / 256, 256, bx};
                        pg8::EpiPartial Ep{WSP(float, WS_PIN), N};
                        pg8::gemm_phase<pg8::EpiPartial, pg8::CtxSplitOrder, false, PG8_SP2>(L + RING_OFF, gs, Sc, Ep, tid); }
                    pg8::Gemm g{XN, Wi, MROWS, N, DM, DM, DM, (size_t)128};
                    pg8::PanelOrder S; S.init(N, G, bx, true); S.wgm = WGM_PROJ;
                    pg8::EpiPlain E{even ? QKV : CQ, N};
                    for (int rep_ = 0; rep_ < 1 + PROBE_INPROJ; ++rep_)
                    pg8::gemm_phase<pg8::EpiPlain, pg8::PanelOrder, PG8_ALIGN, PG8_SP2>(L + RING_OFF, g, S, E, tid);
                }
                GRID_BAR(4);
                if (even) {
                    if (PROBE_PASS) pass_ab(QKV, KV, WSP(float, WS_PIN), INP(10) + li * 128, INP(11) + li * 128, TBL, gw, NGW, lane);
                    pass_ab(QKV, QKV, WSP(float, WS_PIN), INP(10) + li * 128, INP(11) + li * 128, TBL, gw, NGW, lane);
                    GRID_BAR(0);
                    for (int rep_ = 0; rep_ < 1 + PROBE_ATTAB; ++rep_) {
                    int vc = vcu; asm volatile("" : "+s"(vc));
                    float bnd_ = 0.f; bool fastA = false;
                    if (ATT_NOMAX) { const int ln_ = lane; const float* gq_ = INP(10) + li * 128; const float* gk_ = INP(11) + li * 128;
                        const float mq_ = wave_max(fmaxf(fabsf(gq_[ln_]), fabsf(gq_[ln_ + 64]))), mk_ = wave_max(fmaxf(fabsf(gk_[ln_]), fabsf(gk_[ln_ + 64])));
                        bnd_ = 16.3222f * 1.01f * mq_ * mk_ + 0.25f; bnd_ = __builtin_bit_cast(float, __builtin_amdgcn_readfirstlane(__builtin_bit_cast(int, bnd_))); fastA = bnd_ * 2.f <= 120.f; }
                    for (int it = 0; it < 5; ++it) {
                        int type, b, h, qb = 0;
                        if (it < 4) { type = it >> 1; b = it & 1; h = vc >> 5; qb = vc & 31; }
                        else { if (vc >= 32) break; type = 2 + ((vc >> 3) & 1); b = vc >> 4; h = vc & 7; }
                        const bool isB = (type & 1) != 0; const int kvh = h >> 2;
                        const int qcol = (isB ? 1536 : 0) + 128 * h, kcol = (isB ? 2560 : 1024) + 128 * kvh, vcol = (isB ? 2816 : 1280) + 128 * kvh, ocol = (isB ? 1024 : 0) + 128 * h;
                        const size_t rowb = (size_t)b * RPB, qrow = rowb + (type < 2 ? CTXL + 256 * qb : 0);
                        int NT = 4, base1 = 256, wmode = 0, qpos0 = 0;
                        if (type == 0) NT = 132;
                        else if (type == 1) { const int bs = (256 * qb - 128) < 0 ? 0 : (256 * qb - 128), be = (256 * qb + 384) > SEQ ? SEQ : (256 * qb + 384); NT = 4 + (be - bs) / 64; base1 = 256 + bs; wmode = 1; qpos0 = 256 * qb; }
                        float m_init = -1e30f, l_init = 0.f;
                        if (isB) { m_init = INP(12)[li * 8 + h] * 11.313708498984761f; l_init = 1.f; }
                        const bool nomax_ = ATT_NOMAX && ATT_NEGM && type == 0 && fastA; if (nomax_) m_init = bnd_;
                        att::attn_unit<128, 3072, 3072, 3072, 2048, ATT_SD128>(QKV + qrow * AB_IN + qcol, QKV + rowb * AB_IN + kcol, nullptr, QKV + rowb * AB_IN + vcol, O + qrow * DM + ocol,
                                                                   NT, base1, wmode, type < 2 ? 256 * qb : 0, m_init, l_init, type < 2 ? (const float*)TBL : nullptr, (type == 0) ? INP(10) + li * 128 : nullptr, (char*)lds + RING_OFF, tid, nomax_);
                    }
                    }
                } else {
                    if (PROBE_PASS) pass_mla1(CQ, WSP(float, WS_PIN), CQN, CKVN, KR, INP(15) + li * QRANK, INP(16) + li * KVRANK, TBL, gw, NGW, lane);
                    pass_mla1(CQ, WSP(float, WS_PIN), CQN, CKVN, KR, INP(15) + li * QRANK, INP(16) + li * KVRANK, TBL, gw, NGW, lane);
                    GRID_BAR(0);
                    {   pg8::Gemm g{CQN, WUQ + (size_t)li * MLA_QOUT * QRANK, MROWS, MLA_QOUT, QRANK, QRANK, QRANK, (size_t)128};
                        pg8::PanelOrder S; S.init(MLA_QOUT, G, bx, UP_HALFCTX ? true : false); S.wgm = WGM_PROJ;
                        pg8::EpiPlain E{QKV, MLA_QOUT};
                        for (int rep_ = 0; rep_ < 1 + PROBE_UQKV; ++rep_)
                        pg8::gemm_phase<pg8::EpiPlain, pg8::PanelOrder, PG8_ALIGN, PG8_SP2>(L + RING_OFF, g, S, E, tid);
                        if (UP_HALFCTX) { pg8::CtxHalfOrder Sh{MLA_QOUT / 256, bx - 64}; pg8::EpiPlain_T<true> Eh{QKV, MLA_QOUT};
                            pg8::gemm_phase<pg8::EpiPlain_T<true>, pg8::CtxHalfOrder, false, true, true>(L + RING_OFF, g, Sh, Eh, tid); } }
                    {   pg8::Gemm g{CKVN, WUKV + (size_t)li * MLA_KVOUT * KVRANK, MROWS, MLA_KVOUT, KVRANK, KVRANK, KVRANK, (size_t)128};
                        pg8::PanelOrder S; S.init(MLA_KVOUT, G, bx, UP_HALFCTX ? true : false); S.wgm = WGM_PROJ;
                        pg8::EpiPlain E{KV, MLA_KVOUT};
                        for (int rep_ = 0; rep_ < 1 + PROBE_UQKV; ++rep_)
                        pg8::gemm_phase<pg8::EpiPlain, pg8::PanelOrder, PG8_ALIGN, PG8_SP2>(L + RING_OFF, g, S, E, tid);
                        if (UP_HALFCTX) { pg8::CtxHalfOrder Sh{MLA_KVOUT / 256, bx}; pg8::EpiPlain_T<true> Eh{KV, MLA_KVOUT};
                            pg8::gemm_phase<pg8::EpiPlain_T<true>, pg8::CtxHalfOrder, false, true, true>(L + RING_OFF, g, Sh, Eh, tid); } }
                    GRID_BAR(4);
                    const bool need_ctx = l < DEPTH - 1;
                    for (int rep_ = 0; rep_ < 1 + PROBE_ATTMLA; ++rep_) {
                    int vc = vcu; asm volatile("" : "+s"(vc));
                    for (int it = 0; it < 5; ++it) {
                        int b, h, qb = 0; bool cx = false;
                        if (it < 4) { b = it >> 1; h = (it & 1) * 8 + (vc >> 5); qb = vc & 31; }
                        else { if (!need_ctx || vc >= 32) break; b = vc >> 4; h = vc & 15; cx = true; }
                        const size_t rowb = (size_t)b * RPB, qrow = rowb + (cx ? 0 : CTXL + 256 * qb);
                        att::attn_unit<192, 3072, 4096, 4096, 2048, ATT_SD192>(QKV + qrow * MLA_QOUT + 192 * h, KV + rowb * MLA_KVOUT + 256 * h, KR + rowb * 64, KV + rowb * MLA_KVOUT + 256 * h + 128, O + qrow * DM + 128 * h,
                                                                   cx ? 4 : 132, 256, 0, 256 * qb, -1e30f, 0.f, cx ? nullptr : (const float*)TBL, nullptr, (char*)lds + RING_OFF, tid);
                    }
                    }
                }
                GRID_BAR(3);
                {
                    const bf16* Wo = even ? WOUTAB + (size_t)li * DM * DM : WOUTC + (size_t)li * DM * DM;
                    if (l < DEPTH - 1) {
                        pg8::Gemm gs{O, Wo, MROWS, DM, 256, DM, DM, (size_t)128};
                        pg8::CtxSplitOrder Sc{8, DM / 256, 256, bx};
                        pg8::EpiPartial Ep{WSP(float, WS_PARTC), DM};
                        pg8::gemm_phase<pg8::EpiPartial, pg8::CtxSplitOrder, false, PG8_SP2>(L + RING_OFF, gs, Sc, Ep, tid);
                        pS = 8; pgate = modl + (size_t)(2 * 9 + 5) * DM; pcoef = 1.0f;
                    }
                    pg8::Gemm g{O, Wo, MROWS, DM, DM, DM, DM, (size_t)128};
                    pg8::PanelOrder S; S.init(DM, G, bx, true); S.wgm = WGM_G2;
                    pg8::EpiResid E{X, modl, 5, 1.0f / (1 + PROBE_OUTPROJ)};
                    for (int rep_ = 0; rep_ < 1 + PROBE_OUTPROJ; ++rep_)
                    pg8::gemm_phase<pg8::EpiResid, pg8::PanelOrder, PG8_ALIGN, PG8_SP2>(L + RING_OFF, g, S, E, tid);
                    if (PROBE_OUTPLAIN) { pg8::EpiPlain E2{WSP(bf16, WS_END), DM};
                        pg8::gemm_phase<pg8::EpiPlain, pg8::PanelOrder, PG8_ALIGN, PG8_SP2>(L + RING_OFF, g, S, E2, tid); }
                }
                GRID_BAR(4);
            }
            const int j = 2 * half, wi = l * 2 + half;
            const bool ctx_live = !(l == DEPTH - 1 && half == 1);
            for (int rep_ = 0; rep_ < 1 + PROBE_NORM; ++rep_)
            norm_phase(INP(0), INP(2), X, XN, INP(6) + (size_t)(l * 3 + j) * DM, modl, j, l == 0 && half == 0, WSP(float, WS_PARTC), rep_ == 0 ? pS : 0, pgate, pcoef, gw, NGW, lane);
            pS = 0;
            GRID_BAR(0);
            {   pg8::Gemm g{XN, WGU + (size_t)wi * 2 * DFF * DM, MROWS, 2 * DFF, DM, DM, DM, (size_t)128};
                pg8::PanelOrder S; S.init(2 * DFF, G, bx, G1_HALFCTX ? true : !ctx_live); S.wgm = WGM_G1;
                pg8::EpiSwiGLU E{H, H_TILED ? MROWS : DFF};
                for (int rep_ = 0; rep_ < 1 + PROBE_G1; ++rep_)
                for (int cut_ = 0; cut_ < G1_CUTS; ++cut_) {
                    S.r0 = cut_ * (12 / G1_CUTS); S.r1 = (cut_ + 1) * (12 / G1_CUTS);
                    if (cut_ > 0) GRID_BAR(1);
                    pg8::gemm_phase<pg8::EpiSwiGLU, pg8::PanelOrder, PG8_ALIGN, PG8_SP2>(L + RING_OFF, g, S, E, tid); }
                if (G1_HALFCTX && ctx_live) {
                    pg8::CtxHalfOrder Sh{2 * DFF / 256, bx};
                    pg8::EpiSwiGLU_T<true> Eh{H, H_TILED ? MROWS : DFF};
                    pg8::gemm_phase<pg8::EpiSwiGLU_T<true>, pg8::CtxHalfOrder, false, true, true>(L + RING_OFF, g, Sh, Eh, tid); }
                if (PROBE_G1PLAIN) { pg8::EpiPlain E2{WSP(bf16, WS_END), 2 * DFF};
                    pg8::gemm_phase<pg8::EpiPlain, pg8::PanelOrder, PG8_ALIGN, PG8_SP2>(L + RING_OFF, g, S, E2, tid); }
                if (DEFER_CONV && l + 1 < DEPTH && bx >= 88) {
                    int lane_ = lane; asm volatile("" : "+v"(lane_));
                    convert_layer(INP(7), INP(8), INP(9), INP(13), INP(14), INP(17), INP(18), INP(19), args.ws, l + 1, half, 2, (bx - 88) * NWAVES + wave, 168 * NWAVES, (LAS float*)(L + RING_OFF + wave * 16384), lane_); } }
            GRID_BAR(1);
            {
                const bf16* Wd = WDN + (size_t)wi * DM * DFF;
                if (ctx_live) {
                    pg8::Gemm gs{H, Wd, MROWS, DM, 512, DFF, H_TILED ? 64 : DFF, H_TILED ? (size_t)MROWS * 128 : (size_t)128};
                    pg8::CtxSplitOrder Sc{11, DM / 256, 512, bx};
                    pg8::EpiPartial Ep{WSP(float, WS_PARTC), DM};
                    pg8::gemm_phase<pg8::EpiPartial, pg8::CtxSplitOrder, false, PG8_SP2>(L + RING_OFF, gs, Sc, Ep, tid);
                    pS = 11; pgate = modl + (size_t)(2 * 9 + 3 * j + 2) * DM; pcoef = 0.5f;
                }
                pg8::Gemm g{H, Wd, MROWS, DM, DFF, DFF, H_TILED ? 64 : DFF, H_TILED ? (size_t)MROWS * 128 : (size_t)128};
                pg8::PanelOrder S; S.init(DM, G, bx, true); S.rev = REV_G2; S.wgm = WGM_G2;
                pg8::EpiResid E{X, modl, 3 * j + 2, 0.5f / (1 + PROBE_G2)};
                for (int rep_ = 0; rep_ < 1 + PROBE_G2; ++rep_)
                pg8::gemm_phase<pg8::EpiResid, pg8::PanelOrder, PG8_ALIGN, PG8_SP2>(L + RING_OFF, g, S, E, tid); }
            GRID_BAR(2);
        }
    }
    final_phase(X, args.out, INP(20), gw, NGW, lane);
#if PROBE_WAIT_MASK
    if (tid == 0) __hip_atomic_fetch_add(WSP(unsigned, WS_CTL) + 2048, *((volatile LAS unsigned*)(L + MISC_OFF) + 16), __ATOMIC_RELAXED, __HIP_MEMORY_SCOPE_AGENT);
    GRID_BAR(7);
    if (bx == 0 && tid == 0) { const unsigned tot = __hip_atomic_load(WSP(unsigned, WS_CTL) + 2048, __ATOMIC_RELAXED, __HIP_MEMORY_SCOPE_AGENT); const float us_ = (float)tot / (float)G * 0.01f; args.out[0] += floorf((us_ + PROBE_WAIT_OFF) / PROBE_WAIT_Q) * PROBE_WAIT_Q; }
#endif
#undef GRID_BAR
#undef lane
#undef tid
}
#undef MOD
#undef TBL
#undef WGU
#undef WDN
#undef WINAB
#undef WOUTAB
#undef WINC
#undef WUQ
#undef WUKV
#undef WOUTC
#undef X
#undef XN
#undef H
#undef QKV
#undef KV
#undef CQ
#undef CQN
#undef CKVN
#undef KR
#undef O

extern "C" void kernel_launch(void* const* d_in, const int* in_sizes, int n_in, void* d_out, int out_size, void* d_ws, size_t ws_size, hipStream_t stream) {
    static int grid = 0;
    if (grid == 0) {
        if (n_in != 21 || in_sizes[0] != NB * SEQ * DM || out_size != NB * SEQ * DM || ws_size < WS_END) {
            fprintf(stderr, "kernel_launch: shape mismatch: n_in %d in0 %d out %d ws %zu (need %zu)\n", n_in, n_in > 0 ? in_sizes[0] : -1, out_size, ws_size, (size_t)WS_END); grid = -1; return; }
        int dev = 0, cus = 0, per_cu = 0;
        if (hipGetDevice(&dev) != hipSuccess || hipDeviceGetAttribute(&cus, hipDeviceAttributeMultiprocessorCount, dev) != hipSuccess) { fprintf(stderr, "kernel_launch: device query failed\n"); grid = -1; return; }
        if (hipFuncSetAttribute((const void*)fwd, hipFuncAttributeMaxDynamicSharedMemorySize, LDS_BYTES) != hipSuccess) { fprintf(stderr, "kernel_launch: hipFuncSetAttribute failed\n"); grid = -1; return; }
        if (hipOccupancyMaxActiveBlocksPerMultiprocessor(&per_cu, (const void*)fwd, NWAVES * 64, LDS_BYTES) != hipSuccess || per_cu < 1)
            fprintf(stderr, "kernel_launch: note: occupancy query reports %d workgroups per CU\n", per_cu);
        (void)hipGetLastError();
        grid = cus;
    }
    if (grid < 0) return;
    if (hipMemsetAsync((char*)d_ws + WS_CTL, 0, CTL_ZERO_BYTES, stream) != hipSuccess) { fprintf(stderr, "kernel_launch: memset failed\n"); return; }
    Args a{};
    for (int i = 0; i < 21; ++i) a.in[i] = (const float*)d_in[i];
    a.out = (float*)d_out; a.ws = (unsigned char*)d_ws;
    hipLaunchKernelGGL(fwd, dim3(grid), dim3(NWAVES * 64), LDS_BYTES, stream, a);
    const hipError_t le = hipPeekAtLastError();
    if (le != hipSuccess) fprintf(stderr, "kernel_launch: launch failed: %s\n", hipGetErrorName(le));
}
```
